# Optimizing an MI355X kernel written in HIP

```python
import jax, jax.numpy as jnp
from jax import lax
import numpy as np

D_MODEL = 2048
BATCH = 1
SEQ = 8192
DEPTH = 1
DEC_BATCH = 16
DEC_SEQ = 16
PAST_LEN = 2048

CHUNK = 64
EPS = 1e-6
MLA_HEADS = 16
MLA_Q_RANK = 512
MLA_KV_RANK = 512
MLA_NOPE = 128
MLA_ROPE = 64
MLA_V = 128
MLA_QK_DIM = MLA_NOPE + MLA_ROPE
MLA_SCALE = MLA_QK_DIM ** -0.5
ROPE_THETA = 10000.0
Q_BLOCK = 128
GLA_HEADS = 4
GLA_DK = 256
GLA_DV = 512
GLA_GATE_RANK = 16
GLA_TAU = 16.0
GLA_BLOCK = 16
D_FF = 4 * D_MODEL
D_IN = (MLA_Q_RANK + MLA_KV_RANK + MLA_ROPE + 2 * GLA_HEADS * GLA_DK + 2 * GLA_HEADS * GLA_DV
        + GLA_GATE_RANK + 2 * D_MODEL)

kernel_name = "hybrid_mla_gla_streaming_step"


def rmsnorm(x, g):
    xf = x.astype(jnp.float32)
    inv = lax.rsqrt(jnp.mean(xf * xf, axis=-1, keepdims=True) + EPS)
    return (xf * inv * g.astype(jnp.float32)).astype(x.dtype)


def rope(x, pos):
    half = MLA_ROPE // 2
    freqs = jnp.power(ROPE_THETA, -jnp.arange(half, dtype=jnp.float32) / half)
    ang = pos[:, None] * freqs[None, :]
    shape = (ang.shape[0],) + (1,) * (x.ndim - 3) + (half,)
    cos = jnp.cos(ang).reshape(shape)
    sin = jnp.sin(ang).reshape(shape)
    xf = x.astype(jnp.float32)
    x1, x2 = xf[..., :half], xf[..., half:]
    return jnp.concatenate([x1 * cos - x2 * sin, x2 * cos + x1 * sin], axis=-1).astype(x.dtype)


def _front(x, pos, norm_g, w_in, q_norm_g, w_uq, kv_norm_g, gq_n, gq_r, gk_n, gk_r, w_a2, b_a):
    B, T, _ = x.shape
    f32 = jnp.float32
    h = rmsnorm(x, norm_g)
    z = h @ w_in
    gk_w, gv_w = GLA_HEADS * GLA_DK, GLA_HEADS * GLA_DV
    points = [int(p) for p in np.cumsum([MLA_Q_RANK, MLA_KV_RANK, MLA_ROPE, gk_w, gk_w, gv_w,
                                         GLA_GATE_RANK, gv_w, D_MODEL])]
    (q_lat, kv_lat, k_rope_raw, g_q, g_k, g_v, a_lr, out_gate, gate_mla, gate_gla) = jnp.split(z, points, axis=-1)
    q = jnp.einsum('btc,chd->bthd', rmsnorm(q_lat, q_norm_g), w_uq)
    q_nope = q[..., :MLA_NOPE].astype(f32)
    q_rope = rope(q[..., MLA_NOPE:], pos).astype(f32)
    ss = jnp.sum(q_nope * q_nope, -1, keepdims=True) + jnp.sum(q_rope * q_rope, -1, keepdims=True)
    inv_q = lax.rsqrt(ss / MLA_QK_DIM + EPS)
    qn = (q_nope * inv_q * (gq_n * gk_n).astype(f32) * MLA_SCALE).astype(x.dtype)
    qr = (q_rope * inv_q * jnp.tile((gq_r * gk_r).astype(f32), 2) * MLA_SCALE).astype(x.dtype)
    ckv = rmsnorm(kv_lat, kv_norm_g)
    krope = rope(k_rope_raw, pos)
    gla_q = g_q.reshape(B, T, GLA_HEADS, GLA_DK) * (GLA_DK ** -0.5)
    gla_k = g_k.reshape(B, T, GLA_HEADS, GLA_DK)
    gla_v = g_v.reshape(B, T, GLA_HEADS, GLA_DV)
    log_a = (jax.nn.log_sigmoid((a_lr @ w_a2 + b_a).astype(f32)) / GLA_TAU).reshape(B, T, GLA_HEADS, GLA_DK)
    return (qn, qr, ckv, krope, gla_q, gla_k, gla_v, log_a, out_gate, gate_mla, gate_gla)


def _mla_keys(ckv, krope, w_ukv):
    kv = jnp.einsum('bsc,chd->bshd', ckv, w_ukv)
    kn, v = kv[..., :MLA_NOPE], kv[..., MLA_NOPE:]
    knf = kn.astype(jnp.float32)
    krf = krope.astype(jnp.float32)
    ss = jnp.sum(knf * knf, -1) + jnp.sum(krf * krf, -1)[..., None]
    inv_k = lax.rsqrt(ss / MLA_QK_DIM + EPS)
    return kn, v, jnp.swapaxes(inv_k, 1, 2)


def _attend(qn, qr, kn, kr, v, inv_k, mask):
    s = (jnp.einsum('bqhd,bkhd->bhqk', qn, kn, preferred_element_type=jnp.float32)
         + jnp.einsum('bqhr,bkr->bhqk', qr, kr, preferred_element_type=jnp.float32))
    s = s * inv_k[:, :, None, :].astype(jnp.float32)
    if mask is not None:
        s = jnp.where(mask, s, -jnp.inf)
    p = jax.nn.softmax(s, axis=-1).astype(v.dtype)
    return jnp.einsum('bhqk,bkhd->bqhd', p, v)


def _mla_prompt_attention(qn, qr, kn, kr, v, inv_k):
    B, T, H, _ = qn.shape
    key_chunk = jnp.arange(T) // CHUNK

    def block(i):
        q0 = i * Q_BLOCK
        qn_b = lax.dynamic_slice_in_dim(qn, q0, Q_BLOCK, axis=1)
        qr_b = lax.dynamic_slice_in_dim(qr, q0, Q_BLOCK, axis=1)
        q_chunk = (q0 + jnp.arange(Q_BLOCK)) // CHUNK
        mask = key_chunk[None, :] <= q_chunk[:, None]
        return _attend(qn_b, qr_b, kn, kr, v, inv_k, mask)

    out = lax.map(block, jnp.arange(T // Q_BLOCK))
    return jnp.moveaxis(out, 0, 1).reshape(B, T, H * MLA_V)


def _gla_chunked(q, k, v, log_a, s0):
    B, T, H, DK = q.shape
    DV = v.shape[-1]
    L = GLA_BLOCK
    n = -(-T // L)
    pad = n * L - T
    f32 = jnp.float32

    def prep(a):
        a = jnp.pad(a.astype(f32), ((0, 0), (0, pad), (0, 0), (0, 0)))
        return a.reshape(B, n, L, H, a.shape[-1])

    qb, kb, vb, lab = prep(q), prep(k), prep(v), prep(log_a)
    b = jnp.cumsum(lab, axis=2)
    q_t = qb * jnp.exp(b)
    k_t = kb * jnp.exp(-b)
    b_end = b[:, :, -1]
    k_end = kb * jnp.exp(b_end[:, :, None] - b)
    tril = jnp.tril(jnp.ones((L, L), dtype=bool))
    A = jnp.where(tril, jnp.einsum('bnqhd,bnkhd->bnhqk', q_t, k_t), 0.0)
    o_intra = jnp.einsum('bnhqk,bnkhe->bnqhe', A, vb)

    def step(S, xs):
        q_n, k_n, v_n, be_n = xs
        o = jnp.einsum('blhd,bhde->blhe', q_n, S)
        S = S * jnp.exp(be_n)[..., None] + jnp.einsum('blhd,blhe->bhde', k_n, v_n)
        return S, o

    xs = (jnp.moveaxis(q_t, 1, 0), jnp.moveaxis(k_end, 1, 0), jnp.moveaxis(vb, 1, 0), jnp.moveaxis(b_end, 1, 0))
    s_fin, o_inter = lax.scan(step, s0.astype(f32), xs)
    o = o_intra + jnp.moveaxis(o_inter, 0, 1)
    return o.reshape(B, n * L, H, DV)[:, :T], s_fin


def _back(x, o_mla, o_gla, out_gate, gate_mla, gate_gla, gla_norm_g, w_o, norm_ffn_g, w_up, w_down):
    B, T, _ = x.shape
    o_gla = rmsnorm(o_gla, gla_norm_g).astype(x.dtype).reshape(B, T, GLA_HEADS * GLA_DV) * jax.nn.silu(out_gate)
    mixed = jax.nn.sigmoid(gate_mla) * o_mla + jax.nn.sigmoid(gate_gla) * o_gla
    x = x + mixed @ w_o
    h = rmsnorm(x, norm_ffn_g)
    return x + jnp.square(jax.nn.relu(h @ w_up)) @ w_down


def setup_inputs(seed: int = 0) -> dict:
    key = jax.random.key(seed)
    ks = jax.random.split(key, 22)
    f32 = jnp.float32

    def nrm(k, shape, scale=1.0):
        return jax.random.normal(k, shape, f32) * scale

    def gain(k, n):
        return 1.0 + 0.01 * jax.random.normal(k, (DEPTH, n), f32)

    return {
        "x_prompt": nrm(ks[0], (BATCH, SEQ, D_MODEL)),
        "x_sample": nrm(ks[1], (DEC_BATCH, DEC_SEQ, D_MODEL)),
        "cache_mla_ckv": nrm(ks[2], (DEPTH, DEC_BATCH, PAST_LEN, MLA_KV_RANK)),
        "cache_mla_krope": nrm(ks[3], (DEPTH, DEC_BATCH, PAST_LEN, MLA_ROPE)),
        "state_gla": nrm(ks[4], (DEPTH, DEC_BATCH, GLA_HEADS, GLA_DK, GLA_DV)),
        "norm_mix_g": gain(ks[5], D_MODEL),
        "w_in": nrm(ks[6], (DEPTH, D_MODEL, D_IN), D_MODEL ** -0.5),
        "mla_q_norm_g": gain(ks[7], MLA_Q_RANK),
        "mla_w_uq": nrm(ks[8], (DEPTH, MLA_Q_RANK, MLA_HEADS, MLA_QK_DIM), MLA_Q_RANK ** -0.5),
        "mla_kv_norm_g": gain(ks[9], MLA_KV_RANK),
        "mla_w_ukv": nrm(ks[10], (DEPTH, MLA_KV_RANK, MLA_HEADS, MLA_NOPE + MLA_V), MLA_KV_RANK ** -0.5),
        "mla_q_gain_nope": gain(ks[11], MLA_NOPE),
        "mla_q_gain_rope": gain(ks[12], MLA_ROPE // 2),
        "mla_k_gain_nope": gain(ks[13], MLA_NOPE),
        "mla_k_gain_rope": gain(ks[14], MLA_ROPE // 2),
        "gla_w_a2": nrm(ks[15], (DEPTH, GLA_GATE_RANK, GLA_HEADS * GLA_DK), GLA_GATE_RANK ** -0.5),
        "gla_b_a": nrm(ks[16], (DEPTH, GLA_HEADS * GLA_DK), 0.1),
        "gla_norm_g": gain(ks[17], GLA_DV),
        "w_o": nrm(ks[18], (DEPTH, D_MODEL, D_MODEL), D_MODEL ** -0.5),
        "norm_ffn_g": gain(ks[19], D_MODEL),
        "ffn_w_up": nrm(ks[20], (DEPTH, D_MODEL, D_FF), D_MODEL ** -0.5),
        "ffn_w_down": nrm(ks[21], (DEPTH, D_FF, D_MODEL), D_FF ** -0.5),
    }


def reference(x_prompt, x_sample, cache_mla_ckv, cache_mla_krope, state_gla,
              norm_mix_g, w_in, mla_q_norm_g, mla_w_uq, mla_kv_norm_g, mla_w_ukv,
              mla_q_gain_nope, mla_q_gain_rope, mla_k_gain_nope, mla_k_gain_rope,
              gla_w_a2, gla_b_a, gla_norm_g, w_o, norm_ffn_g, ffn_w_up, ffn_w_down):
    past_len = cache_mla_ckv.shape[2]
    pos_p = jnp.arange(x_prompt.shape[1], dtype=jnp.float32)
    pos_s = past_len + jnp.arange(x_sample.shape[1], dtype=jnp.float32)
    xp, xs = x_prompt, x_sample
    ckv_p, kr_p, st_p, ckv_s, kr_s, st_s = [], [], [], [], [], []
    for l in range(DEPTH):
        front_w = (norm_mix_g[l], w_in[l], mla_q_norm_g[l], mla_w_uq[l], mla_kv_norm_g[l],
                   mla_q_gain_nope[l], mla_q_gain_rope[l], mla_k_gain_nope[l], mla_k_gain_rope[l],
                   gla_w_a2[l], gla_b_a[l])
        back_w = (gla_norm_g[l], w_o[l], norm_ffn_g[l], ffn_w_up[l], ffn_w_down[l])

        qn, qr, ckv, kr, gq, gk, gv, la, og, gm, gg = _front(xp, pos_p, *front_w)
        kn, v, inv_k = _mla_keys(ckv, kr, mla_w_ukv[l])
        o_mla = _mla_prompt_attention(qn, qr, kn, kr, v, inv_k)
        s0 = jnp.zeros((xp.shape[0], GLA_HEADS, GLA_DK, GLA_DV), jnp.float32)
        o_gla, s_new = _gla_chunked(gq, gk, gv, la, s0)
        xp_next = _back(xp, o_mla, o_gla, og, gm, gg, *back_w)
        ckv_p.append(ckv)
        kr_p.append(kr)
        st_p.append(s_new.astype(xp.dtype))
        xp = xp_next

        qn, qr, ckv, kr, gq, gk, gv, la, og, gm, gg = _front(xs, pos_s, *front_w)
        ckv_all = jnp.concatenate([cache_mla_ckv[l], ckv], axis=1)
        kr_all = jnp.concatenate([cache_mla_krope[l], kr], axis=1)
        kn, v, inv_k = _mla_keys(ckv_all, kr_all, mla_w_ukv[l])
        o_mla = _attend(qn, qr, kn, kr_all, v, inv_k, None).reshape(xs.shape[0], xs.shape[1], MLA_HEADS * MLA_V)
        o_gla, s_new = _gla_chunked(gq, gk, gv, la, state_gla[l])
        xs_next = _back(xs, o_mla, o_gla, og, gm, gg, *back_w)
        ckv_s.append(ckv)
        kr_s.append(kr)
        st_s.append(s_new.astype(state_gla.dtype))
        xs = xs_next
    return (xp, xs, jnp.stack(ckv_p), jnp.stack(kr_p), jnp.stack(st_p),
            jnp.stack(ckv_s), jnp.stack(kr_s), jnp.stack(st_s))
```

```cpp
#include <hip/hip_runtime.h>
#include <hip/hip_bf16.h>
#include <cstdio>
#include <cstdint>

#define LAS __attribute__((address_space(3)))
#define GAS __attribute__((address_space(1)))
typedef unsigned short bf16_t;
typedef short bf16x8 __attribute__((ext_vector_type(8)));
typedef short s16x4 __attribute__((ext_vector_type(4)));
typedef float f32x4 __attribute__((ext_vector_type(4)));
typedef float f32x2 __attribute__((ext_vector_type(2)));
typedef float f32x16 __attribute__((ext_vector_type(16)));
typedef unsigned u32x4 __attribute__((ext_vector_type(4)));
typedef unsigned u32x2 __attribute__((ext_vector_type(2)));

constexpr int DM = 2048, SEQ = 8192, NSAMP = 256, NTOK = 8448, NZ = 11520, DFF = 8192, DIN = 11344;
constexpr int NH = 16, QKD = 192, NOPE = 128, ROPE = 64, VD = 128, QR = 512, KVR = 512;
constexpr int GH = 4, GDK = 256, GDV = 512, GC = 256, NCH = 32;
constexpr int PAST = 2048, NKEY = 2064, NKP = 2304, DQC = 640, DECB = 16, DECS = 16;
constexpr float EPS = 1e-6f;
constexpr float LOG2E = 1.4426950408889634f;
constexpr float MLA_SCALE = 0.07216878364870322f;

constexpr size_t MiB = 1u << 20;
constexpr size_t WS_CTL = 0, CTL_BYTES = 1 * MiB;
constexpr size_t WS_FSM = 1 * MiB;
constexpr size_t WS_WSM = 7 * MiB;
constexpr size_t WS_ZL = 30 * MiB, WS_ZM = 47 * MiB, WS_ZQK = 52 * MiB, WS_ZV = 85 * MiB, WS_ZOG = 118 * MiB, WS_ZGM = 151 * MiB, WS_ZGG = 184 * MiB;
constexpr size_t WS_R1 = 217 * MiB, WS_R2 = 267 * MiB, WS_R3 = 300 * MiB, WS_R4 = 345 * MiB, WS_R5 = 381 * MiB, WS_END = 413 * MiB;
constexpr size_t F_SSQ_QL = 0, F_SSQ_KV = 8448, F_SSQ_X1 = 16896, F_KRSS = 25344, F_SSQ_QH = 33792, F_SSQ_K = F_SSQ_QH + 135168, F_SSQ_OG = F_SSQ_K + 135168,
                 F_KNSS_C = F_SSQ_OG + 33792, F_KRSS_C = F_KNSS_C + 589824, F_GAMMA = F_KRSS_C + 36864, F_ZERO_END = F_GAMMA, F_ROPE = F_GAMMA + 32768, F_END = F_ROPE + 524288;
static_assert(F_END * 4 <= 6 * MiB, "FSM");
constexpr size_t W_UQ = 0, W_UKVG = W_UQ + 3072 * 512, W_KNP = W_UKVG + 4096 * 512, W_VP = W_KNP + 2048 * 512, W_KNABS = W_VP + 2048 * 512, W_O = W_KNABS + 16 * 512 * 256, W_END = W_O + 2048 * 2048;
static_assert(W_END * 2 <= 23 * MiB, "WSM");
constexpr size_t O_Y = 0, O_CKVP = 17301504, O_KRP = 21495808, O_STP = 22020096, O_CKVS = 22544384, O_KRS = 22675456, O_STS = 22691840, O_END = 31080448;

#define RLX_AGENT __ATOMIC_RELAXED, __HIP_MEMORY_SCOPE_AGENT
__device__ __forceinline__ unsigned cvt_pk_bf16(float lo, float hi) { unsigned r; asm volatile("v_cvt_pk_bf16_f32 %0, %1, %2" : "=v"(r) : "v"(lo), "v"(hi)); return r; }
__device__ __forceinline__ float bf2f(unsigned short b) { return __uint_as_float(((unsigned)b) << 16); }
__device__ __forceinline__ float bflo(unsigned w) { return __uint_as_float(w << 16); }
__device__ __forceinline__ float bfhi(unsigned w) { return __uint_as_float(w & 0xffff0000u); }
__device__ __forceinline__ unsigned short f2bf(float f) { return (unsigned short)(cvt_pk_bf16(f, 0.f) & 0xffffu); }
__device__ __forceinline__ float sigmoidf_(float x) { return 1.f / (1.f + __expf(-x)); }
__device__ __forceinline__ float wave_sum(float v) {
#pragma unroll
    for (int o = 1; o < 64; o <<= 1) v += __shfl_xor(v, o);
    return v;
}
__device__ __forceinline__ float wave_max(float v) {
#pragma unroll
    for (int o = 1; o < 64; o <<= 1) v = fmaxf(v, __shfl_xor(v, o));
    return v;
}

#define XB_TMO      128
#define XB_XCNT(j)  (256  + 64 * (j))
#define XB_XSUB(j)  (1280 + 64 * (j))
#define XB_XGEN(j)  (2304 + 64 * (j))
#define XB_TOP      3328
#define XB_TOPGEN   3392
#define XCD_BAR_WORDS 3456
#define XB_SPIN_CAP (1u << 22)
__device__ __forceinline__ unsigned xb_ld(unsigned* p)              { return __hip_atomic_load(p, __ATOMIC_RELAXED, __HIP_MEMORY_SCOPE_AGENT); }
__device__ __forceinline__ unsigned xb_add(unsigned* p, unsigned v) { return __hip_atomic_fetch_add(p, v, __ATOMIC_RELAXED, __HIP_MEMORY_SCOPE_AGENT); }
__device__ __forceinline__ unsigned xb_xcc_id() { return (unsigned)__builtin_amdgcn_s_getreg((3 << 11) | 20) & 0xFu; }
#define XB_SPIN(cond, bar) do { unsigned _sp = 0; while (cond) { __builtin_amdgcn_s_sleep(1); \
    if ((++_sp & 255u) == 0u) { if (xb_ld(&(bar)[XB_TMO])) break; if (_sp > XB_SPIN_CAP) { atomicAdd(&(bar)[XB_TMO], 1u); break; } } } } while (0)
struct XcdBarrier { unsigned* bar; unsigned x; volatile LAS unsigned* st; };
__device__ __forceinline__ XcdBarrier xcd_barrier_post(unsigned* bar, volatile LAS unsigned* st) {
    XcdBarrier b; b.bar = bar; b.x = xb_xcc_id(); b.st = st;
    if (threadIdx.x == 0) (void)xb_add(&bar[XB_XCNT(b.x)], 1u);
    return b;
}
__device__ __forceinline__ void xcd_barrier_complete(unsigned* bar, unsigned x, unsigned& nloc, unsigned& nx) {
    const unsigned G = gridDim.x * gridDim.y * gridDim.z;
    unsigned sum, cnt, mine, sp = 0u;
    for (;;) {
        sum = 0u; cnt = 0u; mine = 0u;
#pragma unroll
        for (unsigned j = 0; j < 16; ++j) { const unsigned c = xb_ld(&bar[XB_XCNT(j)]); sum += c; cnt += (c > 0u) ? 1u : 0u; mine = (j == x) ? c : mine; }
        if (sum == G) break;
        __builtin_amdgcn_s_sleep(1);
        if ((++sp & 255u) == 0u) { if (xb_ld(&bar[XB_TMO])) break; if (sp > XB_SPIN_CAP) { atomicAdd(&bar[XB_TMO], 1u); break; } }
    }
    nloc = mine > 0u ? mine : 1u; nx = cnt > 0u ? cnt : 1u;
}
__device__ __forceinline__ void xcd_barrier(const XcdBarrier& b) {
    asm volatile("s_waitcnt vmcnt(0)" ::: "memory");
    __syncthreads();
    if (threadIdx.x == 0) {
        unsigned* bar = b.bar;
        __builtin_amdgcn_s_waitcnt(0);
        unsigned nloc = b.st[0], nx = b.st[1];
        if (nloc == 0u) { xcd_barrier_complete(bar, b.x, nloc, nx); b.st[0] = nloc; b.st[1] = nx; }
        const unsigned old = xb_add(&bar[XB_XSUB(b.x)], 1u);
        const unsigned gen = old / nloc;
        if (old + 1u == (gen + 1u) * nloc) {
            __builtin_amdgcn_fence(__ATOMIC_RELEASE, "agent");
            asm volatile("s_waitcnt vmcnt(0)" ::: "memory");
            const unsigned og = xb_add(&bar[XB_TOP], 1u);
            const unsigned tg = og / nx;
            if (og + 1u == (tg + 1u) * nx) xb_add(&bar[XB_TOPGEN], 1u);
            else XB_SPIN(xb_ld(&bar[XB_TOPGEN]) == tg, bar);
            __builtin_amdgcn_fence(__ATOMIC_ACQUIRE, "agent");
            xb_add(&bar[XB_XGEN(b.x)], 1u);
            asm volatile("s_waitcnt vmcnt(0)" ::: "memory");
        } else {
            XB_SPIN(xb_ld(&bar[XB_XGEN(b.x)]) == gen, bar);
            __builtin_amdgcn_fence(__ATOMIC_ACQUIRE, "agent");
            asm volatile("s_waitcnt vmcnt(0)" ::: "memory");
        }
    }
    __syncthreads();
}

constexpr int RING_BYTES = 131072, LDSCTL_OFF = RING_BYTES, MISC_OFF = LDSCTL_OFF + 320, LDS_BYTES = 147456;

struct Frame {
    LAS unsigned char* lds; unsigned char* ws; float* out; const float* const* in;
    int tid, lane, wave, vcu, G;
};

namespace pg8 {
constexpr int BM = 256, BK = 64, HALF = 128, HTB = HALF * BK * 2, STAGE_BYTES = 8 * HTB;
__device__ __forceinline__ int lds_byte(int r, int c) { const int st = (r >> 4) * 2 + (c >> 5), rr = r & 15, cc = c & 31, ob = rr * 64 + cc * 2; return st * 1024 + (ob ^ (((ob >> 9) & 1) << 5)); }
__device__ __forceinline__ void stage_rc(int b, int& R, int& C) { const int st = b / 1024, sb = b % 1024, swz = sb ^ (((sb >> 9) & 1) << 5); R = (st >> 1) * 16 + swz / 64; C = (st & 1) * 32 + (swz % 64) / 2; }
__device__ __forceinline__ int perm32(int rho) { const int n = rho >> 4, i = rho & 15; return 8 * (i >> 2) + 4 * n + (i & 3); }

struct GUnit { const char* A; const char* B; ptrdiff_t dA, dB; int pm, pn, aux; };
struct GCfg { unsigned lda, ldb; int nt, t1; };

typedef f32x4 Acc[2][2][4][2];

template <class Epi, class Sched>
__device__ __forceinline__ void gemm_phase(LAS unsigned char* lds, const GCfg g, const Sched& S, const Epi& E) {
    int tid_ = threadIdx.x; asm volatile("" : "+v"(tid_));
    const int tid = tid_, wid = __builtin_amdgcn_readfirstlane(tid >> 6), lane = tid & 63, wr = wid >> 2, wc = wid & 3, fr = lane & 15, fq = lane >> 4;
    const int nt = g.nt, t1 = g.t1;
    unsigned voffA[2], voffB[2];
#pragma unroll
    for (int i = 0; i < 2; ++i) { int R, C; stage_rc(tid * 16 + i * 8192, R, C); const int Rb = (R & ~31) + perm32(R & 31);
        voffA[i] = (unsigned)R * g.lda + (unsigned)C * 2u; voffB[i] = (unsigned)Rb * g.ldb + (unsigned)C * 2u; }
    const size_t kstep = (size_t)(BK * 2);
    const size_t hstepA = (size_t)HALF * g.lda, hstepB = (size_t)HALF * g.ldb;
    const unsigned ldsw = (unsigned)wid * 1024u;
    const int aoff = lds_byte(wr * 64 + fr, fq * 8), boff = lds_byte(wc * 32 + fr, fq * 8);
#define PG8_SA(b, h) (((b) * 2 + (h)) * HTB)
#define PG8_SB(b, h) ((4 + (b) * 2 + (h)) * HTB)
#define PG8_STAGE(bufoff, gbase, voff) do { _Pragma("unroll") for (int _i = 0; _i < 2; ++_i) \
        __builtin_amdgcn_global_load_lds((const unsigned*)((const char*)(gbase) + (voff)[_i]), (LAS unsigned*)(lds + (bufoff) + ldsw + _i * 8192), 16, 0, 0); } while (0)
#define PG8_LDA(dst, b, h) do { _Pragma("unroll") for (int m = 0; m < 4; ++m) _Pragma("unroll") for (int k = 0; k < 2; ++k) dst[m][k] = *(const LAS bf16x8*)(lds + PG8_SA(b, h) + aoff + m * 2048 + k * 1024); } while (0)
#define PG8_LDB(dst, b, h) do { _Pragma("unroll") for (int n = 0; n < 2; ++n) _Pragma("unroll") for (int k = 0; k < 2; ++k) dst[n][k] = *(const LAS bf16x8*)(lds + PG8_SB(b, h) + boff + n * 2048 + k * 1024); } while (0)
#define PG8_MMA(ai, bj, At, Bt) do { __builtin_amdgcn_s_setprio(1); _Pragma("unroll") for (int m = 0; m < 4; ++m) _Pragma("unroll") for (int n = 0; n < 2; ++n) _Pragma("unroll") for (int k = 0; k < 2; ++k) \
        acc[ai][bj][m][n] = __builtin_amdgcn_mfma_f32_16x16x32_bf16(Bt[n][k], At[m][k], acc[ai][bj][m][n], 0, 0, 0); __builtin_amdgcn_s_setprio(0); } while (0)
#define PG8_WAIT_V(n) asm volatile("s_waitcnt vmcnt(" #n ")" ::: "memory")
#define PG8_WAIT_L(n) asm volatile("s_waitcnt lgkmcnt(" #n ")" ::: "memory")
#define PG8_BAR __builtin_amdgcn_s_barrier()
#define PG8_SCHED __builtin_amdgcn_sched_barrier(0)
#define PG8_APTR(u, t) ((u).A + (ptrdiff_t)(t) * (ptrdiff_t)kstep + (((t) >= t1) ? (u).dA : (ptrdiff_t)0))
#define PG8_BPTR(u, t) ((u).B + (ptrdiff_t)(t) * (ptrdiff_t)kstep + (((t) >= t1) ? (u).dB : (ptrdiff_t)0))
    GUnit cur, nxt; int ui = 0;
    if (!S.next(0, cur)) return;
    Acc acc;
#pragma unroll
    for (int a = 0; a < 2; ++a)
#pragma unroll
        for (int b = 0; b < 2; ++b)
#pragma unroll
            for (int m = 0; m < 4; ++m)
#pragma unroll
                for (int n = 0; n < 2; ++n) acc[a][b][m][n] = (f32x4){0.f, 0.f, 0.f, 0.f};
    bf16x8 At[4][2], B0[2][2], B1[2][2];
    {
        const char* cA = cur.A; const char* cB = cur.B;
        PG8_STAGE(PG8_SB(0, 0), cB, voffB); PG8_STAGE(PG8_SB(0, 1), cB + hstepB, voffB); PG8_STAGE(PG8_SA(0, 0), cA, voffA); PG8_STAGE(PG8_SA(0, 1), cA + hstepA, voffA);
        if (wr == 1) PG8_BAR;
        PG8_WAIT_V(2); PG8_BAR;
        PG8_STAGE(PG8_SB(1, 0), cB + kstep, voffB); PG8_STAGE(PG8_SA(1, 0), cA + kstep, voffA); PG8_STAGE(PG8_SB(1, 1), cB + hstepB + kstep, voffB);
        PG8_WAIT_V(6); PG8_BAR;
    }
    for (;;) {
        const bool has_next = S.next(ui + 1, nxt);
        if (!has_next) nxt = cur;
        for (int t = 0; t < nt; t += 2) {
            const bool last = (t == nt - 2);
            const char* a1 = PG8_APTR(cur, t + 1);
            const char* a2 = last ? nxt.A : PG8_APTR(cur, t + 2); const char* b2 = last ? nxt.B : PG8_BPTR(cur, t + 2);
            const char* a3 = last ? nxt.A + kstep : PG8_APTR(cur, t + 3); const char* b3 = last ? nxt.B + kstep : PG8_BPTR(cur, t + 3);
            PG8_LDB(B0, 0, 0); PG8_LDB(B1, 0, 1); PG8_SCHED; PG8_LDA(At, 0, 0); PG8_STAGE(PG8_SA(1, 1), a1 + hstepA, voffA);
            PG8_WAIT_V(8); PG8_WAIT_L(0); PG8_BAR; PG8_MMA(0, 0, At, B0); PG8_MMA(0, 1, At, B1); PG8_BAR; PG8_SCHED;
            PG8_LDA(At, 0, 1); PG8_STAGE(PG8_SB(0, 0), b2, voffB); PG8_STAGE(PG8_SB(0, 1), b2 + hstepB, voffB); PG8_STAGE(PG8_SA(0, 0), a2, voffA);
            PG8_WAIT_V(8); PG8_WAIT_L(0); PG8_BAR; PG8_MMA(1, 0, At, B0); PG8_MMA(1, 1, At, B1); PG8_BAR; PG8_SCHED;
            PG8_LDB(B0, 1, 0); PG8_LDB(B1, 1, 1); PG8_SCHED; PG8_LDA(At, 1, 0); PG8_STAGE(PG8_SA(0, 1), a2 + hstepA, voffA);
            PG8_WAIT_V(8); PG8_WAIT_L(0); PG8_BAR; PG8_MMA(0, 0, At, B0); PG8_MMA(0, 1, At, B1); PG8_BAR; PG8_SCHED;
            PG8_LDA(At, 1, 1); PG8_STAGE(PG8_SB(1, 0), b3, voffB); PG8_STAGE(PG8_SB(1, 1), b3 + hstepB, voffB); PG8_STAGE(PG8_SA(1, 0), a3, voffA);
            PG8_WAIT_V(8); PG8_WAIT_L(0); PG8_BAR; PG8_MMA(1, 0, At, B0); PG8_MMA(1, 1, At, B1); PG8_BAR; PG8_SCHED;
        }
        if (wr == 0) PG8_BAR;
        { int fr_ = fr, fq_ = fq; asm volatile("" : "+v"(fr_), "+v"(fq_));
          E(acc, cur, wr, wc, fr_, fq_); }
        if (!has_next) break;
#pragma unroll
        for (int a = 0; a < 2; ++a)
#pragma unroll
            for (int b = 0; b < 2; ++b)
#pragma unroll
                for (int m = 0; m < 4; ++m)
#pragma unroll
                    for (int n = 0; n < 2; ++n) acc[a][b][m][n] = (f32x4){0.f, 0.f, 0.f, 0.f};
        cur = nxt; ++ui;
        if (wr == 1) PG8_BAR;
    }
    PG8_WAIT_V(0);
    PG8_BAR;
#undef PG8_SA
#undef PG8_SB
#undef PG8_STAGE
#undef PG8_LDA
#undef PG8_LDB
#undef PG8_MMA
#undef PG8_WAIT_V
#undef PG8_WAIT_L
#undef PG8_BAR
#undef PG8_SCHED
#undef PG8_APTR
#undef PG8_BPTR
}

__device__ __forceinline__ void tile_of(int L, int nM, int nN, int& pm, int& pn) {
    const int nig = 8 * nN, gid = L / nig, fm = gid * 8, gsz = (nM - fm) < 8 ? (nM - fm) : 8, r = L % nig;
    pm = fm + r % gsz; pn = r / gsz;
}
}

enum { M_INPROJ = 0, M_QUP, M_KVUP, M_CNORM, M_QABS, M_S, M_PC, M_O, M_GLA_A, M_GLA_DS, M_GLA_O, M_WO, M_UP, M_DOWN };

struct EP { unsigned char* ws; float* out; const float* xp; const float* xs; };

__device__ __forceinline__ u32x4 pack8(const f32x4 v0, const f32x4 v1) {
    u32x4 w; w.x = cvt_pk_bf16(v0[0], v0[1]); w.y = cvt_pk_bf16(v0[2], v0[3]); w.z = cvt_pk_bf16(v1[0], v1[1]); w.w = cvt_pk_bf16(v1[2], v1[3]); return w;
}
__device__ __forceinline__ float sumsq8(const f32x4 a, const f32x4 b) {
    return (a[0] * a[0] + a[1] * a[1]) + (a[2] * a[2] + a[3] * a[3]) + (b[0] * b[0] + b[1] * b[1]) + (b[2] * b[2] + b[3] * b[3]);
}
__device__ __forceinline__ float red_fq(float s) { s += __shfl_xor(s, 16); s += __shfl_xor(s, 32); return s; }

template <int MODE> struct Epi {
    EP p;
    __device__ __forceinline__ void operator()(const pg8::Acc& acc, const pg8::GUnit& u, int wr, int wc, int fr, int fq) const {
        unsigned char* ws = p.ws;
        float* fsm = (float*)(ws + WS_FSM);
        const int rt0 = wr * 64 + fr;
        const int ct0 = wc * 32 + 8 * fq;
        if constexpr (MODE == M_INPROJ) {
            const int pn = u.pn; bf16_t* base; int ld;
            if (pn < 4) { base = (bf16_t*)(ws + WS_ZL) + pn * 256; ld = 1024; }
            else if (pn < 12) { base = (bf16_t*)(ws + WS_ZQK) + (pn - 4) * 256; ld = 2048; }
            else if (pn < 20) { base = (bf16_t*)(ws + WS_ZV) + (pn - 12) * 256; ld = 2048; }
            else if (pn < 28) { base = (bf16_t*)(ws + WS_ZOG) + (pn - 20) * 256; ld = 2048; }
            else if (pn < 36) { base = (bf16_t*)(ws + WS_ZGM) + (pn - 28) * 256; ld = 2048; }
            else if (pn < 44) { base = (bf16_t*)(ws + WS_ZGG) + (pn - 36) * 256; ld = 2048; }
            else { base = (bf16_t*)(ws + WS_ZM); ld = 256; }
            float* ssq = fsm + (pn < 2 ? F_SSQ_QL : F_SSQ_KV);
#pragma unroll
            for (int ai = 0; ai < 2; ++ai)
#pragma unroll
                for (int m = 0; m < 4; ++m) {
                    const int row = u.pm * 256 + rt0 + ai * 128 + m * 16;
                    bf16_t* rowp = base + (size_t)row * ld + ct0;
                    *(u32x4*)(rowp) = pack8(acc[ai][0][m][0], acc[ai][0][m][1]);
                    *(u32x4*)(rowp + 128) = pack8(acc[ai][1][m][0], acc[ai][1][m][1]);
                    if (pn < 4) {
                        float s = sumsq8(acc[ai][0][m][0], acc[ai][0][m][1]) + sumsq8(acc[ai][1][m][0], acc[ai][1][m][1]);
                        s = red_fq(s);
                        if (fq == 0) atomicAdd(ssq + row, s);
                    }
                }
        } else if constexpr (MODE == M_QUP) {
            bf16_t* Qp = (bf16_t*)(ws + WS_R1);
            float* ssq = fsm + F_SSQ_QH;
#pragma unroll
            for (int bj = 0; bj < 2; ++bj) {
                const int c = u.pn * 256 + bj * 128 + ct0, h = c / 192, j = c - h * 192;
                const int hw = (u.pn * 256 + bj * 128 + wc * 32) / 192;
#pragma unroll
                for (int ai = 0; ai < 2; ++ai)
#pragma unroll
                    for (int m = 0; m < 4; ++m) {
                        const int row = u.pm * 256 + rt0 + ai * 128 + m * 16;
                        *(u32x4*)(Qp + ((size_t)h * NTOK + row) * 192 + j) = pack8(acc[ai][bj][m][0], acc[ai][bj][m][1]);
                        float s = red_fq(sumsq8(acc[ai][bj][m][0], acc[ai][bj][m][1]));
                        if (fq == 0) atomicAdd(ssq + (size_t)row * 16 + hw, s);
                    }
            }
        } else if constexpr (MODE == M_KVUP) {
            bf16_t* Kp = (bf16_t*)(p.out + O_Y); bf16_t* Vp = (bf16_t*)(ws + WS_R2);
            const float* ssq_kv = fsm + F_SSQ_KV; float* ssq_k = fsm + F_SSQ_K;
            const int h = u.pn;
#pragma unroll
            for (int ai = 0; ai < 2; ++ai)
#pragma unroll
                for (int m = 0; m < 4; ++m) {
                    const int row = u.pm * 256 + rt0 + ai * 128 + m * 16;
                    const float inv = rsqrtf(ssq_kv[row] * (1.f / 512.f) + EPS);
                    const f32x4 k0 = acc[ai][0][m][0] * inv, k1 = acc[ai][0][m][1] * inv, v0 = acc[ai][1][m][0] * inv, v1 = acc[ai][1][m][1] * inv;
                    if (row < SEQ) {
                        *(u32x4*)(Kp + ((size_t)h * SEQ + row) * 192 + ct0) = pack8(k0, k1);
                        *(u32x4*)(Vp + ((size_t)h * SEQ + row) * 128 + ct0) = pack8(v0, v1);
                    }
                    float s = red_fq(sumsq8(k0, k1));
                    if (fq == 0) atomicAdd(ssq_k + (size_t)row * 16 + h, s);
                }
        } else if constexpr (MODE == M_CNORM) {
            float* knss = fsm + F_KNSS_C;
#pragma unroll
            for (int bj = 0; bj < 2; ++bj)
#pragma unroll
                for (int ai = 0; ai < 2; ++ai)
#pragma unroll
                    for (int m = 0; m < 4; ++m) {
                        const int row = u.pm * 256 + rt0 + ai * 128 + m * 16;
                        float s = red_fq(sumsq8(acc[ai][bj][m][0], acc[ai][bj][m][1]));
                        if (fq == 0) atomicAdd(knss + (size_t)row * 16 + u.pn * 2 + bj, s);
                    }
        } else if constexpr (MODE == M_QABS) {
            bf16_t* Qcat = (bf16_t*)(p.out + O_Y) + 48 * MiB / 2;
            const int h = u.aux;
#pragma unroll
            for (int ai = 0; ai < 2; ++ai)
#pragma unroll
                for (int m = 0; m < 4; ++m) {
                    const int r = rt0 + ai * 128 + m * 16, b = r >> 4, q = r & 15;
                    bf16_t* rowp = Qcat + ((size_t)b * 256 + h * 16 + q) * DQC + u.pn * 256 + ct0;
                    *(u32x4*)(rowp) = pack8(acc[ai][0][m][0], acc[ai][0][m][1]);
                    *(u32x4*)(rowp + 128) = pack8(acc[ai][1][m][0], acc[ai][1][m][1]);
                }
        } else if constexpr (MODE == M_S) {
            float* Sb = p.out + O_Y;
            const float* knss = fsm + F_KNSS_C; const float* krss = fsm + F_KRSS_C;
            const int b = u.aux;
#pragma unroll
            for (int ai = 0; ai < 2; ++ai)
#pragma unroll
                for (int m = 0; m < 4; ++m) {
                    const int r = rt0 + ai * 128 + m * 16, h = r >> 4;
#pragma unroll
                    for (int bj = 0; bj < 2; ++bj) {
                        const int k = u.pn * 256 + bj * 128 + ct0;
                        const size_t kr = (size_t)b * NKP + k;
                        f32x4 o0, o1;
#pragma unroll
                        for (int i = 0; i < 4; ++i) {
                            o0[i] = acc[ai][bj][m][0][i] * rsqrtf((knss[(kr + i) * 16 + h] + krss[kr + i]) * (1.f / 192.f) + EPS);
                            o1[i] = acc[ai][bj][m][1][i] * rsqrtf((knss[(kr + 4 + i) * 16 + h] + krss[kr + 4 + i]) * (1.f / 192.f) + EPS);
                        }
                        float* dst = Sb + ((size_t)b * 256 + r) * NKP + k;
                        *(f32x4*)dst = o0; *(f32x4*)(dst + 4) = o1;
                        asm volatile("" ::: "memory");
                    }
                }
        } else if constexpr (MODE == M_PC) {
            float* PCp = (float*)(ws + WS_R1);
            const int b = u.aux >> 2, ks = u.aux & 3;
#pragma unroll
            for (int ai = 0; ai < 2; ++ai)
#pragma unroll
                for (int m = 0; m < 4; ++m) {
                    const int r = rt0 + ai * 128 + m * 16, h = r >> 4, q = r & 15;
                    float* rowp = PCp + (((size_t)ks * 16 + h) * 256 + b * 16 + q) * 512 + u.pn * 256 + ct0;
#pragma unroll
                    for (int bj = 0; bj < 2; ++bj) { *(f32x4*)(rowp + bj * 128) = acc[ai][bj][m][0]; *(f32x4*)(rowp + bj * 128 + 4) = acc[ai][bj][m][1]; }
                }
        } else if constexpr (MODE == M_O) {
            bf16_t* Zgm = (bf16_t*)(ws + WS_ZGM);
            const int h = u.aux, bj = h & 1;
#pragma unroll
            for (int ai = 0; ai < 2; ++ai)
#pragma unroll
                for (int m = 0; m < 4; ++m) {
                    const int r = rt0 + ai * 128 + m * 16;
                    bf16_t* gp = Zgm + (size_t)(SEQ + r) * 2048 + h * 128 + ct0;
                    const u32x4 g = *(const u32x4*)gp;
                    const f32x4 a0 = bj ? acc[ai][1][m][0] : acc[ai][0][m][0], a1 = bj ? acc[ai][1][m][1] : acc[ai][0][m][1];
                    f32x4 o0, o1;
                    o0[0] = a0[0] * sigmoidf_(bflo(g.x)); o0[1] = a0[1] * sigmoidf_(bfhi(g.x)); o0[2] = a0[2] * sigmoidf_(bflo(g.y)); o0[3] = a0[3] * sigmoidf_(bfhi(g.y));
                    o1[0] = a1[0] * sigmoidf_(bflo(g.z)); o1[1] = a1[1] * sigmoidf_(bfhi(g.z)); o1[2] = a1[2] * sigmoidf_(bflo(g.w)); o1[3] = a1[3] * sigmoidf_(bfhi(g.w));
                    *(u32x4*)gp = pack8(o0, o1);
                }
        } else if constexpr (MODE == M_GLA_A) {
            bf16_t* Am = (bf16_t*)(ws + WS_ZQK) + (size_t)u.aux * 65536;
#pragma unroll
            for (int ai = 0; ai < 2; ++ai)
#pragma unroll
                for (int m = 0; m < 4; ++m) {
                    const int t = rt0 + ai * 128 + m * 16;
#pragma unroll
                    for (int bj = 0; bj < 2; ++bj) {
                        const int s0 = bj * 128 + ct0;
                        f32x4 a0 = acc[ai][bj][m][0], a1 = acc[ai][bj][m][1];
#pragma unroll
                        for (int i = 0; i < 4; ++i) { if (s0 + i > t) a0[i] = 0.f; if (s0 + 4 + i > t) a1[i] = 0.f; }
                        *(u32x4*)(Am + (size_t)t * 256 + s0) = pack8(a0, a1);
                        asm volatile("" ::: "memory");
                    }
                }
        } else if constexpr (MODE == M_GLA_DS) {
            bf16_t* dS = (bf16_t*)(ws + WS_R1) + (size_t)u.aux * 131072;
#pragma unroll
            for (int ai = 0; ai < 2; ++ai)
#pragma unroll
                for (int m = 0; m < 4; ++m) {
                    const int e = u.pm * 256 + rt0 + ai * 128 + m * 16;
                    bf16_t* rowp = dS + (size_t)e * 256 + ct0;
                    *(u32x4*)(rowp) = pack8(acc[ai][0][m][0], acc[ai][0][m][1]);
                    *(u32x4*)(rowp + 128) = pack8(acc[ai][1][m][0], acc[ai][1][m][1]);
                }
        } else if constexpr (MODE == M_GLA_O) {
            bf16_t* Zv = (bf16_t*)(ws + WS_ZV); float* ssq = fsm + F_SSQ_OG;
            const int h = u.aux >> 5, c = u.aux & 31;
#pragma unroll
            for (int ai = 0; ai < 2; ++ai)
#pragma unroll
                for (int m = 0; m < 4; ++m) {
                    const int t = c * 256 + rt0 + ai * 128 + m * 16;
                    bf16_t* rowp = Zv + (size_t)t * 2048 + h * 512 + u.pn * 256 + ct0;
                    *(u32x4*)(rowp) = pack8(acc[ai][0][m][0], acc[ai][0][m][1]);
                    *(u32x4*)(rowp + 128) = pack8(acc[ai][1][m][0], acc[ai][1][m][1]);
                    float s = red_fq(sumsq8(acc[ai][0][m][0], acc[ai][0][m][1]) + sumsq8(acc[ai][1][m][0], acc[ai][1][m][1]));
                    if (fq == 0) atomicAdd(ssq + (size_t)t * 4 + h, s);
                }
        } else if constexpr (MODE == M_WO) {
            float* Y = p.out + O_Y; bf16_t* x1b = (bf16_t*)(ws + WS_R2); float* ssq = fsm + F_SSQ_X1;
#pragma unroll
            for (int ai = 0; ai < 2; ++ai)
#pragma unroll
                for (int m = 0; m < 4; ++m) {
                    const int row = u.pm * 256 + rt0 + ai * 128 + m * 16;
                    const float* xr = (row < SEQ ? p.xp + (size_t)row * DM : p.xs + (size_t)(row - SEQ) * DM) + u.pn * 256 + ct0;
                    float s = 0.f;
#pragma unroll
                    for (int bj = 0; bj < 2; ++bj) {
                        const f32x4 x0 = *(const f32x4*)(xr + bj * 128) + acc[ai][bj][m][0], x1 = *(const f32x4*)(xr + bj * 128 + 4) + acc[ai][bj][m][1];
                        float* yp = Y + (size_t)row * DM + u.pn * 256 + bj * 128 + ct0;
                        *(f32x4*)yp = x0; *(f32x4*)(yp + 4) = x1;
                        *(u32x4*)(x1b + (size_t)row * DM + u.pn * 256 + bj * 128 + ct0) = pack8(x0, x1);
                        s += sumsq8(x0, x1);
                    }
                    s = red_fq(s);
                    if (fq == 0) atomicAdd(ssq + row, s);
                }
        } else if constexpr (MODE == M_UP) {
            bf16_t* Hb = (bf16_t*)(ws + WS_ZL); const float* ssq = fsm + F_SSQ_X1;
#pragma unroll
            for (int ai = 0; ai < 2; ++ai)
#pragma unroll
                for (int m = 0; m < 4; ++m) {
                    const int row = u.pm * 256 + rt0 + ai * 128 + m * 16;
                    const float inv2 = 1.f / (ssq[row] * (1.f / 2048.f) + EPS);
#pragma unroll
                    for (int bj = 0; bj < 2; ++bj) {
                        f32x4 a0 = acc[ai][bj][m][0], a1 = acc[ai][bj][m][1];
#pragma unroll
                        for (int i = 0; i < 4; ++i) { const float r0 = fmaxf(a0[i], 0.f), r1 = fmaxf(a1[i], 0.f); a0[i] = r0 * r0 * inv2; a1[i] = r1 * r1 * inv2; }
                        *(u32x4*)(Hb + (size_t)row * DFF + u.pn * 256 + bj * 128 + ct0) = pack8(a0, a1);
                    }
                }
        } else if constexpr (MODE == M_DOWN) {
            float* Y = p.out + O_Y;
#pragma unroll
            for (int ai = 0; ai < 2; ++ai)
#pragma unroll
                for (int m = 0; m < 4; ++m) {
                    const int row = u.pm * 256 + rt0 + ai * 128 + m * 16;
#pragma unroll
                    for (int bj = 0; bj < 2; ++bj) {
                        float* yp = Y + (size_t)row * DM + u.pn * 256 + bj * 128 + ct0;
                        const f32x4 y0 = *(const f32x4*)yp + acc[ai][bj][m][0], y1 = *(const f32x4*)(yp + 4) + acc[ai][bj][m][1];
                        *(f32x4*)yp = y0; *(f32x4*)(yp + 4) = y1;
                    }
                }
        }
    }
};

template <int MODE> struct Sched {
    unsigned char* ws; float* out; int G, c, n;
    __device__ __forceinline__ bool next(int i, pg8::GUnit& u) const {
        const int L = i * G + c; if (L >= n) return false;
        u.dA = 0; u.dB = 0; u.aux = 0;
        if constexpr (MODE == M_INPROJ) {
            pg8::tile_of(L, 33, 45, u.pm, u.pn);
            u.A = (const char*)(ws + WS_R2) + (size_t)u.pm * 256 * 4096; u.B = (const char*)(ws + WS_R1) + (size_t)u.pn * 256 * 4096;
        } else if constexpr (MODE == M_QUP) {
            pg8::tile_of(L, 33, 12, u.pm, u.pn);
            u.A = (const char*)(ws + WS_ZL) + (size_t)u.pm * 256 * 2048; u.B = (const char*)(ws + WS_WSM) + (W_UQ + (size_t)u.pn * 256 * 512) * 2;
        } else if constexpr (MODE == M_KVUP) {
            pg8::tile_of(L, 33, 16, u.pm, u.pn);
            u.A = (const char*)(ws + WS_ZL) + (size_t)u.pm * 256 * 2048 + 1024; u.B = (const char*)(ws + WS_WSM) + (W_UKVG + (size_t)u.pn * 256 * 512) * 2;
        } else if constexpr (MODE == M_CNORM) {
            pg8::tile_of(L, 144, 8, u.pm, u.pn);
            u.A = (const char*)(ws + WS_R3) + (size_t)u.pm * 256 * (DQC * 2); u.B = (const char*)(ws + WS_WSM) + (W_KNP + (size_t)u.pn * 256 * 512) * 2;
        } else if constexpr (MODE == M_QABS) {
            const int h = L >> 1; u.pm = 0; u.pn = L & 1; u.aux = h;
            u.A = (const char*)(out + O_Y) + 53 * MiB + (size_t)h * 256 * 512; u.B = (const char*)(ws + WS_WSM) + (W_KNABS + ((size_t)h * 512 + u.pn * 256) * 256) * 2;
        } else if constexpr (MODE == M_S) {
            const int b = L / 9; u.pm = 0; u.pn = L - b * 9; u.aux = b;
            u.A = (const char*)(out + O_Y) + 48 * MiB + (size_t)b * 256 * (DQC * 2); u.B = (const char*)(ws + WS_R3) + ((size_t)b * NKP + u.pn * 256) * (DQC * 2);
        } else if constexpr (MODE == M_PC) {
            const int b = L / 6, r = L - b * 6, ks = r >> 1; u.pm = 0; u.pn = r & 1; u.aux = b * 4 + ks;
            u.A = (const char*)(ws + WS_R5) + ((size_t)b * 256 * NKP + ks * 768) * 2; u.B = (const char*)(ws + WS_R4) + (((size_t)b * 512 + u.pn * 256) * NKP + ks * 768) * 2;
        } else if constexpr (MODE == M_O) {
            const int h = L; u.pm = 0; u.pn = 0; u.aux = h;
            u.A = (const char*)(ws + WS_ZQK) + 16 * MiB + (size_t)h * 256 * 1024; u.B = (const char*)(ws + WS_WSM) + (W_VP + (size_t)(h & ~1) * 128 * 512) * 2;
        } else if constexpr (MODE == M_GLA_A) {
            u.pm = 0; u.pn = 0; u.aux = L;
            u.A = (const char*)(ws + WS_ZL) + (size_t)L * 131072; u.B = (const char*)(ws + WS_R5) + (size_t)L * 131072;
        } else if constexpr (MODE == M_GLA_DS) {
            const int hc = L >> 1; u.pm = L & 1; u.pn = 0; u.aux = hc;
            u.A = (const char*)(out + O_STS) + ((size_t)hc * 512 + u.pm * 256) * 512; u.B = (const char*)(ws + WS_R5) + 16 * MiB + (size_t)hc * 131072;
        } else if constexpr (MODE == M_GLA_O) {
            const int hc = L >> 1; u.pm = 0; u.pn = L & 1; u.aux = hc;
            u.A = (const char*)(ws + WS_ZQK) + (size_t)hc * 131072; u.B = (const char*)(out + O_STS) + ((size_t)hc * 512 + u.pn * 256) * 512;
            { const char* A2 = (const char*)(ws + WS_ZL) + (size_t)hc * 131072; const char* B2 = (const char*)(ws + WS_R2) + ((size_t)hc * 512 + u.pn * 256) * 512;
              u.dA = (A2 - 4 * 128) - u.A; u.dB = (B2 - 4 * 128) - u.B; }
        } else if constexpr (MODE == M_WO) {
            pg8::tile_of(L, 33, 8, u.pm, u.pn);
            u.A = (const char*)(ws + WS_ZOG) + (size_t)u.pm * 256 * 4096; u.B = (const char*)(ws + WS_WSM) + (W_O + (size_t)u.pn * 256 * 2048) * 2;
        } else if constexpr (MODE == M_UP) {
            pg8::tile_of(L, 33, 32, u.pm, u.pn);
            u.A = (const char*)(ws + WS_R2) + (size_t)u.pm * 256 * 4096; u.B = (const char*)(ws + WS_R1) + (size_t)u.pn * 256 * 4096;
        } else if constexpr (MODE == M_DOWN) {
            pg8::tile_of(L, 33, 8, u.pm, u.pn);
            u.A = (const char*)(ws + WS_ZL) + (size_t)u.pm * 256 * 16384; u.B = (const char*)(ws + WS_R3) + (size_t)u.pn * 256 * 16384;
        }
        return true;
    }
};

template <int MODE>
__device__ __forceinline__ void run_gemm(Frame& F, const EP& ep, int n_units, unsigned lda, unsigned ldb, int nt, int t1, int& rot) {
    Sched<MODE> S; S.ws = F.ws; S.out = F.out; S.G = F.G; S.c = (F.vcu + F.G - rot) % F.G; S.n = n_units;
    Epi<MODE> E; E.p = ep;
    pg8::GCfg g; g.lda = lda; g.ldb = ldb; g.nt = nt; g.t1 = t1;
    pg8::gemm_phase<Epi<MODE>, Sched<MODE>>(F.lds, g, S, E);
    rot = (rot + n_units) % F.G;
}

namespace att {
constexpr int NW = 8, QBLK = 32, KVBLK = 64, QB = 256;
constexpr int SHM_V = KVBLK * 128 * 2, SHM_K = KVBLK * 192 * 2;
constexpr int LDS_ATT = 2 * SHM_V + 2 * SHM_K + NW * 64 * 4;
constexpr float THR = 8.f;
#define KSWZ(row, colB) ((row) * 384 + ((colB) ^ ((((row) >> 1) & 7) << 4)))
#define SBAR() __builtin_amdgcn_sched_barrier(0)
__device__ __forceinline__ int v_st(int k, int c) { const int kk = (k & ~0xC) | ((k & 4) << 1) | ((k & 8) >> 1); return ((kk >> 3) * 4 + (c >> 5)) * 512 + ((kk & 7) * 32 + (c & 31)) * 2; }
__device__ __forceinline__ int v_rd_base(int lane) { return ((lane & 3) << 3) | (((lane >> 2) & 3) << 6) | (((lane >> 4) & 1) << 5) | (((lane >> 5) & 1) << 8); }
constexpr int v_rd_off(int d0, int ks, int half) { return d0 * 512 + ks * 4096 + half * 2048; }
__device__ __forceinline__ int crow(int r, int hi) { return (r & 3) + 8 * (r >> 2) + 4 * hi; }
__device__ __forceinline__ unsigned cvtpk(float lo, float hi) { unsigned r; asm volatile("v_cvt_pk_bf16_f32 %0, %1, %2" : "=v"(r) : "v"(lo), "v"(hi)); return r; }

__device__ __forceinline__ void partialSM(f32x16& p0, f32x16& p1, float& m_reg, float& mn, float& alpha) {
    float pmax = p0[0];
#pragma unroll
    for (int r = 1; r < 16; ++r) pmax = fmaxf(pmax, p0[r]);
#pragma unroll
    for (int r = 0; r < 16; ++r) pmax = fmaxf(pmax, p1[r]);
    { auto rr = __builtin_amdgcn_permlane32_swap(__float_as_uint(pmax), __float_as_uint(pmax), false, false);
      pmax = fmaxf(__uint_as_float(rr[0]), __uint_as_float(rr[1])); }
    if (__builtin_expect(__all((pmax - m_reg) <= THR), 1)) { mn = m_reg; alpha = 1.f; }
    else { mn = fmaxf(m_reg, pmax); alpha = __builtin_amdgcn_exp2f(m_reg - mn); m_reg = mn; }
#pragma unroll
    for (int r = 0; r < 16; ++r) p0[r] = p0[r] - mn;
#pragma unroll
    for (int r = 0; r < 16; ++r) p1[r] = p1[r] - mn;
#pragma unroll
    for (int r = 0; r < 16; ++r) p0[r] = __builtin_amdgcn_exp2f(p0[r]);
}
__device__ __forceinline__ void finishSM(f32x16& p0, f32x16& p1, float alpha, float& l_reg, bf16x8& pa0, bf16x8& pa1, bf16x8& pa2, bf16x8& pa3) {
#pragma unroll
    for (int r = 0; r < 16; ++r) p1[r] = __builtin_amdgcn_exp2f(p1[r]);
    float ps = 0;
#pragma unroll
    for (int r = 0; r < 16; ++r) ps += p0[r];
#pragma unroll
    for (int r = 0; r < 16; ++r) ps += p1[r];
    { auto rr = __builtin_amdgcn_permlane32_swap(__float_as_uint(ps), __float_as_uint(ps), false, false);
      ps = __uint_as_float(rr[0]) + __uint_as_float(rr[1]); }
    l_reg = l_reg * alpha + ps;
#define PK4(P, B_, OUT) do { unsigned a0 = cvtpk(P[B_+0], P[B_+1]), a1 = cvtpk(P[B_+2], P[B_+3]);                          \
        unsigned b0 = cvtpk(P[B_+4], P[B_+5]), b1 = cvtpk(P[B_+6], P[B_+7]);                                             \
        auto r0 = __builtin_amdgcn_permlane32_swap(a0, b0, false, false); auto r1 = __builtin_amdgcn_permlane32_swap(a1, b1, false, false); \
        u32x4 w = {r0[0], r1[0], r0[1], r1[1]}; OUT = *reinterpret_cast<bf16x8*>(&w); } while (0)
    PK4(p0, 0, pa0); PK4(p0, 8, pa1); PK4(p1, 0, pa2); PK4(p1, 8, pa3);
#undef PK4
}
template <int KB>
__device__ __forceinline__ void qkt(f32x16& p0, f32x16& p1, const char* K_lds, int r32, int hi, const bf16x8* qr) {
    p0 = f32x16{}; p1 = f32x16{};
    const char* kb[4];
#pragma unroll
    for (int dd = 0; dd < 4; ++dd) kb[dd] = K_lds + KB * SHM_K + KSWZ(r32, (dd * 16 + hi * 8) * 2);
#pragma unroll
    for (int d0 = 0; d0 < 12; ++d0) { const char* a = kb[d0 & 3] + (d0 >> 2) * 128;
        bf16x8 b0 = *reinterpret_cast<const bf16x8*>(a);
        bf16x8 b1 = *reinterpret_cast<const bf16x8*>(a + 32 * 384);
        p0 = __builtin_amdgcn_mfma_f32_32x32x16_bf16(b0, qr[d0], p0, 0, 0, 0);
        p1 = __builtin_amdgcn_mfma_f32_32x32x16_bf16(b1, qr[d0], p1, 0, 0, 0); }
}
template <int VB>
__device__ __forceinline__ void pv_tile(f32x16* o, int vb0, bf16x8 pa0, bf16x8 pa1, bf16x8 pa2, bf16x8 pa3) {
#define TRRD(dst, off) asm volatile("ds_read_b64_tr_b16 %0, %1 offset:%2" : "=&v"(dst) : "v"(vb0), "i"(off) : "memory")
#define PV_D0(d0) do { s16x4 l0, l1, l2, l3, h0, h1, h2, h3; constexpr int b_ = VB * SHM_V + v_rd_off(d0, 0, 0); \
        TRRD(l0, b_); TRRD(h0, b_ + 2048); TRRD(l1, b_ + 4096); TRRD(h1, b_ + 6144); TRRD(l2, b_ + 8192); TRRD(h2, b_ + 10240); TRRD(l3, b_ + 12288); TRRD(h3, b_ + 14336); \
        asm volatile("s_waitcnt lgkmcnt(0)" ::: "memory"); SBAR();   \
        o[d0] = __builtin_amdgcn_mfma_f32_32x32x16_bf16(pa0, (bf16x8){l0[0], l0[1], l0[2], l0[3], h0[0], h0[1], h0[2], h0[3]}, o[d0], 0, 0, 0);   \
        o[d0] = __builtin_amdgcn_mfma_f32_32x32x16_bf16(pa1, (bf16x8){l1[0], l1[1], l1[2], l1[3], h1[0], h1[1], h1[2], h1[3]}, o[d0], 0, 0, 0);   \
        o[d0] = __builtin_amdgcn_mfma_f32_32x32x16_bf16(pa2, (bf16x8){l2[0], l2[1], l2[2], l2[3], h2[0], h2[1], h2[2], h2[3]}, o[d0], 0, 0, 0);   \
        o[d0] = __builtin_amdgcn_mfma_f32_32x32x16_bf16(pa3, (bf16x8){l3[0], l3[1], l3[2], l3[3], h3[0], h3[1], h3[2], h3[3]}, o[d0], 0, 0, 0); } while (0)
    PV_D0(0); PV_D0(1); PV_D0(2); PV_D0(3);
#undef PV_D0
#undef TRRD
}

struct BlockRef { const bf16_t* Q; const bf16_t* K; const bf16_t* V; bf16_t* G; int qb; };
struct Seam { bf16x8 qr[12]; bf16x8 st_v0, st_v1, st_k0, st_k1, st_k2; };

#define VMW() asm volatile("s_waitcnt vmcnt(0)" ::: "memory")
#define VMWN(n) asm volatile("s_waitcnt vmcnt(%0)" :: "i"(n) : "memory")
#define LD8(p) (*reinterpret_cast<const bf16x8*>(p))
#define SLOAD_H(Kp, Vp, k0) do { S.st_v0 = LD8((Vp) + (size_t)((k0) + sr) * 128 + sc); S.st_v1 = LD8((Vp) + (size_t)((k0) + 32 + sr) * 128 + sc); \
        const bf16_t* kt_ = (Kp) + (size_t)(k0) * 192 + tid * 8; S.st_k0 = LD8(kt_); S.st_k1 = LD8(kt_ + 4096); S.st_k2 = LD8(kt_ + 8192); } while (0)
#define SWRITE_HK(bf) do { *(bf16x8*)(K_lds + (bf) * SHM_K + kw0) = S.st_k0; *(bf16x8*)(K_lds + (bf) * SHM_K + kw1) = S.st_k1; *(bf16x8*)(K_lds + (bf) * SHM_K + kw2) = S.st_k2; } while (0)
#define SWRITE_HV(bf) do { *(bf16x8*)(V_lds + (bf) * SHM_V + vst0) = S.st_v0; *(bf16x8*)(V_lds + (bf) * SHM_V + vst1) = S.st_v1; } while (0)
#define SWRITE_H(bf) do { SWRITE_HV(bf); SWRITE_HK(bf); } while (0)
#define KW_OFFS() const int g0_ = tid, g1_ = tid + 512, g2_ = tid + 1024; \
    const int kw0 = KSWZ(g0_ / 24, (g0_ % 24) * 16), kw1 = KSWZ(g1_ / 24, (g1_ % 24) * 16), kw2 = KSWZ(g2_ / 24, (g2_ % 24) * 16)

__device__ __forceinline__ void prime(const BlockRef& cur, char* lds, Seam& S) {
    int tid_ = threadIdx.x; asm volatile("" : "+v"(tid_));
    const int tid = tid_;
    const int sr = tid >> 4, sc = (tid & 15) * 8; char* K_lds = lds + 2 * SHM_V;
    KW_OFFS();
    SLOAD_H(cur.K, cur.V, 0); VMW(); SWRITE_HK(0);
    __syncthreads();
}
__device__ __forceinline__ void block(const BlockRef& cur, const BlockRef& nxt, char* lds, Seam& S) {
    int tid_ = threadIdx.x; asm volatile("" : "+v"(tid_));
    const int tid = tid_, wid = __builtin_amdgcn_readfirstlane(tid >> 6), lane = tid & 63, r32 = lane & 31, hi = lane >> 5;
    const int NT = 4 * cur.qb + 4;
    const int tmax = 4 * cur.qb + (wid >> 1);
    char* V_lds = lds; char* K_lds = lds + 2 * SHM_V;
    float* wsf = (float*)(lds + 2 * SHM_V + 2 * SHM_K) + wid * 64; float* li_l = wsf, * al_l = wsf + 32;
    float m_reg = -1e30f, l_reg = 0; f32x16 o[4] = {};
    const int sr = tid >> 4, sc = (tid & 15) * 8, vst0 = v_st(sr, sc), vst1 = v_st(32 + sr, sc);
    KW_OFFS();
    const int vb0 = (int)(uintptr_t)V_lds + v_rd_base(lane);
    const bf16_t* Kh = cur.K; const bf16_t* Vh = cur.V;
#define RESC(a) do { if (__any((a) < 1.f)) { if (hi == 0) al_l[r32] = (a); asm volatile("s_waitcnt lgkmcnt(0)" ::: "memory");              \
                     _Pragma("unroll") for (int d_ = 0; d_ < 4; ++d_) _Pragma("unroll") for (int r = 0; r < 16; ++r) o[d_][r] *= al_l[crow(r, hi)]; } } while (0)
#define KBASE(t) ((t) * KVBLK)
#define MASKT(P0_, P1_, t) do { if ((t) > tmax) { const float NEG_ = -__builtin_inff(); _Pragma("unroll") for (int r = 0; r < 16; ++r) { P0_[r] = NEG_; P1_[r] = NEG_; } } } while (0)
    constexpr int NQL = 0;
#define SEAM_K0() do { VMWN(NQL); SWRITE_HK(0); SBAR(); } while (0)
    f32x16 pA0, pA1, pB0, pB1; float mnA, mnB, alA, alB; bf16x8 pa0, pa1, pa2, pa3;
#pragma unroll
    for (int d0 = 0; d0 < 12; ++d0) S.qr[d0] = LD8(cur.Q + (size_t)(wid * QBLK + r32) * 192 + d0 * 16 + hi * 8);
    SWRITE_HV(0); SBAR();
    SLOAD_H(Kh, Vh, KBASE(1));
    SBAR(); qkt<0>(pA0, pA1, K_lds, r32, hi, S.qr);
    MASKT(pA0, pA1, 0); partialSM(pA0, pA1, m_reg, mnA, alA);
    VMW(); SWRITE_H(1);
    __syncthreads();
#define HALF_STEP(PX0, PX1, mnX, alX, PY0, PY1, alY, t, KB, VB, SB) do {                                                      \
        SBAR(); qkt<KB>(PX0, PX1, K_lds, r32, hi, S.qr);                                                          \
        finishSM(PY0, PY1, alY, l_reg, pa0, pa1, pa2, pa3); SBAR();                                                           \
        if ((t) + 1 < NT) { SLOAD_H(Kh, Vh, KBASE((t) + 1)); SBAR(); }                                               \
        pv_tile<VB>(o, vb0, pa0, pa1, pa2, pa3); MASKT(PX0, PX1, (t)); partialSM(PX0, PX1, m_reg, mnX, alX);                                        \
        __syncthreads();                                                                                                      \
        if ((t) + 1 < NT) { VMW(); SWRITE_H(SB); }                                                                          \
        RESC(alX); __syncthreads(); } while (0)
    for (int t = 1; t + 1 < NT; t += 2) {
        HALF_STEP(pB0, pB1, mnB, alB, pA0, pA1, alA, t, 1, 0, 0);
        HALF_STEP(pA0, pA1, mnA, alA, pB0, pB1, alB, t + 1, 0, 1, 1);
    }
    SBAR(); qkt<1>(pB0, pB1, K_lds, r32, hi, S.qr); SBAR();
    SLOAD_H(nxt.K, nxt.V, 0); SBAR();
    finishSM(pA0, pA1, alA, l_reg, pa0, pa1, pa2, pa3); SBAR();
    pv_tile<0>(o, vb0, pa0, pa1, pa2, pa3);
    MASKT(pB0, pB1, NT - 1); partialSM(pB0, pB1, m_reg, mnB, alB); __syncthreads(); RESC(alB);
    finishSM(pB0, pB1, alB, l_reg, pa0, pa1, pa2, pa3); SBAR(); pv_tile<1>(o, vb0, pa0, pa1, pa2, pa3);
    SBAR(); SEAM_K0();
    if (hi == 0) li_l[r32] = l_reg; asm volatile("s_waitcnt lgkmcnt(0)" ::: "memory");
    float rli[16];
#pragma unroll
    for (int r = 0; r < 16; ++r) rli[r] = __builtin_amdgcn_rcpf(li_l[crow(r, hi)]);
    bf16_t* Gw = cur.G + (size_t)(wid * QBLK) * 2048;
#pragma unroll
    for (int r = 0; r < 16; ++r) { const int orow = crow(r, hi);
#pragma unroll
        for (int d0 = 0; d0 < 4; ++d0) {
            bf16_t* gp = Gw + (size_t)orow * 2048 + d0 * 32 + r32;
            const float gate = bf2f(*gp);
            const float v = o[d0][r] * rli[r] * sigmoidf_(gate);
            const float vn = __shfl_xor(v, 1);
            if ((r32 & 1) == 0) *(unsigned*)gp = cvtpk(v, vn); } }
    __syncthreads();
#undef RESC
#undef KBASE
#undef MASKT
#undef SEAM_K0
#undef HALF_STEP
}
#undef VMW
#undef VMWN
#undef LD8
#undef SLOAD_H
#undef SWRITE_HK
#undef SWRITE_HV
#undef SWRITE_H
#undef KW_OFFS
#undef KSWZ
#undef SBAR
}

#define LDS_WAIT() asm volatile("s_waitcnt lgkmcnt(0)" ::: "memory")
__device__ __forceinline__ unsigned pk2(float lo, float hi) { return cvt_pk_bf16(lo, hi); }

__device__ __forceinline__ void tr_item(const float* src, size_t ldn, bf16_t* dst, size_t ldk, int k0, int ndst0, int srcn, const float* kscale, LAS float* scr, int lane) {
#pragma unroll 8
    for (int i = 0; i < 32; ++i) { const int kk = 2 * i + (lane >> 5);
        float v = 0.f; if (srcn >= 0) { v = src[(size_t)(k0 + kk) * ldn + srcn]; if (kscale) v *= kscale[k0 + kk]; }
        scr[kk * 33 + (lane & 31)] = v; }
    LDS_WAIT(); asm volatile("" ::: "memory");
    const int c = lane & 7;
#pragma unroll
    for (int j = 0; j < 4; ++j) { const int n = (lane >> 3) + 8 * j; const LAS float* s = scr + (8 * c) * 33 + n;
        u32x4 o; o.x = pk2(s[0 * 33], s[1 * 33]); o.y = pk2(s[2 * 33], s[3 * 33]); o.z = pk2(s[4 * 33], s[5 * 33]); o.w = pk2(s[6 * 33], s[7 * 33]);
        *(u32x4*)(dst + (size_t)(ndst0 + n) * ldk + k0 + 8 * c) = o; }
    LDS_WAIT(); asm volatile("" ::: "memory");
}
__device__ __forceinline__ int win_src(int n) {
    if (n < 1024) return n;
    if (n < 5120) return n + 64;
    if (n < 11264) return n + 80;
    const int lc = n - 11264;
    if (lc < 64) return 1024 + lc;
    if (lc < 80) return 5184 + (lc - 64);
    return -1;
}

__device__ __forceinline__ void p0_prologue(Frame& F) {
    LAS float* scr = (LAS float*)(F.lds + F.wave * 16384);
    const int gw = F.vcu * 8 + F.wave, NGW = F.G * 8, lane = F.lane;
    const int gt = gw * 64 + lane, NGT = NGW * 64;
    unsigned char* ws = F.ws; bf16_t* wsm = (bf16_t*)(ws + WS_WSM); float* fsm = (float*)(ws + WS_FSM);
    for (int i = gt; i < (int)F_ZERO_END; i += NGT) fsm[i] = 0.f;
    {
        const float* g = F.in[5]; bf16_t* hb = (bf16_t*)(ws + WS_R2);
        for (int row = gw; row < NTOK; row += NGW) {
            const float* xr = row < SEQ ? F.in[0] + (size_t)row * DM : F.in[1] + (size_t)(row - SEQ) * DM;
            f32x4 v[8]; float s = 0.f;
#pragma unroll
            for (int j = 0; j < 8; ++j) { v[j] = *(const f32x4*)(xr + (lane + 64 * j) * 4); s += (v[j][0] * v[j][0] + v[j][1] * v[j][1]) + (v[j][2] * v[j][2] + v[j][3] * v[j][3]); }
            const float inv = rsqrtf(wave_sum(s) * (1.f / DM) + EPS);
#pragma unroll
            for (int j = 0; j < 8; ++j) { const f32x4 gg = *(const f32x4*)(g + (lane + 64 * j) * 4);
                u32x2 o; o.x = pk2(v[j][0] * inv * gg[0], v[j][1] * inv * gg[1]); o.y = pk2(v[j][2] * inv * gg[2], v[j][3] * inv * gg[3]);
                *(u32x2*)(hb + (size_t)row * DM + (lane + 64 * j) * 4) = o; }
        }
    }
    {
        const float* wukv = F.in[10]; bf16_t* wk = wsm + W_KNABS;
        for (int i = gt; i < 16 * 512 * 32; i += NGT) { const int j8 = (i & 31) * 8, c = (i >> 5) & 511, h = i >> 14;
            u32x4 o = {0u, 0u, 0u, 0u};
            if (j8 < 128) { const float* s = wukv + (size_t)c * 4096 + h * 256 + j8; const f32x4 a = *(const f32x4*)s, b = *(const f32x4*)(s + 4);
                o.x = pk2(a[0], a[1]); o.y = pk2(a[2], a[3]); o.z = pk2(b[0], b[1]); o.w = pk2(b[2], b[3]); }
            *(u32x4*)(wk + ((size_t)h * 512 + c) * 256 + j8) = o; }
    }
    constexpr int I_IN = 32 * 360, I_UQ = 8 * 96, I_UKV = 8 * 128, I_KN = 8 * 64, I_V = 8 * 64, I_O = 32 * 64;
    constexpr int NIT = I_IN + I_UQ + I_UKV + I_KN + I_V + I_O;
    for (int it = gw; it < NIT; it += NGW) {
        int r = it; const int n = lane & 31;
        if (r < I_IN) { const int kb = r / 360, nb = r % 360; tr_item(F.in[6], DIN, (bf16_t*)(ws + WS_R1), 2048, kb * 64, nb * 32, win_src(nb * 32 + n), nullptr, scr, lane); continue; } r -= I_IN;
        if (r < I_UQ) { const int kb = r / 96, nb = r % 96; tr_item(F.in[8], 3072, wsm + W_UQ, 512, kb * 64, nb * 32, nb * 32 + n, F.in[7], scr, lane); continue; } r -= I_UQ;
        if (r < I_UKV) { const int kb = r / 128, nb = r % 128; tr_item(F.in[10], 4096, wsm + W_UKVG, 512, kb * 64, nb * 32, nb * 32 + n, F.in[9], scr, lane); continue; } r -= I_UKV;
        if (r < I_KN) { const int kb = r / 64, nb = r % 64; const int nd = nb * 32 + n; tr_item(F.in[10], 4096, wsm + W_KNP, 512, kb * 64, nb * 32, (nd >> 7) * 256 + (nd & 127), nullptr, scr, lane); continue; } r -= I_KN;
        if (r < I_V) { const int kb = r / 64, nb = r % 64; const int nd = nb * 32 + n; tr_item(F.in[10], 4096, wsm + W_VP, 512, kb * 64, nb * 32, (nd >> 7) * 256 + 128 + (nd & 127), nullptr, scr, lane); continue; } r -= I_V;
        { const int kb = r / 64, nb = r % 64; tr_item(F.in[18], 2048, wsm + W_O, 2048, kb * 64, nb * 32, nb * 32 + n, nullptr, scr, lane); }
    }
}

__device__ __forceinline__ void p2_ckv_krope(Frame& F) {
    const int gw = F.vcu * 8 + F.wave, NGW = F.G * 8, lane = F.lane;
    unsigned char* ws = F.ws; float* fsm = (float*)(ws + WS_FSM);
    const bf16_t* ZL = (const bf16_t*)(ws + WS_ZL); const bf16_t* ZM = (const bf16_t*)(ws + WS_ZM);
    const float* gkv = F.in[9]; const float* cs = fsm + F_ROPE;
    for (int t = gw; t < NTOK; t += NGW) {
        const float inv = rsqrtf(fsm[F_SSQ_KV + t] * (1.f / 512.f) + EPS);
        const u32x4 w = *(const u32x4*)(ZL + (size_t)t * 1024 + 512 + lane * 8);
        const f32x4 g0 = *(const f32x4*)(gkv + lane * 8), g1 = *(const f32x4*)(gkv + lane * 8 + 4);
        f32x4 o0, o1;
        o0[0] = bflo(w.x) * inv * g0[0]; o0[1] = bfhi(w.x) * inv * g0[1]; o0[2] = bflo(w.y) * inv * g0[2]; o0[3] = bfhi(w.y) * inv * g0[3];
        o1[0] = bflo(w.z) * inv * g1[0]; o1[1] = bfhi(w.z) * inv * g1[1]; o1[2] = bflo(w.w) * inv * g1[2]; o1[3] = bfhi(w.w) * inv * g1[3];
        float* oc = t < SEQ ? F.out + O_CKVP + (size_t)t * 512 : F.out + O_CKVS + (size_t)(t - SEQ) * 512;
        *(f32x4*)(oc + lane * 8) = o0; *(f32x4*)(oc + lane * 8 + 4) = o1;
        float ss = 0.f;
        if (lane < 32) {
            const float x1 = bf2f(ZM[(size_t)t * 256 + lane]), x2 = bf2f(ZM[(size_t)t * 256 + 32 + lane]);
            const int pos = t < SEQ ? t : PAST + ((t - SEQ) & 15);
            const float c = cs[pos * 64 + lane], s = cs[pos * 64 + 32 + lane];
            const float y1 = x1 * c - x2 * s, y2 = x2 * c + x1 * s;
            float* ok = t < SEQ ? F.out + O_KRP + (size_t)t * 64 : F.out + O_KRS + (size_t)(t - SEQ) * 64;
            ok[lane] = y1; ok[32 + lane] = y2; ss = y1 * y1 + y2 * y2;
        }
        ss = wave_sum(ss);
        if (lane == 0) fsm[F_KRSS + t] = ss;
    }
}

__device__ __forceinline__ void p3_finalize_qk(Frame& F) {
    const int gw = F.vcu * 8 + F.wave, NGW = F.G * 8, lane = F.lane, l = lane & 31;
    unsigned char* ws = F.ws; float* fsm = (float*)(ws + WS_FSM); const float* cs = fsm + F_ROPE;
    bf16_t* Qp = (bf16_t*)(ws + WS_R1); bf16_t* Kp = (bf16_t*)(F.out + O_Y);
    bf16_t* Qcat = (bf16_t*)(F.out + O_Y) + 48 * MiB / 2; bf16_t* QnA = (bf16_t*)(F.out + O_Y) + 53 * MiB / 2;
    const float* gqn = F.in[11]; const float* gqr = F.in[12]; const float* gkn = F.in[13]; const float* gkr = F.in[14];
    for (int p = gw * 2 + (lane >> 5); p < NTOK * 16; p += NGW * 2) {
        const int t = p >> 4, h = p & 15;
        const float al = rsqrtf(fsm[F_SSQ_QL + t] * (1.f / 512.f) + EPS);
        const float invq = rsqrtf(al * al * fsm[F_SSQ_QH + p] * (1.f / 192.f) + EPS);
        const float sc = al * invq * MLA_SCALE * LOG2E;
        bf16_t* q = Qp + ((size_t)h * NTOK + t) * 192;
        const int r = t - SEQ, b = r >> 4, qi = r & 15;
        if (l < 16) {
            const u32x4 w = *(const u32x4*)(q + l * 8);
            const f32x4 a0 = *(const f32x4*)(gqn + l * 8), a1 = *(const f32x4*)(gqn + l * 8 + 4), b0 = *(const f32x4*)(gkn + l * 8), b1 = *(const f32x4*)(gkn + l * 8 + 4);
            u32x4 o;
            o.x = pk2(bflo(w.x) * sc * a0[0] * b0[0], bfhi(w.x) * sc * a0[1] * b0[1]); o.y = pk2(bflo(w.y) * sc * a0[2] * b0[2], bfhi(w.y) * sc * a0[3] * b0[3]);
            o.z = pk2(bflo(w.z) * sc * a1[0] * b1[0], bfhi(w.z) * sc * a1[1] * b1[1]); o.w = pk2(bflo(w.w) * sc * a1[2] * b1[2], bfhi(w.w) * sc * a1[3] * b1[3]);
            *(u32x4*)(q + l * 8) = o;
            if (t >= SEQ) { bf16_t* qa = QnA + ((size_t)h * 256 + r) * 256; *(u32x4*)(qa + l * 8) = o; *(u32x4*)(qa + 128 + l * 8) = (u32x4){0u, 0u, 0u, 0u}; }
        } else if (l < 20) {
            const int k = l - 16; const int pos = t < SEQ ? t : PAST + qi;
            const u32x4 w1 = *(const u32x4*)(q + 128 + 8 * k), w2 = *(const u32x4*)(q + 160 + 8 * k);
            float x1[8] = {bflo(w1.x), bfhi(w1.x), bflo(w1.y), bfhi(w1.y), bflo(w1.z), bfhi(w1.z), bflo(w1.w), bfhi(w1.w)};
            float x2[8] = {bflo(w2.x), bfhi(w2.x), bflo(w2.y), bfhi(w2.y), bflo(w2.z), bfhi(w2.z), bflo(w2.w), bfhi(w2.w)};
            float y1[8], y2[8];
#pragma unroll
            for (int i = 0; i < 8; ++i) { const int ii = 8 * k + i; const float c = cs[pos * 64 + ii], s = cs[pos * 64 + 32 + ii], g = gqr[ii] * gkr[ii] * sc;
                y1[i] = (x1[i] * c - x2[i] * s) * g; y2[i] = (x2[i] * c + x1[i] * s) * g; }
            u32x4 o1 = {pk2(y1[0], y1[1]), pk2(y1[2], y1[3]), pk2(y1[4], y1[5]), pk2(y1[6], y1[7])};
            u32x4 o2 = {pk2(y2[0], y2[1]), pk2(y2[2], y2[3]), pk2(y2[4], y2[5]), pk2(y2[6], y2[7])};
            *(u32x4*)(q + 128 + 8 * k) = o1; *(u32x4*)(q + 160 + 8 * k) = o2;
            if (t >= SEQ) { bf16_t* qc = Qcat + ((size_t)b * 256 + h * 16 + qi) * DQC; *(u32x4*)(qc + 512 + 8 * k) = o1; *(u32x4*)(qc + 544 + 8 * k) = o2; }
        } else if (l < 28) {
            if (t >= SEQ) { bf16_t* qc = Qcat + ((size_t)b * 256 + h * 16 + qi) * DQC; *(u32x4*)(qc + 576 + 8 * (l - 20)) = (u32x4){0u, 0u, 0u, 0u}; }
        }
    }
    for (int p = gw * 2 + (lane >> 5); p < SEQ * 16; p += NGW * 2) {
        const int t = p >> 4, h = p & 15;
        const float invk = rsqrtf((fsm[F_SSQ_K + p] + fsm[F_KRSS + t]) * (1.f / 192.f) + EPS);
        bf16_t* k = Kp + ((size_t)h * SEQ + t) * 192;
        if (l < 16) {
            const u32x4 w = *(const u32x4*)(k + l * 8); u32x4 o;
            o.x = pk2(bflo(w.x) * invk, bfhi(w.x) * invk); o.y = pk2(bflo(w.y) * invk, bfhi(w.y) * invk); o.z = pk2(bflo(w.z) * invk, bfhi(w.z) * invk); o.w = pk2(bflo(w.w) * invk, bfhi(w.w) * invk);
            *(u32x4*)(k + l * 8) = o;
        } else if (l < 24) {
            const float* kr = F.out + O_KRP + (size_t)t * 64 + (l - 16) * 8; const f32x4 a = *(const f32x4*)kr, b = *(const f32x4*)(kr + 4);
            u32x4 o = {pk2(a[0] * invk, a[1] * invk), pk2(a[2] * invk, a[3] * invk), pk2(b[0] * invk, b[1] * invk), pk2(b[2] * invk, b[3] * invk)};
            *(u32x4*)(k + 128 + (l - 16) * 8) = o;
        }
    }
}
__device__ __forceinline__ void p3_kcat_ct(Frame& F) {
    LAS float* scr = (LAS float*)(F.lds + F.wave * 16384);
    const int gw = F.vcu * 8 + F.wave, NGW = F.G * 8, lane = F.lane;
    const int gt = gw * 64 + lane, NGT = NGW * 64;
    unsigned char* ws = F.ws; float* fsm = (float*)(ws + WS_FSM);
    bf16_t* Kcat = (bf16_t*)(ws + WS_R3); bf16_t* CT = (bf16_t*)(ws + WS_R4);
    const float* cckv = F.in[2]; const float* ckr = F.in[3];
    for (int row = gw; row < DECB * NKP; row += NGW) {
        const int b = row / NKP, k = row - b * NKP;
        bf16_t* dst = Kcat + (size_t)row * DQC;
        float ss = 0.f;
#pragma unroll
        for (int j = 0; j < 2; ++j) { const int ch = lane + 64 * j; if (ch >= 80) break;
            u32x4 o = {0u, 0u, 0u, 0u};
            if (k < NKEY && ch < 72) {
                const float* s;
                if (ch < 64) s = (k < PAST ? cckv + ((size_t)b * PAST + k) * 512 : F.out + O_CKVS + (size_t)(b * 16 + k - PAST) * 512) + ch * 8;
                else s = (k < PAST ? ckr + ((size_t)b * PAST + k) * 64 : F.out + O_KRS + (size_t)(b * 16 + k - PAST) * 64) + (ch - 64) * 8;
                const f32x4 a = *(const f32x4*)s, c = *(const f32x4*)(s + 4);
                o.x = pk2(a[0], a[1]); o.y = pk2(a[2], a[3]); o.z = pk2(c[0], c[1]); o.w = pk2(c[2], c[3]);
                if (ch >= 64) ss = (a[0] * a[0] + a[1] * a[1]) + (a[2] * a[2] + a[3] * a[3]) + (c[0] * c[0] + c[1] * c[1]) + (c[2] * c[2] + c[3] * c[3]);
            }
            *(u32x4*)(dst + ch * 8) = o; }
        ss = wave_sum(ss);
        if (lane == 0) fsm[F_KRSS_C + row] = ss;
    }
    for (int it = gw; it < 16 * 32 * 16; it += NGW) {
        const int b = it >> 9, r = it & 511, kb = r >> 4, nb = r & 15;
        tr_item(cckv + (size_t)b * PAST * 512, 512, CT + (size_t)b * 512 * NKP, NKP, kb * 64, nb * 32, nb * 32 + (lane & 31), nullptr, scr, lane);
    }
    for (int i = gt; i < 16 * 512 * 32; i += NGT) { const int ch = i & 31, c = (i >> 5) & 511, b = i >> 14;
        u32x4 o = {0u, 0u, 0u, 0u};
        if (ch < 2) { const float* s = F.out + O_CKVS + (size_t)(b * 16 + ch * 8) * 512 + c;
            o.x = pk2(s[0], s[512]); o.y = pk2(s[1024], s[1536]); o.z = pk2(s[2048], s[2560]); o.w = pk2(s[3072], s[3584]); }
        *(u32x4*)(CT + ((size_t)b * 512 + c) * NKP + PAST + ch * 8) = o; }
}
__device__ __forceinline__ float logsig16(float x) { return (fminf(x, 0.f) - log1pf(__expf(-fabsf(x)))) * (1.f / 16.f); }
__device__ __forceinline__ void p3_gla_prep(Frame& F) {
    unsigned char* ws = F.ws; float* fsm = (float*)(ws + WS_FSM);
    const bf16_t* ZQK = (const bf16_t*)(ws + WS_ZQK); const bf16_t* ZV = (const bf16_t*)(ws + WS_ZV); const bf16_t* ZM = (const bf16_t*)(ws + WS_ZM);
    bf16_t* qt = (bf16_t*)(ws + WS_ZL); bf16_t* kt = (bf16_t*)(ws + WS_R5); bf16_t* kendT = (bf16_t*)(ws + WS_R5) + 8 * MiB; bf16_t* vT = (bf16_t*)(F.out + O_STS);
    const float* wa2 = F.in[15]; const float* ba_ = F.in[16];
    LAS float* alr_s = (LAS float*)F.lds;
    LAS float* tot_s = (LAS float*)(F.lds + 16384);
    LAS unsigned char* tile = F.lds + 16384 + 2048;
    const int tid = F.tid;
    for (int un = F.vcu; un < 256; un += F.G) {
        const int hc = un >> 1, dh = un & 1, h = hc >> 5, c = hc & 31;
        const int dl = tid & 127, qtr = tid >> 7, d = dh * 128 + dl;
        { const int tt = tid >> 1, half = tid & 1; const u32x4 w = *(const u32x4*)(ZM + (size_t)(c * 256 + tt) * 256 + 64 + half * 8);
          LAS float* a = alr_s + tt * 16 + half * 8;
          a[0] = bflo(w.x); a[1] = bfhi(w.x); a[2] = bflo(w.y); a[3] = bfhi(w.y); a[4] = bflo(w.z); a[5] = bfhi(w.z); a[6] = bflo(w.w); a[7] = bfhi(w.w); }
        float wa[16];
#pragma unroll
        for (int r = 0; r < 16; ++r) wa[r] = wa2[r * 1024 + h * 256 + d];
        const float ba = ba_[h * 256 + d];
        __syncthreads();
        float tot = 0.f;
        for (int i = 0; i < 64; ++i) { const LAS float* a = alr_s + (qtr * 64 + i) * 16; float x = ba;
#pragma unroll
            for (int r = 0; r < 16; ++r) x += a[r] * wa[r];
            tot += logsig16(x); }
        tot_s[qtr * 128 + dl] = tot;
        __syncthreads();
        float off = 0.f, bend = 0.f;
#pragma unroll
        for (int q = 0; q < 4; ++q) { const float v = tot_s[q * 128 + dl]; bend += v; if (q < qtr) off += v; }
        if (qtr == 0) fsm[F_GAMMA + hc * 256 + d] = __expf(bend);
        float bcum = off;
        for (int i = 0; i < 64; ++i) { const int tl = qtr * 64 + i; const LAS float* a = alr_s + tl * 16; float x = ba;
#pragma unroll
            for (int r = 0; r < 16; ++r) x += a[r] * wa[r];
            bcum += logsig16(x);
            const size_t trow = (size_t)(c * 256 + tl) * 2048;
            const float gq = bf2f(ZQK[trow + h * 256 + d]), gk = bf2f(ZQK[trow + 1024 + h * 256 + d]);
            qt[(size_t)hc * 65536 + tl * 256 + d] = f2bf(gq * 0.0625f * __expf(bcum));
            kt[(size_t)hc * 65536 + tl * 256 + d] = f2bf(gk * __expf(-bcum));
            *(LAS bf16_t*)(tile + dl * 520 + tl * 2) = f2bf(gk * __expf(bend - bcum)); }
        __syncthreads();
#pragma unroll 4
        for (int j = 0; j < 16; ++j) { const int g = tid + 512 * j, row = g >> 6, ch = g & 63;
            const u32x2 v = *(const LAS u32x2*)(tile + row * 520 + ch * 8);
            *(u32x2*)(kendT + (size_t)hc * 65536 + (size_t)(dh * 128 + row) * 256 + ch * 4) = v; }
        __syncthreads();
    }
    LAS unsigned char* tl2 = F.lds;
    for (int it = F.vcu; it < 1024; it += F.G) {
        const int hc = it >> 3, eb = it & 7, h = hc >> 5, c = hc & 31, e0 = eb * 64;
#pragma unroll
        for (int j = 0; j < 4; ++j) { const int g = tid + 512 * j, t = g >> 3, ch = g & 7;
            const u32x4 w = *(const u32x4*)(ZV + (size_t)(c * 256 + t) * 2048 + h * 512 + e0 + ch * 8);
            LAS unsigned char* p = tl2 + (ch * 8) * 520 + t * 2;
            *(LAS bf16_t*)(p) = (bf16_t)(w.x & 0xffff); *(LAS bf16_t*)(p + 520) = (bf16_t)(w.x >> 16);
            *(LAS bf16_t*)(p + 2 * 520) = (bf16_t)(w.y & 0xffff); *(LAS bf16_t*)(p + 3 * 520) = (bf16_t)(w.y >> 16);
            *(LAS bf16_t*)(p + 4 * 520) = (bf16_t)(w.z & 0xffff); *(LAS bf16_t*)(p + 5 * 520) = (bf16_t)(w.z >> 16);
            *(LAS bf16_t*)(p + 6 * 520) = (bf16_t)(w.w & 0xffff); *(LAS bf16_t*)(p + 7 * 520) = (bf16_t)(w.w >> 16); }
        __syncthreads();
#pragma unroll
        for (int j = 0; j < 8; ++j) { const int g = tid + 512 * j, row = g >> 6, ch = g & 63;
            const u32x2 v = *(const LAS u32x2*)(tl2 + row * 520 + ch * 8);
            *(u32x2*)(vT + ((size_t)hc * 512 + e0 + row) * 256 + ch * 4) = v; }
        __syncthreads();
    }
}

__device__ __forceinline__ void p6_softmax_scan(Frame& F) {
    const int gw = F.vcu * 8 + F.wave, NGW = F.G * 8, lane = F.lane;
    unsigned char* ws = F.ws; float* fsm = (float*)(ws + WS_FSM);
    const float* Sb = F.out + O_Y; bf16_t* P = (bf16_t*)(ws + WS_R5);
    for (int R = gw; R < 16 * 256; R += NGW) {
        const float* sr = Sb + (size_t)R * NKP; f32x4 v[9]; float m = -3.0e38f;
#pragma unroll
        for (int j = 0; j < 9; ++j) { const int k = (lane + 64 * j) * 4; v[j] = *(const f32x4*)(sr + k);
#pragma unroll
            for (int i = 0; i < 4; ++i) { if (k + i >= NKEY) v[j][i] = -__builtin_inff(); m = fmaxf(m, v[j][i]); } }
        m = wave_max(m); float s = 0.f;
#pragma unroll
        for (int j = 0; j < 9; ++j)
#pragma unroll
            for (int i = 0; i < 4; ++i) { v[j][i] = __builtin_amdgcn_exp2f(v[j][i] - m); s += v[j][i]; }
        const float inv = 1.f / wave_sum(s);
#pragma unroll
        for (int j = 0; j < 9; ++j) { const int k = (lane + 64 * j) * 4; u32x2 o = {pk2(v[j][0] * inv, v[j][1] * inv), pk2(v[j][2] * inv, v[j][3] * inv)};
            *(u32x2*)(P + (size_t)R * NKP + k) = o; }
    }
    const bf16_t* dS = (const bf16_t*)(ws + WS_R1); bf16_t* Sst = (bf16_t*)(ws + WS_R2); const float* gam = fsm + F_GAMMA;
    for (int gid = (F.vcu * 8 + F.wave) * 64 + lane; gid < 4 * 512 * 64; gid += F.G * 512) {
        const int dq = gid & 63, e = (gid >> 6) & 511, h = gid >> 15;
        f32x4 st = {0.f, 0.f, 0.f, 0.f};
#pragma unroll 8
        for (int c = 0; c < 32; ++c) { const int hc = h * 32 + c; const size_t idx = ((size_t)hc * 512 + e) * 256 + dq * 4;
            const u32x2 w = *(const u32x2*)(dS + idx); const f32x4 g = *(const f32x4*)(gam + hc * 256 + dq * 4);
            u32x2 o = {pk2(st[0], st[1]), pk2(st[2], st[3])}; *(u32x2*)(Sst + idx) = o;
            st[0] = g[0] * st[0] + bflo(w.x); st[1] = g[1] * st[1] + bfhi(w.x); st[2] = g[2] * st[2] + bflo(w.y); st[3] = g[3] * st[3] + bfhi(w.y); }
        float* op = F.out + O_STP + ((size_t)h * 256 + dq * 4) * 512 + e;
        op[0] = st[0]; op[512] = st[1]; op[1024] = st[2]; op[1536] = st[3];
    }
}

__device__ __forceinline__ void p8_pc_convert(Frame& F) {
    const int gt = (F.vcu * 8 + F.wave) * 64 + F.lane, NGT = F.G * 512;
    const float* PCp = (const float*)(F.ws + WS_R1); bf16_t* PCb = (bf16_t*)(F.ws + WS_ZQK) + 8 * MiB;
    for (int i = gt; i < 16 * 256 * 64; i += NGT) { const size_t e = (size_t)i * 8; f32x4 a = {0.f, 0.f, 0.f, 0.f}, b = a;
#pragma unroll
        for (int ks = 0; ks < 3; ++ks) { const float* s = PCp + (size_t)ks * 16 * 256 * 512 + e; a += *(const f32x4*)s; b += *(const f32x4*)(s + 4); }
        u32x4 o = {pk2(a[0], a[1]), pk2(a[2], a[3]), pk2(b[0], b[1]), pk2(b[2], b[3])}; *(u32x4*)(PCb + e) = o; }
}

__device__ __forceinline__ void p9_ffn_weights(Frame& F) {
    LAS float* scr = (LAS float*)(F.lds + F.wave * 16384);
    const int gw = F.vcu * 8 + F.wave, NGW = F.G * 8, lane = F.lane, n = lane & 31;
    for (int it = gw; it < 16384; it += NGW) {
        if (it < 8192) { const int kb = it / 256, nb = it % 256; tr_item(F.in[20], DFF, (bf16_t*)(F.ws + WS_R1), 2048, kb * 64, nb * 32, nb * 32 + n, F.in[19], scr, lane); }
        else { const int r = it - 8192, kb = r / 64, nb = r % 64; tr_item(F.in[21], 2048, (bf16_t*)(F.ws + WS_R3), DFF, kb * 64, nb * 32, nb * 32 + n, nullptr, scr, lane); }
    }
}
__device__ __forceinline__ void p9_gla_sample(Frame& F) {
    unsigned char* ws = F.ws; float* fsm = (float*)(ws + WS_FSM);
    const bf16_t* ZQK = (const bf16_t*)(ws + WS_ZQK); bf16_t* ZV = (bf16_t*)(ws + WS_ZV); const bf16_t* ZM = (const bf16_t*)(ws + WS_ZM);
    const float* wa2 = F.in[15]; const float* ba_ = F.in[16]; const float* S0 = F.in[4];
    LAS float* alr_s = (LAS float*)F.lds;
    LAS float* qt_s = alr_s + 256;
    LAS float* kt_s = qt_s + 4096;
    LAS float* ke_s = kt_s + 4096;
    LAS float* gam_s = ke_s + 4096;
    LAS float* A_s = gam_s + 256;
    const int tid = F.tid;
    for (int un = F.vcu; un < 64; un += F.G) {
        const int b = un >> 2, h = un & 3; const int row0 = SEQ + b * 16;
        if (tid < 256) alr_s[tid] = bf2f(ZM[(size_t)(row0 + (tid >> 4)) * 256 + 64 + (tid & 15)]);
        __syncthreads();
        if (tid < 256) { const int d = tid; float bb[16]; float bc = 0.f; const float ba = ba_[h * 256 + d]; float wa[16];
#pragma unroll
            for (int r = 0; r < 16; ++r) wa[r] = wa2[r * 1024 + h * 256 + d];
#pragma unroll
            for (int t = 0; t < 16; ++t) { float x = ba;
#pragma unroll
                for (int r = 0; r < 16; ++r) x += alr_s[t * 16 + r] * wa[r];
                bc += logsig16(x); bb[t] = bc; }
#pragma unroll
            for (int t = 0; t < 16; ++t) { const size_t tr = (size_t)(row0 + t) * 2048;
                const float gq = bf2f(ZQK[tr + h * 256 + d]), gk = bf2f(ZQK[tr + 1024 + h * 256 + d]);
                qt_s[d * 16 + t] = gq * 0.0625f * __expf(bb[t]); kt_s[d * 16 + t] = gk * __expf(-bb[t]); ke_s[d * 16 + t] = gk * __expf(bc - bb[t]); }
            gam_s[d] = __expf(bc); }
        __syncthreads();
        if (tid < 256) { const int t = tid >> 4, s = tid & 15; float a = 0.f;
            for (int d = 0; d < 256; ++d) a += qt_s[d * 16 + t] * kt_s[d * 16 + s];
            A_s[tid] = (s <= t) ? a : 0.f; }
        __syncthreads();
        const int e = tid; float v[16], o[16];
#pragma unroll
        for (int t = 0; t < 16; ++t) v[t] = bf2f(ZV[(size_t)(row0 + t) * 2048 + h * 512 + e]);
#pragma unroll
        for (int t = 0; t < 16; ++t) { float a = 0.f;
#pragma unroll
            for (int s = 0; s < 16; ++s) a += A_s[t * 16 + s] * v[s];
            o[t] = a; }
        const float* sp = S0 + ((size_t)(b * 4 + h) * 256) * 512 + e; float* op = F.out + O_STS + ((size_t)(b * 4 + h) * 256) * 512 + e;
#pragma unroll 4
        for (int d = 0; d < 256; ++d) { const float s0 = sp[(size_t)d * 512]; float sn = gam_s[d] * s0;
            const LAS f32x4* q4 = (const LAS f32x4*)(qt_s + d * 16); const LAS f32x4* k4 = (const LAS f32x4*)(ke_s + d * 16);
#pragma unroll
            for (int j = 0; j < 4; ++j) { const f32x4 qv = q4[j], kv = k4[j];
#pragma unroll
                for (int i = 0; i < 4; ++i) { o[j * 4 + i] += qv[i] * s0; sn += kv[i] * v[j * 4 + i]; } }
            op[(size_t)d * 512] = sn; }
#pragma unroll
        for (int t = 0; t < 16; ++t) { ZV[(size_t)(row0 + t) * 2048 + h * 512 + e] = f2bf(o[t]);
            const float s = wave_sum(o[t] * o[t]); if (F.lane == 0) atomicAdd(fsm + F_SSQ_OG + (size_t)(row0 + t) * 4 + h, s); }
        __syncthreads();
    }
}

__device__ __forceinline__ void p10_mix(Frame& F) {
    const int gt = (F.vcu * 8 + F.wave) * 64 + F.lane, NGT = F.G * 512;
    unsigned char* ws = F.ws; const float* fsm = (const float*)(ws + WS_FSM); const float* gn = F.in[17];
    bf16_t* ZOG = (bf16_t*)(ws + WS_ZOG); const bf16_t* ZGM = (const bf16_t*)(ws + WS_ZGM); const bf16_t* ZGG = (const bf16_t*)(ws + WS_ZGG); const bf16_t* ZV = (const bf16_t*)(ws + WS_ZV);
    for (int i = gt; i < NTOK * 256; i += NGT) { const int t = i >> 8, c8 = (i & 255) * 8, hg = c8 >> 9; const size_t e = (size_t)t * 2048 + c8;
        const float inv = rsqrtf(fsm[F_SSQ_OG + (size_t)t * 4 + hg] * (1.f / 512.f) + EPS);
        const u32x4 wm = *(const u32x4*)(ZGM + e), wg = *(const u32x4*)(ZGG + e), wo = *(const u32x4*)(ZOG + e), wv = *(const u32x4*)(ZV + e);
        const f32x4 g0 = *(const f32x4*)(gn + (c8 & 511)), g1 = *(const f32x4*)(gn + (c8 & 511) + 4);
        const float m[8] = {bflo(wm.x), bfhi(wm.x), bflo(wm.y), bfhi(wm.y), bflo(wm.z), bfhi(wm.z), bflo(wm.w), bfhi(wm.w)};
        const float gg[8] = {bflo(wg.x), bfhi(wg.x), bflo(wg.y), bfhi(wg.y), bflo(wg.z), bfhi(wg.z), bflo(wg.w), bfhi(wg.w)};
        const float og[8] = {bflo(wo.x), bfhi(wo.x), bflo(wo.y), bfhi(wo.y), bflo(wo.z), bfhi(wo.z), bflo(wo.w), bfhi(wo.w)};
        const float ov[8] = {bflo(wv.x), bfhi(wv.x), bflo(wv.y), bfhi(wv.y), bflo(wv.z), bfhi(wv.z), bflo(wv.w), bfhi(wv.w)};
        const float gnv[8] = {g0[0], g0[1], g0[2], g0[3], g1[0], g1[1], g1[2], g1[3]};
        float r[8];
#pragma unroll
        for (int k = 0; k < 8; ++k) r[k] = m[k] + sigmoidf_(gg[k]) * (og[k] * sigmoidf_(og[k])) * (ov[k] * inv * gnv[k]);
        u32x4 o = {pk2(r[0], r[1]), pk2(r[2], r[3]), pk2(r[4], r[5]), pk2(r[6], r[7])}; *(u32x4*)(ZOG + e) = o; }
}

#ifndef N_LAUNCHES
#define N_LAUNCHES 1
#endif
constexpr int N_PHASES = 14;

__device__ __forceinline__ att::BlockRef att_ref(Frame& F, int h, int qb) {
    att::BlockRef r;
    r.Q = (const bf16_t*)(F.ws + WS_R1) + ((size_t)h * NTOK + (size_t)qb * 256) * 192;
    r.K = (const bf16_t*)(F.out + O_Y) + (size_t)h * SEQ * 192;
    r.V = (const bf16_t*)(F.ws + WS_R2) + (size_t)h * SEQ * 128;
    r.G = (bf16_t*)(F.ws + WS_ZGM) + (size_t)qb * 256 * 2048 + h * 128;
    r.qb = qb; return r;
}
__device__ __forceinline__ void p4_attention(Frame& F) {
    const int nblk = 512;
    int n = F.vcu * 2; if (n >= nblk) return;
    att::Seam S;
    att::BlockRef cur = att_ref(F, n >> 5, (n & 1) ? 31 - ((n >> 1) & 15) : ((n >> 1) & 15));
    att::prime(cur, (char*)F.lds, S);
    for (;;) {
        int nn = (n & 1) ? (n - 1 + 2 * F.G) : n + 1;
        const bool last = nn >= nblk;
        const att::BlockRef nxt = last ? cur : att_ref(F, nn >> 5, (nn & 1) ? 31 - ((nn >> 1) & 15) : ((nn >> 1) & 15));
        att::block(cur, nxt, (char*)F.lds, S);
        if (last) break;
        cur = nxt; n = nn;
    }
}

struct Args { const float* in[22]; float* out; unsigned char* ws; float freq[32]; int ph_lo, ph_hi, li, pad; };

__global__ void __launch_bounds__(512, 2) mega_fwd(Args args) {
    extern __shared__ __attribute__((aligned(16))) unsigned char lds_raw[];
    Frame F;
    F.lds = (LAS unsigned char*)lds_raw; F.ws = args.ws; F.out = args.out; F.in = args.in;
    F.tid = threadIdx.x; F.lane = F.tid & 63; F.wave = __builtin_amdgcn_readfirstlane(F.tid >> 6);
    F.G = gridDim.x; { const int bx = blockIdx.x; F.vcu = (F.G % 8 == 0) ? (bx % 8) * (F.G / 8) + bx / 8 : bx; }
    volatile LAS unsigned* MISC = (volatile LAS unsigned*)(F.lds + MISC_OFF);
    for (int u = F.tid; u < (LDS_BYTES - LDSCTL_OFF) / 4; u += 512) ((LAS unsigned*)(F.lds + LDSCTL_OFF))[u] = 0u;
    __syncthreads();
    XcdBarrier bar; bar.bar = (unsigned*)(F.ws + WS_CTL) + 4096; bar.x = 0; bar.st = nullptr;
    if (N_LAUNCHES == 1) bar = xcd_barrier_post((unsigned*)(F.ws + WS_CTL) + 4096, MISC + 8);
    EP ep; ep.ws = F.ws; ep.out = F.out; ep.xp = args.in[0]; ep.xs = args.in[1];
    const int lo = args.ph_lo, hi = args.ph_hi;
#ifndef PH_MASK
#define PH_MASK 0xffffffff
#endif
#define IN(k) ((((unsigned)PH_MASK >> (k)) & 1u) && lo <= (k) && (k) < hi)
#define SEAM(k) do { if (IN(k) && IN((k) + 1)) xcd_barrier(bar); { int t_ = threadIdx.x; asm volatile("" : "+v"(t_)); F.tid = t_; F.lane = t_ & 63; } } while (0)
    int rot = 0;
    if (IN(0)) {
        p0_prologue(F);
        { float* cs = (float*)(F.ws + WS_FSM) + F_ROPE; const int gt = (F.vcu * 8 + F.wave) * 64 + F.lane;
          for (int i = gt; i < SEQ * 32; i += F.G * 512) { const int p = i >> 5, k = i & 31;
              const float ang = (float)p * args.freq[k];
              const double xd = (double)ang; const double kq = __builtin_rint(xd * 0.63661977236758134308); const float r = (float)(xd - kq * 1.57079632679489661923);
              const float sr = __sinf(r), cr = __cosf(r); const int q = ((int)kq) & 3;
              const float c = (q == 0) ? cr : (q == 1) ? -sr : (q == 2) ? -cr : sr;
              const float s = (q == 0) ? sr : (q == 1) ? cr : (q == 2) ? -sr : -cr;
              cs[p * 64 + k] = c; cs[p * 64 + 32 + k] = s; } }
    }
    SEAM(0);
    if (IN(1)) { rot = 0; run_gemm<M_INPROJ>(F, ep, 33 * 45, 4096, 4096, 32, 32, rot); }
    SEAM(1);
    if (IN(2)) { rot = 0; run_gemm<M_QUP>(F, ep, 33 * 12, 2048, 1024, 8, 8, rot); run_gemm<M_KVUP>(F, ep, 33 * 16, 2048, 1024, 8, 8, rot); p2_ckv_krope(F); }
    SEAM(2);
    if (IN(3)) { p3_finalize_qk(F); p3_kcat_ct(F); p3_gla_prep(F); }
    SEAM(3);
    if (IN(4)) { rot = 0; p4_attention(F); run_gemm<M_QABS>(F, ep, 32, 512, 512, 4, 4, rot); run_gemm<M_CNORM>(F, ep, 144 * 8, 1280, 1024, 8, 8, rot); }
    SEAM(4);
    if (IN(5)) { rot = 0; run_gemm<M_S>(F, ep, 144, 1280, 1280, 10, 10, rot); run_gemm<M_GLA_A>(F, ep, 128, 512, 512, 4, 4, rot); run_gemm<M_GLA_DS>(F, ep, 256, 512, 512, 4, 4, rot); }
    SEAM(5);
    if (IN(6)) { p6_softmax_scan(F); }
    SEAM(6);
    if (IN(7)) { rot = 0; run_gemm<M_PC>(F, ep, 96, 4608, 4608, 12, 12, rot); run_gemm<M_GLA_O>(F, ep, 256, 512, 512, 8, 4, rot); }
    SEAM(7);
    if (IN(8)) { p8_pc_convert(F); }
    SEAM(8);
    if (IN(9)) { rot = 0; run_gemm<M_O>(F, ep, 16, 1024, 1024, 8, 8, rot); p9_gla_sample(F); p9_ffn_weights(F); }
    SEAM(9);
    if (IN(10)) { p10_mix(F); }
    SEAM(10);
    if (IN(11)) { rot = 0; run_gemm<M_WO>(F, ep, 33 * 8, 4096, 4096, 32, 32, rot); }
    SEAM(11);
    if (IN(12)) { rot = 0; run_gemm<M_UP>(F, ep, 33 * 32, 4096, 4096, 32, 32, rot); }
    SEAM(12);
    if (IN(13)) { rot = 0; run_gemm<M_DOWN>(F, ep, 33 * 8, 16384, 16384, 128, 128, rot); }
#undef IN
#undef SEAM
}

extern "C" void kernel_launch(void* const* d_in, const int* in_sizes, int n_in, void* d_out, int out_size, void* d_ws, size_t ws_size, hipStream_t stream) {
    static int grid = 0;
    if (grid == 0) {
        if (n_in != 22 || out_size != (int)O_END || ws_size < WS_END) { fprintf(stderr, "kernel_launch: unexpected shapes (n_in %d out %d ws %zu)\n", n_in, out_size, ws_size); grid = -1; return; }
        int dev = 0, cus = 0, per_cu = 0;
        if (hipGetDevice(&dev) != hipSuccess || hipDeviceGetAttribute(&cus, hipDeviceAttributeMultiprocessorCount, dev) != hipSuccess) { grid = -1; return; }
        if (hipFuncSetAttribute((const void*)mega_fwd, hipFuncAttributeMaxDynamicSharedMemorySize, LDS_BYTES) != hipSuccess) { fprintf(stderr, "kernel_launch: hipFuncSetAttribute failed\n"); grid = -1; return; }
        if (hipOccupancyMaxActiveBlocksPerMultiprocessor(&per_cu, (const void*)mega_fwd, 512, LDS_BYTES) != hipSuccess || per_cu < 1) { fprintf(stderr, "kernel_launch: occupancy query says %d blocks per CU\n", per_cu); (void)hipGetLastError(); grid = -1; return; }
        grid = cus;
    }
    if (grid < 0) return;
    (void)hipMemsetAsync((char*)d_ws + WS_CTL, 0, CTL_BYTES, stream);
    Args a{};
    for (int i = 0; i < 22; ++i) a.in[i] = (const float*)d_in[i];
    a.out = (float*)d_out; a.ws = (unsigned char*)d_ws;
    for (int k = 0; k < 32; ++k) a.freq[k] = powf(10000.f, -(float)k / 32.f);
    if (N_LAUNCHES == 1) { a.ph_lo = 0; a.ph_hi = N_PHASES; a.li = 0; hipLaunchKernelGGL(mega_fwd, dim3(grid), dim3(512), LDS_BYTES, stream, a); }
    else { for (int p = 0; p < N_PHASES; ++p) { a.ph_lo = p; a.ph_hi = p + 1; a.li = p; hipLaunchKernelGGL(mega_fwd, dim3(grid), dim3(512), LDS_BYTES, stream, a); } }
}
```

```cpp
#include <hip/hip_runtime.h>
#include <hip/hip_bf16.h>
#include <cstdio>
#include <cstdint>

#define LAS __attribute__((address_space(3)))
#define GAS __attribute__((address_space(1)))
typedef unsigned short bf16_t;
typedef short bf16x8 __attribute__((ext_vector_type(8)));
typedef short s16x4 __attribute__((ext_vector_type(4)));
typedef float f32x4 __attribute__((ext_vector_type(4)));
typedef float f32x2 __attribute__((ext_vector_type(2)));
typedef float f32x16 __attribute__((ext_vector_type(16)));
typedef unsigned u32x4 __attribute__((ext_vector_type(4)));
typedef unsigned u32x2 __attribute__((ext_vector_type(2)));

constexpr int DM = 2048, SEQ = 8192, NSAMP = 256, NTOK = 8448, NZ = 11520, DFF = 8192, DIN = 11344;
constexpr int NH = 16, QKD = 192, NOPE = 128, ROPE = 64, VD = 128, QR = 512, KVR = 512;
constexpr int GH = 4, GDK = 256, GDV = 512, GC = 256, NCH = 32;
constexpr int PAST = 2048, NKEY = 2064, NKP = 2304, DQC = 640, DECB = 16, DECS = 16;
constexpr float EPS = 1e-6f;
constexpr float LOG2E = 1.4426950408889634f;
constexpr float MLA_SCALE = 0.07216878364870322f;

constexpr size_t MiB = 1u << 20;
constexpr size_t WS_CTL = 0, CTL_BYTES = 1 * MiB;
constexpr size_t WS_FSM = 1 * MiB;
constexpr size_t WS_WSM = 7 * MiB;
constexpr size_t WS_ZL = 30 * MiB, WS_ZM = 47 * MiB, WS_ZQK = 52 * MiB, WS_ZV = 85 * MiB, WS_ZOG = 118 * MiB, WS_ZGM = 151 * MiB, WS_ZGG = 184 * MiB;
constexpr size_t WS_R1 = 217 * MiB, WS_R2 = 267 * MiB, WS_R3 = 300 * MiB, WS_R4 = 345 * MiB, WS_R5 = 381 * MiB, WS_END = 413 * MiB;
constexpr size_t F_SSQ_QL = 0  , F_SSQ_KV = F_SSQ_QL + 16896  , F_SSQ_X1 = F_SSQ_KV + 16896  , F_KRSS = F_SSQ_X1 + 67584, F_SSQ_K = F_KRSS + 8448  ,
                 F_SSQ_OG = F_SSQ_K + 135168  , F_KNSS_C = F_SSQ_OG + 67584, F_KRSS_C = F_KNSS_C + 589824, F_GAMMA = F_KRSS_C + 36864, F_ROPE = F_GAMMA + 32768, F_END = F_ROPE + 524288;
static_assert(F_END * 4 <= 6 * MiB, "FSM");
constexpr size_t W_UQ = 0, W_UKVG = W_UQ + 3072 * 512, W_KNP = W_UKVG + 4096 * 512, W_VP = W_KNP + 2048 * 512, W_KNABS = W_VP + 2048 * 512, W_O = W_KNABS + 16 * 512 * 256, W_END = W_O + 2048 * 2048;
static_assert(W_END * 2 <= 23 * MiB, "WSM");
constexpr size_t O_Y = 0, O_CKVP = 17301504, O_KRP = 21495808, O_STP = 22020096, O_CKVS = 22544384, O_KRS = 22675456, O_STS = 22691840, O_END = 31080448;

#define RLX_AGENT __ATOMIC_RELAXED, __HIP_MEMORY_SCOPE_AGENT
__device__ __forceinline__ unsigned cvt_pk_bf16(float lo, float hi) { unsigned r; asm volatile("v_cvt_pk_bf16_f32 %0, %1, %2" : "=v"(r) : "v"(lo), "v"(hi)); return r; }
__device__ __forceinline__ float bf2f(unsigned short b) { return __uint_as_float(((unsigned)b) << 16); }
__device__ __forceinline__ float bflo(unsigned w) { return __uint_as_float(w << 16); }
__device__ __forceinline__ float bfhi(unsigned w) { return __uint_as_float(w & 0xffff0000u); }
__device__ __forceinline__ unsigned short f2bf(float f) { return (unsigned short)(cvt_pk_bf16(f, 0.f) & 0xffffu); }
__device__ __forceinline__ float sigmoidf_(float x) { return 1.f / (1.f + __expf(-x)); }
__device__ __forceinline__ float wave_sum(float v) {
#pragma unroll
    for (int o = 1; o < 64; o <<= 1) v += __shfl_xor(v, o);
    return v;
}
__device__ __forceinline__ float wave_max(float v) {
#pragma unroll
    for (int o = 1; o < 64; o <<= 1) v = fmaxf(v, __shfl_xor(v, o));
    return v;
}

#define XB_TMO      128
#define XB_XCNT(j)  (256  + 64 * (j))
#define XB_XSUB(j)  (1280 + 64 * (j))
#define XB_XGEN(j)  (2304 + 64 * (j))
#define XB_TOP      3328
#define XB_TOPGEN   3392
#define XCD_BAR_WORDS 3456
#define XB_SPIN_CAP (1u << 22)
__device__ __forceinline__ unsigned xb_ld(unsigned* p)              { return __hip_atomic_load(p, __ATOMIC_RELAXED, __HIP_MEMORY_SCOPE_AGENT); }
__device__ __forceinline__ unsigned xb_add(unsigned* p, unsigned v) { return __hip_atomic_fetch_add(p, v, __ATOMIC_RELAXED, __HIP_MEMORY_SCOPE_AGENT); }
__device__ __forceinline__ unsigned xb_xcc_id() { return (unsigned)__builtin_amdgcn_s_getreg((3 << 11) | 20) & 0xFu; }
#define XB_SPIN(cond, bar) do { unsigned _sp = 0; while (cond) { __builtin_amdgcn_s_sleep(1); \
    if ((++_sp & 255u) == 0u) { if (xb_ld(&(bar)[XB_TMO])) break; if (_sp > XB_SPIN_CAP) { atomicAdd(&(bar)[XB_TMO], 1u); break; } } } } while (0)
struct XcdBarrier { unsigned* bar; unsigned x; volatile LAS unsigned* st; };
__device__ __forceinline__ XcdBarrier xcd_barrier_post(unsigned* bar, volatile LAS unsigned* st) {
    XcdBarrier b; b.bar = bar; b.x = xb_xcc_id(); b.st = st;
    if (threadIdx.x == 0) (void)xb_add(&bar[XB_XCNT(b.x)], 1u);
    return b;
}
__device__ __forceinline__ void xcd_barrier_complete(unsigned* bar, unsigned x, unsigned& nloc, unsigned& nx) {
    const unsigned G = gridDim.x * gridDim.y * gridDim.z;
    unsigned sum, cnt, mine, sp = 0u;
    for (;;) {
        sum = 0u; cnt = 0u; mine = 0u;
#pragma unroll
        for (unsigned j = 0; j < 16; ++j) { const unsigned c = xb_ld(&bar[XB_XCNT(j)]); sum += c; cnt += (c > 0u) ? 1u : 0u; mine = (j == x) ? c : mine; }
        if (sum == G) break;
        __builtin_amdgcn_s_sleep(1);
        if ((++sp & 255u) == 0u) { if (xb_ld(&bar[XB_TMO])) break; if (sp > XB_SPIN_CAP) { atomicAdd(&bar[XB_TMO], 1u); break; } }
    }
    nloc = mine > 0u ? mine : 1u; nx = cnt > 0u ? cnt : 1u;
}
__device__ __forceinline__ void xcd_barrier(const XcdBarrier& b) {
    asm volatile("s_waitcnt vmcnt(0)" ::: "memory");
    __syncthreads();
    if (threadIdx.x == 0) {
        unsigned* bar = b.bar;
        __builtin_amdgcn_s_waitcnt(0);
        unsigned nloc = b.st[0], nx = b.st[1];
        if (nloc == 0u) { xcd_barrier_complete(bar, b.x, nloc, nx); b.st[0] = nloc; b.st[1] = nx; }
        const unsigned old = xb_add(&bar[XB_XSUB(b.x)], 1u);
        const unsigned gen = old / nloc;
        if (old + 1u == (gen + 1u) * nloc) {
            __builtin_amdgcn_fence(__ATOMIC_RELEASE, "agent");
            asm volatile("s_waitcnt vmcnt(0)" ::: "memory");
            const unsigned og = xb_add(&bar[XB_TOP], 1u);
            const unsigned tg = og / nx;
            if (og + 1u == (tg + 1u) * nx) xb_add(&bar[XB_TOPGEN], 1u);
            else XB_SPIN(xb_ld(&bar[XB_TOPGEN]) == tg, bar);
            __builtin_amdgcn_fence(__ATOMIC_ACQUIRE, "agent");
            xb_add(&bar[XB_XGEN(b.x)], 1u);
            asm volatile("s_waitcnt vmcnt(0)" ::: "memory");
        } else {
            XB_SPIN(xb_ld(&bar[XB_XGEN(b.x)]) == gen, bar);
            __builtin_amdgcn_fence(__ATOMIC_ACQUIRE, "agent");
            asm volatile("s_waitcnt vmcnt(0)" ::: "memory");
        }
    }
    __syncthreads();
}

constexpr int RING_BYTES = 131072, LDSCTL_OFF = RING_BYTES, MISC_OFF = LDSCTL_OFF + 320, LDS_BYTES = 147456;

struct Frame {
    LAS unsigned char* lds; unsigned char* ws; float* out; const float* const* in;
    int tid, lane, wave, vcu, G;
};

namespace pg8 {
constexpr int BM = 256, BK = 64, HALF = 128, HTB = HALF * BK * 2, STAGE_BYTES = 8 * HTB;
__device__ __forceinline__ int lds_byte(int r, int c) { const int st = (r >> 4) * 2 + (c >> 5), rr = r & 15, cc = c & 31, ob = rr * 64 + cc * 2; return st * 1024 + (ob ^ (((ob >> 9) & 1) << 5)); }
__device__ __forceinline__ void stage_rc(int b, int& R, int& C) { const int st = b / 1024, sb = b % 1024, swz = sb ^ (((sb >> 9) & 1) << 5); R = (st >> 1) * 16 + swz / 64; C = (st & 1) * 32 + (swz % 64) / 2; }
__device__ __forceinline__ int perm32(int rho) { const int n = rho >> 4, i = rho & 15; return 8 * (i >> 2) + 4 * n + (i & 3); }

struct GUnit { const char* A; const char* B; int pm, pn, aux; };
struct GCfg { unsigned lda, ldb; int nt, t1; };

typedef f32x4 Acc[2][2][4][2];

template <class Epi, class Sched>
__device__ __forceinline__ void gemm_phase(LAS unsigned char* lds, const GCfg g, const Sched& S, const Epi& E) {
    int tid_ = threadIdx.x; asm volatile("" : "+v"(tid_));
    const int tid = tid_, wid = __builtin_amdgcn_readfirstlane(tid >> 6), lane = tid & 63, wr = wid >> 2, wc = wid & 3, fr = lane & 15, fq = lane >> 4;
    const int nt = g.nt;
    unsigned voffA[2], voffB[2];
#pragma unroll
    for (int i = 0; i < 2; ++i) { int R, C; stage_rc(tid * 16 + i * 8192, R, C); const int Rb = (R & ~31) + perm32(R & 31);
        voffA[i] = (unsigned)R * g.lda + (unsigned)C * 2u; voffB[i] = (unsigned)Rb * g.ldb + (unsigned)C * 2u; }
    const size_t kstep = (size_t)(BK * 2);
    const size_t hstepA = (size_t)HALF * g.lda, hstepB = (size_t)HALF * g.ldb;
    const unsigned ldsw = (unsigned)wid * 1024u;
    const int aoff = lds_byte(wr * 64 + fr, fq * 8), boff = lds_byte(wc * 32 + fr, fq * 8);
#define PG8_SA(b, h) (((b) * 2 + (h)) * HTB)
#define PG8_SB(b, h) ((4 + (b) * 2 + (h)) * HTB)
#define PG8_STAGE(bufoff, gbase, voff) do { _Pragma("unroll") for (int _i = 0; _i < 2; ++_i) \
        __builtin_amdgcn_global_load_lds((const unsigned*)((const char*)(gbase) + (voff)[_i]), (LAS unsigned*)(lds + (bufoff) + ldsw + _i * 8192), 16, 0, 0); } while (0)
#define PG8_LDA(dst, b, h) do { _Pragma("unroll") for (int m = 0; m < 4; ++m) _Pragma("unroll") for (int k = 0; k < 2; ++k) dst[m][k] = *(const LAS bf16x8*)(lds + PG8_SA(b, h) + aoff + m * 2048 + k * 1024); } while (0)
#define PG8_LDB(dst, b, h) do { _Pragma("unroll") for (int n = 0; n < 2; ++n) _Pragma("unroll") for (int k = 0; k < 2; ++k) dst[n][k] = *(const LAS bf16x8*)(lds + PG8_SB(b, h) + boff + n * 2048 + k * 1024); } while (0)
#define PG8_MMA(ai, bj, At, Bt) do { __builtin_amdgcn_s_setprio(1); _Pragma("unroll") for (int m = 0; m < 4; ++m) _Pragma("unroll") for (int n = 0; n < 2; ++n) _Pragma("unroll") for (int k = 0; k < 2; ++k) \
        acc[ai][bj][m][n] = __builtin_amdgcn_mfma_f32_16x16x32_bf16(Bt[n][k], At[m][k], acc[ai][bj][m][n], 0, 0, 0); __builtin_amdgcn_s_setprio(0); } while (0)
#define PG8_WAIT_V(n) asm volatile("s_waitcnt vmcnt(" #n ")" ::: "memory")
#define PG8_WAIT_L(n) asm volatile("s_waitcnt lgkmcnt(" #n ")" ::: "memory")
#define PG8_BAR __builtin_amdgcn_s_barrier()
#define PG8_SCHED __builtin_amdgcn_sched_barrier(0)
#define PG8_APTR(u, t) ((u).A + (size_t)(t) * kstep)
#define PG8_BPTR(u, t) ((u).B + (size_t)(t) * kstep)
    GUnit cur, nxt; int ui = 0;
    if (!S.next(0, cur)) return;
    Acc acc;
#pragma unroll
    for (int a = 0; a < 2; ++a)
#pragma unroll
        for (int b = 0; b < 2; ++b)
#pragma unroll
            for (int m = 0; m < 4; ++m)
#pragma unroll
                for (int n = 0; n < 2; ++n) acc[a][b][m][n] = (f32x4){0.f, 0.f, 0.f, 0.f};
    bf16x8 At[4][2], B0[2][2], B1[2][2];
    {
        const char* cA = cur.A; const char* cB = cur.B;
        PG8_STAGE(PG8_SB(0, 0), cB, voffB); PG8_STAGE(PG8_SB(0, 1), cB + hstepB, voffB); PG8_STAGE(PG8_SA(0, 0), cA, voffA); PG8_STAGE(PG8_SA(0, 1), cA + hstepA, voffA);
        if (wr == 1) PG8_BAR;
        PG8_WAIT_V(2); PG8_BAR;
        PG8_STAGE(PG8_SB(1, 0), cB + kstep, voffB); PG8_STAGE(PG8_SA(1, 0), cA + kstep, voffA); PG8_STAGE(PG8_SB(1, 1), cB + hstepB + kstep, voffB);
        PG8_WAIT_V(6); PG8_BAR;
    }
    for (;;) {
        const bool has_next = S.next(ui + 1, nxt);
        if (!has_next) nxt = cur;
        for (int t = 0; t < nt; t += 2) {
            const bool last = (t == nt - 2);
            const char* a1 = PG8_APTR(cur, t + 1);
            const char* a2 = last ? nxt.A : PG8_APTR(cur, t + 2); const char* b2 = last ? nxt.B : PG8_BPTR(cur, t + 2);
            const char* a3 = last ? nxt.A + kstep : PG8_APTR(cur, t + 3); const char* b3 = last ? nxt.B + kstep : PG8_BPTR(cur, t + 3);
            PG8_LDB(B0, 0, 0); PG8_LDB(B1, 0, 1); PG8_SCHED; PG8_LDA(At, 0, 0); PG8_STAGE(PG8_SA(1, 1), a1 + hstepA, voffA);
            PG8_WAIT_V(8); PG8_WAIT_L(0); PG8_BAR; PG8_MMA(0, 0, At, B0); PG8_MMA(0, 1, At, B1); PG8_BAR; PG8_SCHED;
            PG8_LDA(At, 0, 1); PG8_STAGE(PG8_SB(0, 0), b2, voffB); PG8_STAGE(PG8_SB(0, 1), b2 + hstepB, voffB); PG8_STAGE(PG8_SA(0, 0), a2, voffA);
            PG8_WAIT_V(8); PG8_WAIT_L(0); PG8_BAR; PG8_MMA(1, 0, At, B0); PG8_MMA(1, 1, At, B1); PG8_BAR; PG8_SCHED;
            PG8_LDB(B0, 1, 0); PG8_LDB(B1, 1, 1); PG8_SCHED; PG8_LDA(At, 1, 0); PG8_STAGE(PG8_SA(0, 1), a2 + hstepA, voffA);
            PG8_WAIT_V(8); PG8_WAIT_L(0); PG8_BAR; PG8_MMA(0, 0, At, B0); PG8_MMA(0, 1, At, B1); PG8_BAR; PG8_SCHED;
            PG8_LDA(At, 1, 1); PG8_STAGE(PG8_SB(1, 0), b3, voffB); PG8_STAGE(PG8_SB(1, 1), b3 + hstepB, voffB); PG8_STAGE(PG8_SA(1, 0), a3, voffA);
            PG8_WAIT_V(8); PG8_WAIT_L(0); PG8_BAR; PG8_MMA(1, 0, At, B0); PG8_MMA(1, 1, At, B1); PG8_BAR; PG8_SCHED;
        }
        if (wr == 0) PG8_BAR;
        { int fr_ = fr, fq_ = fq; asm volatile("" : "+v"(fr_), "+v"(fq_));
          E(acc, cur, wr, wc, fr_, fq_); }
        if (!has_next) break;
#pragma unroll
        for (int a = 0; a < 2; ++a)
#pragma unroll
            for (int b = 0; b < 2; ++b)
#pragma unroll
                for (int m = 0; m < 4; ++m)
#pragma unroll
                    for (int n = 0; n < 2; ++n) acc[a][b][m][n] = (f32x4){0.f, 0.f, 0.f, 0.f};
        cur = nxt; ++ui;
        if (wr == 1) PG8_BAR;
    }
    PG8_WAIT_V(0);
    PG8_BAR;
#undef PG8_SA
#undef PG8_SB
#undef PG8_STAGE
#undef PG8_LDA
#undef PG8_LDB
#undef PG8_MMA
#undef PG8_WAIT_V
#undef PG8_WAIT_L
#undef PG8_BAR
#undef PG8_SCHED
#undef PG8_APTR
#undef PG8_BPTR
}

__device__ __forceinline__ void tile_of(int L, int nM, int nN, int& pm, int& pn) {
    const int nig = 8 * nN, gid = L / nig, fm = gid * 8, gsz = (nM - fm) < 8 ? (nM - fm) : 8, r = L % nig;
    pm = fm + r % gsz; pn = r / gsz;
}
}

enum { M_INPROJ = 0, M_QUP, M_KVUP, M_CNORM, M_QABS, M_S, M_PC, M_O, M_GLA_A, M_GLA_DS, M_GLA_O, M_GLA_O2, M_WO, M_UP, M_DOWN, M_WO_S, M_UP_S, M_DOWN_S };

struct EP { unsigned char* ws; float* out; const float* xp; const float* xs; LAS unsigned char* lds; int dry; };
constexpr int EPI_RED_OFF = 131072 + 1024;

__device__ __forceinline__ u32x4 pack8(const f32x4 v0, const f32x4 v1) {
    u32x4 w; w.x = cvt_pk_bf16(v0[0], v0[1]); w.y = cvt_pk_bf16(v0[2], v0[3]); w.z = cvt_pk_bf16(v1[0], v1[1]); w.w = cvt_pk_bf16(v1[2], v1[3]); return w;
}
__device__ __forceinline__ float sumsq8(const f32x4 a, const f32x4 b) {
    return (a[0] * a[0] + a[1] * a[1]) + (a[2] * a[2] + a[3] * a[3]) + (b[0] * b[0] + b[1] * b[1]) + (b[2] * b[2] + b[3] * b[3]);
}
__device__ __forceinline__ float red_fq(float s) { s += __shfl_xor(s, 16); s += __shfl_xor(s, 32); return s; }


__device__ __forceinline__ void epi_red_put(LAS unsigned char* lds, int slot, const float (&part)[2][4], int rt0, int wc, int fq) {
    LAS float* red = (LAS float*)(lds + EPI_RED_OFF) + slot * 1024;
    if (fq == 0) {
#pragma unroll
        for (int ai = 0; ai < 2; ++ai)
#pragma unroll
            for (int m = 0; m < 4; ++m) red[(rt0 + ai * 128 + m * 16) * 4 + wc] = part[ai][m];
    }
}
__device__ __forceinline__ void epi_red_sync() { asm volatile("s_waitcnt lgkmcnt(0)" ::: "memory"); __builtin_amdgcn_s_barrier(); asm volatile("" ::: "memory"); }
__device__ __forceinline__ float epi_red_get(LAS unsigned char* lds, int slot, int row) {
    const LAS f32x4* red = (const LAS f32x4*)(lds + EPI_RED_OFF) + slot * 256; const f32x4 v = red[row]; return (v[0] + v[1]) + (v[2] + v[3]);
}

template <int MODE> struct Epi {
    EP p;
    __device__ __forceinline__ void operator()(const pg8::Acc& acc, const pg8::GUnit& u, int wr, int wc, int fr, int fq) const {
        unsigned char* ws = p.ws;
        float* fsm = (float*)(ws + WS_FSM);
#ifdef PROBE
        if (p.dry) {
#pragma unroll
            for (int a = 0; a < 2; ++a)
#pragma unroll
                for (int b = 0; b < 2; ++b)
#pragma unroll
                    for (int m = 0; m < 4; ++m) asm volatile("" :: "v"(acc[a][b][m][0]), "v"(acc[a][b][m][1]));
            return; }
#endif
        const int rt0 = wr * 64 + fr;
        const int ct0 = wc * 32 + 8 * fq;
        if constexpr (MODE == M_INPROJ) {
            const int pn = u.pn; bf16_t* base; int ld;
            if (pn < 4) { base = (bf16_t*)(ws + WS_ZL) + pn * 256; ld = 1024; }
            else if (pn < 12) { base = (bf16_t*)(ws + WS_ZQK) + (pn - 4) * 256; ld = 2048; }
            else if (pn < 20) { base = (bf16_t*)(ws + WS_ZV) + (pn - 12) * 256; ld = 2048; }
            else if (pn < 28) { base = (bf16_t*)(ws + WS_ZOG) + (pn - 20) * 256; ld = 2048; }
            else if (pn < 36) { base = (bf16_t*)(ws + WS_ZGM) + (pn - 28) * 256; ld = 2048; }
            else if (pn < 44) { base = (bf16_t*)(ws + WS_ZGG) + (pn - 36) * 256; ld = 2048; }
            else { base = (bf16_t*)(ws + WS_ZM); ld = 256; }
            float part[2][4];
#pragma unroll
            for (int ai = 0; ai < 2; ++ai)
#pragma unroll
                for (int m = 0; m < 4; ++m) {
                    const int row = u.pm * 256 + rt0 + ai * 128 + m * 16;
                    bf16_t* rowp = base + (size_t)row * ld + ct0;
                    *(u32x4*)(rowp) = pack8(acc[ai][0][m][0], acc[ai][0][m][1]);
                    *(u32x4*)(rowp + 128) = pack8(acc[ai][1][m][0], acc[ai][1][m][1]);
                    part[ai][m] = red_fq(sumsq8(acc[ai][0][m][0], acc[ai][0][m][1]) + sumsq8(acc[ai][1][m][0], acc[ai][1][m][1]));
                }
            if (pn < 4) {
                epi_red_put(p.lds, 0, part, rt0, wc, fq); epi_red_sync();
                const int tid = threadIdx.x;
                if (tid < 256) fsm[(pn < 2 ? F_SSQ_QL : F_SSQ_KV) + (size_t)(u.pm * 256 + tid) * 2 + (pn & 1)] = epi_red_get(p.lds, 0, tid);
            }
        } else if constexpr (MODE == M_QUP) {
            bf16_t* Qp = (bf16_t*)(ws + WS_R1);
            float* ssq = (float*)((char*)(p.out + O_Y) + 56 * MiB);
#pragma unroll
            for (int bj = 0; bj < 2; ++bj) {
                const int c = u.pn * 256 + bj * 128 + ct0, h = c / 192, j = c - h * 192;
                const int grp = u.pn * 8 + bj * 4 + wc;
#pragma unroll
                for (int ai = 0; ai < 2; ++ai)
#pragma unroll
                    for (int m = 0; m < 4; ++m) {
                        const int row = u.pm * 256 + rt0 + ai * 128 + m * 16;
                        *(u32x4*)(Qp + ((size_t)h * NTOK + row) * 192 + j) = pack8(acc[ai][bj][m][0], acc[ai][bj][m][1]);
                        float s = red_fq(sumsq8(acc[ai][bj][m][0], acc[ai][bj][m][1]));
                        if (fq == 0) ssq[(size_t)row * 96 + grp] = s;
                    }
            }
        } else if constexpr (MODE == M_KVUP) {
            bf16_t* Kp = (bf16_t*)(p.out + O_Y); bf16_t* Vp = (bf16_t*)(ws + WS_R2);
            const float* ssq_kv = fsm + F_SSQ_KV; float* ssq_k = fsm + F_SSQ_K;
            const int h = u.pn; float part[2][4];
#pragma unroll
            for (int ai = 0; ai < 2; ++ai)
#pragma unroll
                for (int m = 0; m < 4; ++m) {
                    const int row = u.pm * 256 + rt0 + ai * 128 + m * 16;
                    const f32x2 sq = *(const f32x2*)(ssq_kv + (size_t)row * 2);
                    const float inv = rsqrtf((sq[0] + sq[1]) * (1.f / 512.f) + EPS);
                    const f32x4 k0 = acc[ai][0][m][0] * inv, k1 = acc[ai][0][m][1] * inv, v0 = acc[ai][1][m][0] * inv, v1 = acc[ai][1][m][1] * inv;
                    if (row < SEQ) {
                        *(u32x4*)(Kp + ((size_t)h * SEQ + row) * 192 + ct0) = pack8(k0, k1);
                        *(u32x4*)(Vp + ((size_t)h * SEQ + row) * 128 + ct0) = pack8(v0, v1);
                    }
                    part[ai][m] = red_fq(sumsq8(k0, k1));
                }
            epi_red_put(p.lds, 0, part, rt0, wc, fq); epi_red_sync();
            { const int tid = threadIdx.x; if (tid < 256) ssq_k[(size_t)(u.pm * 256 + tid) * 16 + h] = epi_red_get(p.lds, 0, tid); }
        } else if constexpr (MODE == M_CNORM) {
            float* knss = fsm + F_KNSS_C; float part[2][2][4];
#pragma unroll
            for (int bj = 0; bj < 2; ++bj)
#pragma unroll
                for (int ai = 0; ai < 2; ++ai)
#pragma unroll
                    for (int m = 0; m < 4; ++m) part[bj][ai][m] = red_fq(sumsq8(acc[ai][bj][m][0], acc[ai][bj][m][1]));
            epi_red_put(p.lds, 0, part[0], rt0, wc, fq); epi_red_put(p.lds, 1, part[1], rt0, wc, fq); epi_red_sync();
            { const int tid = threadIdx.x, row = tid & 255, bj = tid >> 8; knss[(size_t)(u.pm * 256 + row) * 16 + u.pn * 2 + bj] = epi_red_get(p.lds, bj, row); }
        } else if constexpr (MODE == M_QABS) {
            bf16_t* Qcat = (bf16_t*)(p.out + O_Y) + 48 * MiB / 2;
            const int h = u.aux;
#pragma unroll
            for (int ai = 0; ai < 2; ++ai)
#pragma unroll
                for (int m = 0; m < 4; ++m) {
                    const int r = rt0 + ai * 128 + m * 16, b = r >> 4, q = r & 15;
                    bf16_t* rowp = Qcat + ((size_t)b * 256 + h * 16 + q) * DQC + u.pn * 256 + ct0;
                    *(u32x4*)(rowp) = pack8(acc[ai][0][m][0], acc[ai][0][m][1]);
                    *(u32x4*)(rowp + 128) = pack8(acc[ai][1][m][0], acc[ai][1][m][1]);
                }
        } else if constexpr (MODE == M_S) {
            float* Sb = p.out + O_Y;
            const float* knss = fsm + F_KNSS_C; const float* krss = fsm + F_KRSS_C;
            const int b = u.aux;
#pragma unroll
            for (int ai = 0; ai < 2; ++ai)
#pragma unroll
                for (int m = 0; m < 4; ++m) {
                    const int r = rt0 + ai * 128 + m * 16, h = r >> 4;
#pragma unroll
                    for (int bj = 0; bj < 2; ++bj) {
                        const int k = u.pn * 256 + bj * 128 + ct0;
                        const size_t kr = (size_t)b * NKP + k;
                        f32x4 o0, o1;
#pragma unroll
                        for (int i = 0; i < 4; ++i) {
                            o0[i] = acc[ai][bj][m][0][i] * rsqrtf((knss[(kr + i) * 16 + h] + krss[kr + i]) * (1.f / 192.f) + EPS);
                            o1[i] = acc[ai][bj][m][1][i] * rsqrtf((knss[(kr + 4 + i) * 16 + h] + krss[kr + 4 + i]) * (1.f / 192.f) + EPS);
                        }
                        float* dst = Sb + ((size_t)b * 256 + r) * NKP + k;
                        *(f32x4*)dst = o0; *(f32x4*)(dst + 4) = o1;
                        asm volatile("" ::: "memory");
                    }
                }
        } else if constexpr (MODE == M_PC) {
            float* PCp = (float*)(ws + WS_R1);
            const int b = u.aux >> 2, ks = u.aux & 3;
#pragma unroll
            for (int ai = 0; ai < 2; ++ai)
#pragma unroll
                for (int m = 0; m < 4; ++m) {
                    const int r = rt0 + ai * 128 + m * 16, h = r >> 4, q = r & 15;
                    float* rowp = PCp + (((size_t)ks * 16 + h) * 256 + b * 16 + q) * 512 + u.pn * 256 + ct0;
#pragma unroll
                    for (int bj = 0; bj < 2; ++bj) { *(f32x4*)(rowp + bj * 128) = acc[ai][bj][m][0]; *(f32x4*)(rowp + bj * 128 + 4) = acc[ai][bj][m][1]; }
                }
        } else if constexpr (MODE == M_O) {
            bf16_t* Zgm = (bf16_t*)(ws + WS_ZGM);
            const int h = u.aux, bj = h & 1;
#pragma unroll
            for (int ai = 0; ai < 2; ++ai)
#pragma unroll
                for (int m = 0; m < 4; ++m) {
                    const int r = rt0 + ai * 128 + m * 16;
                    bf16_t* gp = Zgm + (size_t)(SEQ + r) * 2048 + h * 128 + ct0;
                    const u32x4 g = *(const u32x4*)gp;
                    const f32x4 a0 = bj ? acc[ai][1][m][0] : acc[ai][0][m][0], a1 = bj ? acc[ai][1][m][1] : acc[ai][0][m][1];
                    f32x4 o0, o1;
                    o0[0] = a0[0] * sigmoidf_(bflo(g.x)); o0[1] = a0[1] * sigmoidf_(bfhi(g.x)); o0[2] = a0[2] * sigmoidf_(bflo(g.y)); o0[3] = a0[3] * sigmoidf_(bfhi(g.y));
                    o1[0] = a1[0] * sigmoidf_(bflo(g.z)); o1[1] = a1[1] * sigmoidf_(bfhi(g.z)); o1[2] = a1[2] * sigmoidf_(bflo(g.w)); o1[3] = a1[3] * sigmoidf_(bfhi(g.w));
                    *(u32x4*)gp = pack8(o0, o1);
                }
        } else if constexpr (MODE == M_GLA_A) {
            bf16_t* Am = (bf16_t*)(ws + WS_ZQK) + (size_t)u.aux * 65536;
#pragma unroll
            for (int ai = 0; ai < 2; ++ai)
#pragma unroll
                for (int m = 0; m < 4; ++m) {
                    const int t = rt0 + ai * 128 + m * 16;
#pragma unroll
                    for (int bj = 0; bj < 2; ++bj) {
                        const int s0 = bj * 128 + ct0;
                        f32x4 a0 = acc[ai][bj][m][0], a1 = acc[ai][bj][m][1];
#pragma unroll
                        for (int i = 0; i < 4; ++i) { if (s0 + i > t) a0[i] = 0.f; if (s0 + 4 + i > t) a1[i] = 0.f; }
                        *(u32x4*)(Am + (size_t)t * 256 + s0) = pack8(a0, a1);
                        asm volatile("" ::: "memory");
                    }
                }
        } else if constexpr (MODE == M_GLA_DS) {
            bf16_t* dS = (bf16_t*)(ws + WS_R1) + (size_t)u.aux * 131072;
#pragma unroll
            for (int ai = 0; ai < 2; ++ai)
#pragma unroll
                for (int m = 0; m < 4; ++m) {
                    const int e = u.pm * 256 + rt0 + ai * 128 + m * 16;
                    bf16_t* rowp = dS + (size_t)e * 256 + ct0;
                    *(u32x4*)(rowp) = pack8(acc[ai][0][m][0], acc[ai][0][m][1]);
                    *(u32x4*)(rowp + 128) = pack8(acc[ai][1][m][0], acc[ai][1][m][1]);
                }
        } else if constexpr (MODE == M_GLA_O || MODE == M_GLA_O2) {
            bf16_t* Zv = (bf16_t*)(ws + WS_ZV); float* ssq = fsm + F_SSQ_OG;
            const int h = u.aux >> 5, c = u.aux & 31; float part[2][4];
#pragma unroll
            for (int ai = 0; ai < 2; ++ai)
#pragma unroll
                for (int m = 0; m < 4; ++m) {
                    const int t = c * 256 + rt0 + ai * 128 + m * 16;
                    bf16_t* rowp = Zv + (size_t)t * 2048 + h * 512 + u.pn * 256 + ct0;
                    f32x4 a0 = acc[ai][0][m][0], a1 = acc[ai][0][m][1], b0 = acc[ai][1][m][0], b1 = acc[ai][1][m][1];
                    if constexpr (MODE == M_GLA_O2) {
                        const u32x4 wa = *(const u32x4*)(rowp), wb = *(const u32x4*)(rowp + 128);
                        a0[0] += bflo(wa.x); a0[1] += bfhi(wa.x); a0[2] += bflo(wa.y); a0[3] += bfhi(wa.y); a1[0] += bflo(wa.z); a1[1] += bfhi(wa.z); a1[2] += bflo(wa.w); a1[3] += bfhi(wa.w);
                        b0[0] += bflo(wb.x); b0[1] += bfhi(wb.x); b0[2] += bflo(wb.y); b0[3] += bfhi(wb.y); b1[0] += bflo(wb.z); b1[1] += bfhi(wb.z); b1[2] += bflo(wb.w); b1[3] += bfhi(wb.w);
                    }
                    *(u32x4*)(rowp) = pack8(a0, a1);
                    *(u32x4*)(rowp + 128) = pack8(b0, b1);
                    part[ai][m] = red_fq(sumsq8(a0, a1) + sumsq8(b0, b1));
                    asm volatile("" ::: "memory");
                }
            if constexpr (MODE == M_GLA_O2) {
                epi_red_put(p.lds, 0, part, rt0, wc, fq); epi_red_sync();
                const int tid = threadIdx.x; if (tid < 256) ssq[((size_t)(c * 256 + tid) * 4 + h) * 2 + u.pn] = epi_red_get(p.lds, 0, tid);
            }
        } else if constexpr (MODE == M_WO) {
            float* Y = p.out + O_Y; bf16_t* x1b = (bf16_t*)(ws + WS_R2); float* ssq = fsm + F_SSQ_X1; float part[2][4];
#pragma unroll
            for (int ai = 0; ai < 2; ++ai)
#pragma unroll
                for (int m = 0; m < 4; ++m) {
                    const int row = u.pm * 256 + rt0 + ai * 128 + m * 16;
                    const float* xr = (row < SEQ ? p.xp + (size_t)row * DM : p.xs + (size_t)(row - SEQ) * DM) + u.pn * 256 + ct0;
                    float s = 0.f;
#pragma unroll
                    for (int bj = 0; bj < 2; ++bj) {
                        const f32x4 x0 = *(const f32x4*)(xr + bj * 128) + acc[ai][bj][m][0], x1 = *(const f32x4*)(xr + bj * 128 + 4) + acc[ai][bj][m][1];
                        float* yp = Y + (size_t)row * DM + u.pn * 256 + bj * 128 + ct0;
                        *(f32x4*)yp = x0; *(f32x4*)(yp + 4) = x1;
                        *(u32x4*)(x1b + (size_t)row * DM + u.pn * 256 + bj * 128 + ct0) = pack8(x0, x1);
                        s += sumsq8(x0, x1);
                    }
                    part[ai][m] = red_fq(s);
                }
            epi_red_put(p.lds, 0, part, rt0, wc, fq); epi_red_sync();
            { const int tid = threadIdx.x; if (tid < 256) ssq[(size_t)(u.pm * 256 + tid) * 8 + u.pn] = epi_red_get(p.lds, 0, tid); }
        } else if constexpr (MODE == M_UP) {
            bf16_t* Hb = (bf16_t*)(ws + WS_ZL); const float* ssq = fsm + F_SSQ_X1;
#pragma unroll
            for (int ai = 0; ai < 2; ++ai)
#pragma unroll
                for (int m = 0; m < 4; ++m) {
                    const int row = u.pm * 256 + rt0 + ai * 128 + m * 16;
                    const f32x4 q0 = *(const f32x4*)(ssq + (size_t)row * 8), q1 = *(const f32x4*)(ssq + (size_t)row * 8 + 4);
                    const float inv2 = 1.f / (((q0[0] + q0[1]) + (q0[2] + q0[3]) + (q1[0] + q1[1]) + (q1[2] + q1[3])) * (1.f / 2048.f) + EPS);
#pragma unroll
                    for (int bj = 0; bj < 2; ++bj) {
                        f32x4 a0 = acc[ai][bj][m][0], a1 = acc[ai][bj][m][1];
#pragma unroll
                        for (int i = 0; i < 4; ++i) { const float r0 = fmaxf(a0[i], 0.f), r1 = fmaxf(a1[i], 0.f); a0[i] = r0 * r0 * inv2; a1[i] = r1 * r1 * inv2; }
                        *(u32x4*)(Hb + (size_t)row * DFF + u.pn * 256 + bj * 128 + ct0) = pack8(a0, a1);
                    }
                }
        } else if constexpr (MODE == M_DOWN) {
            float* Y = p.out + O_Y;
#pragma unroll
            for (int ai = 0; ai < 2; ++ai)
#pragma unroll
                for (int m = 0; m < 4; ++m) {
                    const int row = u.pm * 256 + rt0 + ai * 128 + m * 16;
#pragma unroll
                    for (int bj = 0; bj < 2; ++bj) {
                        float* yp = Y + (size_t)row * DM + u.pn * 256 + bj * 128 + ct0;
                        const f32x4 y0 = *(const f32x4*)yp + acc[ai][bj][m][0], y1 = *(const f32x4*)(yp + 4) + acc[ai][bj][m][1];
                        *(f32x4*)yp = y0; *(f32x4*)(yp + 4) = y1;
                    }
                }
        } else if constexpr (MODE == M_WO_S || MODE == M_UP_S || MODE == M_DOWN_S) {
            constexpr int ld = (MODE == M_UP_S) ? DFF : DM;
            float* slab = (float*)(ws + (MODE == M_UP_S ? WS_R5 : WS_R4)) + (size_t)u.aux * 256 * ld;
#pragma unroll
            for (int ai = 0; ai < 2; ++ai)
#pragma unroll
                for (int m = 0; m < 4; ++m) {
                    float* rowp = slab + (size_t)(rt0 + ai * 128 + m * 16) * ld + u.pn * 256 + ct0;
#pragma unroll
                    for (int bj = 0; bj < 2; ++bj) { *(f32x4*)(rowp + bj * 128) = acc[ai][bj][m][0]; *(f32x4*)(rowp + bj * 128 + 4) = acc[ai][bj][m][1]; }
                }
        }
    }
};

template <int MODE> struct Sched {
    unsigned char* ws; float* out; int G, c, n;
    __device__ __forceinline__ bool next(int i, pg8::GUnit& u) const {
        const int L = i * G + c; if (L >= n) return false;
        u.aux = 0;
        if constexpr (MODE == M_INPROJ) {
            pg8::tile_of(L, 33, 45, u.pm, u.pn);
            u.A = (const char*)(ws + WS_R2) + (size_t)u.pm * 256 * 4096; u.B = (const char*)(ws + WS_R1) + (size_t)u.pn * 256 * 4096;
        } else if constexpr (MODE == M_QUP) {
            pg8::tile_of(L, 33, 12, u.pm, u.pn);
            u.A = (const char*)(ws + WS_ZL) + (size_t)u.pm * 256 * 2048; u.B = (const char*)(ws + WS_WSM) + (W_UQ + (size_t)u.pn * 256 * 512) * 2;
        } else if constexpr (MODE == M_KVUP) {
            pg8::tile_of(L, 33, 16, u.pm, u.pn);
            u.A = (const char*)(ws + WS_ZL) + (size_t)u.pm * 256 * 2048 + 1024; u.B = (const char*)(ws + WS_WSM) + (W_UKVG + (size_t)u.pn * 256 * 512) * 2;
        } else if constexpr (MODE == M_CNORM) {
            pg8::tile_of(L, 144, 8, u.pm, u.pn);
            u.A = (const char*)(ws + WS_R3) + (size_t)u.pm * 256 * (DQC * 2); u.B = (const char*)(ws + WS_WSM) + (W_KNP + (size_t)u.pn * 256 * 512) * 2;
        } else if constexpr (MODE == M_QABS) {
            const int h = L >> 1; u.pm = 0; u.pn = L & 1; u.aux = h;
            u.A = (const char*)(out + O_Y) + 53 * MiB + (size_t)h * 256 * 512; u.B = (const char*)(ws + WS_WSM) + (W_KNABS + ((size_t)h * 512 + u.pn * 256) * 256) * 2;
        } else if constexpr (MODE == M_S) {
            const int b = L / 9; u.pm = 0; u.pn = L - b * 9; u.aux = b;
            u.A = (const char*)(out + O_Y) + 48 * MiB + (size_t)b * 256 * (DQC * 2); u.B = (const char*)(ws + WS_R3) + ((size_t)b * NKP + u.pn * 256) * (DQC * 2);
        } else if constexpr (MODE == M_PC) {
            const int b = L / 6, r = L - b * 6, ks = r >> 1; u.pm = 0; u.pn = r & 1; u.aux = b * 4 + ks;
            u.A = (const char*)(ws + WS_R5) + ((size_t)b * 256 * NKP + ks * 768) * 2; u.B = (const char*)(ws + WS_R4) + (((size_t)b * 512 + u.pn * 256) * NKP + ks * 768) * 2;
        } else if constexpr (MODE == M_O) {
            const int h = L; u.pm = 0; u.pn = 0; u.aux = h;
            u.A = (const char*)(ws + WS_ZQK) + 16 * MiB + (size_t)h * 256 * 1024; u.B = (const char*)(ws + WS_WSM) + (W_VP + (size_t)(h & ~1) * 128 * 512) * 2;
        } else if constexpr (MODE == M_GLA_A) {
            u.pm = 0; u.pn = 0; u.aux = L;
            u.A = (const char*)(ws + WS_ZL) + (size_t)L * 131072; u.B = (const char*)(ws + WS_R5) + (size_t)L * 131072;
        } else if constexpr (MODE == M_GLA_DS) {
            const int hc = L >> 1; u.pm = L & 1; u.pn = 0; u.aux = hc;
            u.A = (const char*)(out + O_STS) + ((size_t)hc * 512 + u.pm * 256) * 512; u.B = (const char*)(ws + WS_R5) + 16 * MiB + (size_t)hc * 131072;
        } else if constexpr (MODE == M_GLA_O) {
            const int hc = L >> 1; u.pm = 0; u.pn = L & 1; u.aux = hc;
            u.A = (const char*)(ws + WS_ZQK) + (size_t)hc * 131072; u.B = (const char*)(out + O_STS) + ((size_t)hc * 512 + u.pn * 256) * 512;
        } else if constexpr (MODE == M_GLA_O2) {
            const int hc = L >> 1; u.pm = 0; u.pn = L & 1; u.aux = hc;
            u.A = (const char*)(ws + WS_ZL) + (size_t)hc * 131072; u.B = (const char*)(ws + WS_R2) + ((size_t)hc * 512 + u.pn * 256) * 512;
        } else if constexpr (MODE == M_WO) {
            pg8::tile_of(L, 32, 8, u.pm, u.pn);
            u.A = (const char*)(ws + WS_ZOG) + (size_t)u.pm * 256 * 4096; u.B = (const char*)(ws + WS_WSM) + (W_O + (size_t)u.pn * 256 * 2048) * 2;
        } else if constexpr (MODE == M_UP) {
            pg8::tile_of(L, 32, 32, u.pm, u.pn);
            u.A = (const char*)(ws + WS_R2) + (size_t)u.pm * 256 * 4096; u.B = (const char*)(ws + WS_R1) + (size_t)u.pn * 256 * 4096;
        } else if constexpr (MODE == M_DOWN) {
            pg8::tile_of(L, 32, 8, u.pm, u.pn);
            u.A = (const char*)(ws + WS_ZL) + (size_t)u.pm * 256 * 16384; u.B = (const char*)(ws + WS_R3) + (size_t)u.pn * 256 * 16384;
        } else if constexpr (MODE == M_WO_S) {
            u.pm = 0; u.pn = L & 7; u.aux = L >> 3;
            u.A = (const char*)(ws + WS_ZOG) + (size_t)SEQ * 4096 + u.aux * 512; u.B = (const char*)(ws + WS_WSM) + (W_O + (size_t)u.pn * 256 * 2048) * 2 + u.aux * 512;
        } else if constexpr (MODE == M_UP_S) {
            u.pm = 0; u.pn = L & 31; u.aux = L >> 5;
            u.A = (const char*)(ws + WS_R2) + (size_t)SEQ * 4096 + u.aux * 1024; u.B = (const char*)(ws + WS_R1) + (size_t)u.pn * 256 * 4096 + u.aux * 1024;
        } else if constexpr (MODE == M_DOWN_S) {
            u.pm = 0; u.pn = L & 7; u.aux = L >> 3;
            u.A = (const char*)(ws + WS_ZL) + (size_t)SEQ * 16384 + u.aux * 1024; u.B = (const char*)(ws + WS_R3) + (size_t)u.pn * 256 * 16384 + u.aux * 1024;
        }
        return true;
    }
};

template <int MODE>
__device__ __forceinline__ void run_gemm(Frame& F, const EP& ep, int n_units, unsigned lda, unsigned ldb, int nt, int t1, int& rot) {
    Sched<MODE> S; S.ws = F.ws; S.out = F.out; S.G = F.G; S.c = (F.vcu + F.G - rot) % F.G; S.n = n_units;
    Epi<MODE> E; E.p = ep;
    pg8::GCfg g; g.lda = lda; g.ldb = ldb; g.nt = nt; g.t1 = t1;
    pg8::gemm_phase<Epi<MODE>, Sched<MODE>>(F.lds, g, S, E);
    rot = (rot + n_units) % F.G;
}

namespace att {
constexpr int NW = 8, QBLK = 32, KVBLK = 64, QB = 256;
constexpr int SHM_V = KVBLK * 128 * 2, SHM_K = KVBLK * 192 * 2;
constexpr int LDS_ATT = 2 * SHM_V + 2 * SHM_K + NW * 64 * 4;
constexpr float THR = 8.f;
#define KSWZ(row, colB) ((row) * 384 + ((colB) ^ ((((row) >> 1) & 7) << 4)))
#define SBAR() __builtin_amdgcn_sched_barrier(0)
__device__ __forceinline__ int v_st(int k, int c) { const int kk = (k & ~0xC) | ((k & 4) << 1) | ((k & 8) >> 1); return ((kk >> 3) * 4 + (c >> 5)) * 512 + ((kk & 7) * 32 + (c & 31)) * 2; }
__device__ __forceinline__ int v_rd_base(int lane) { return ((lane & 3) << 3) | (((lane >> 2) & 3) << 6) | (((lane >> 4) & 1) << 5) | (((lane >> 5) & 1) << 8); }
constexpr int v_rd_off(int d0, int ks, int half) { return d0 * 512 + ks * 4096 + half * 2048; }
__device__ __forceinline__ int crow(int r, int hi) { return (r & 3) + 8 * (r >> 2) + 4 * hi; }
__device__ __forceinline__ unsigned cvtpk(float lo, float hi) { unsigned r; asm volatile("v_cvt_pk_bf16_f32 %0, %1, %2" : "=v"(r) : "v"(lo), "v"(hi)); return r; }

__device__ __forceinline__ void partialSM(f32x16& p0, f32x16& p1, float& m_reg, float& mn, float& alpha) {
    float pmax = p0[0];
#pragma unroll
    for (int r = 1; r < 16; ++r) pmax = fmaxf(pmax, p0[r]);
#pragma unroll
    for (int r = 0; r < 16; ++r) pmax = fmaxf(pmax, p1[r]);
    { auto rr = __builtin_amdgcn_permlane32_swap(__float_as_uint(pmax), __float_as_uint(pmax), false, false);
      pmax = fmaxf(__uint_as_float(rr[0]), __uint_as_float(rr[1])); }
    if (__builtin_expect(__all((pmax - m_reg) <= THR), 1)) { mn = m_reg; alpha = 1.f; }
    else { mn = fmaxf(m_reg, pmax); alpha = __builtin_amdgcn_exp2f(m_reg - mn); m_reg = mn; }
#pragma unroll
    for (int r = 0; r < 16; ++r) p0[r] = p0[r] - mn;
#pragma unroll
    for (int r = 0; r < 16; ++r) p1[r] = p1[r] - mn;
#pragma unroll
    for (int r = 0; r < 16; ++r) p0[r] = __builtin_amdgcn_exp2f(p0[r]);
}
__device__ __forceinline__ void finishSM(f32x16& p0, f32x16& p1, float alpha, float& l_reg, bf16x8& pa0, bf16x8& pa1, bf16x8& pa2, bf16x8& pa3) {
#pragma unroll
    for (int r = 0; r < 16; ++r) p1[r] = __builtin_amdgcn_exp2f(p1[r]);
    float ps = 0;
#pragma unroll
    for (int r = 0; r < 16; ++r) ps += p0[r];
#pragma unroll
    for (int r = 0; r < 16; ++r) ps += p1[r];
    { auto rr = __builtin_amdgcn_permlane32_swap(__float_as_uint(ps), __float_as_uint(ps), false, false);
      ps = __uint_as_float(rr[0]) + __uint_as_float(rr[1]); }
    l_reg = l_reg * alpha + ps;
#define PK4(P, B_, OUT) do { unsigned a0 = cvtpk(P[B_+0], P[B_+1]), a1 = cvtpk(P[B_+2], P[B_+3]);                          \
        unsigned b0 = cvtpk(P[B_+4], P[B_+5]), b1 = cvtpk(P[B_+6], P[B_+7]);                                             \
        auto r0 = __builtin_amdgcn_permlane32_swap(a0, b0, false, false); auto r1 = __builtin_amdgcn_permlane32_swap(a1, b1, false, false); \
        u32x4 w = {r0[0], r1[0], r0[1], r1[1]}; OUT = *reinterpret_cast<bf16x8*>(&w); } while (0)
    PK4(p0, 0, pa0); PK4(p0, 8, pa1); PK4(p1, 0, pa2); PK4(p1, 8, pa3);
#undef PK4
}
template <int KB>
__device__ __forceinline__ void qkt(f32x16& p0, f32x16& p1, const char* K_lds, int r32, int hi, const bf16x8* qr) {
    p0 = f32x16{}; p1 = f32x16{};
    const char* kb[4];
#pragma unroll
    for (int dd = 0; dd < 4; ++dd) kb[dd] = K_lds + KB * SHM_K + KSWZ(r32, (dd * 16 + hi * 8) * 2);
#pragma unroll
    for (int d0 = 0; d0 < 12; ++d0) { const char* a = kb[d0 & 3] + (d0 >> 2) * 128;
        bf16x8 b0 = *reinterpret_cast<const bf16x8*>(a);
        bf16x8 b1 = *reinterpret_cast<const bf16x8*>(a + 32 * 384);
        p0 = __builtin_amdgcn_mfma_f32_32x32x16_bf16(b0, qr[d0], p0, 0, 0, 0);
        p1 = __builtin_amdgcn_mfma_f32_32x32x16_bf16(b1, qr[d0], p1, 0, 0, 0); }
}
template <int VB>
__device__ __forceinline__ void pv_tile(f32x16* o, int vb0, bf16x8 pa0, bf16x8 pa1, bf16x8 pa2, bf16x8 pa3) {
#define TRRD(dst, off) asm volatile("ds_read_b64_tr_b16 %0, %1 offset:%2" : "=&v"(dst) : "v"(vb0), "i"(off) : "memory")
#define PV_D0(d0) do { s16x4 l0, l1, l2, l3, h0, h1, h2, h3; constexpr int b_ = VB * SHM_V + v_rd_off(d0, 0, 0); \
        TRRD(l0, b_); TRRD(h0, b_ + 2048); TRRD(l1, b_ + 4096); TRRD(h1, b_ + 6144); TRRD(l2, b_ + 8192); TRRD(h2, b_ + 10240); TRRD(l3, b_ + 12288); TRRD(h3, b_ + 14336); \
        asm volatile("s_waitcnt lgkmcnt(0)" ::: "memory"); SBAR();   \
        o[d0] = __builtin_amdgcn_mfma_f32_32x32x16_bf16(pa0, (bf16x8){l0[0], l0[1], l0[2], l0[3], h0[0], h0[1], h0[2], h0[3]}, o[d0], 0, 0, 0);   \
        o[d0] = __builtin_amdgcn_mfma_f32_32x32x16_bf16(pa1, (bf16x8){l1[0], l1[1], l1[2], l1[3], h1[0], h1[1], h1[2], h1[3]}, o[d0], 0, 0, 0);   \
        o[d0] = __builtin_amdgcn_mfma_f32_32x32x16_bf16(pa2, (bf16x8){l2[0], l2[1], l2[2], l2[3], h2[0], h2[1], h2[2], h2[3]}, o[d0], 0, 0, 0);   \
        o[d0] = __builtin_amdgcn_mfma_f32_32x32x16_bf16(pa3, (bf16x8){l3[0], l3[1], l3[2], l3[3], h3[0], h3[1], h3[2], h3[3]}, o[d0], 0, 0, 0); } while (0)
    PV_D0(0); PV_D0(1); PV_D0(2); PV_D0(3);
#undef PV_D0
#undef TRRD
}

struct BlockRef { const bf16_t* Q; const bf16_t* K; const bf16_t* V; bf16_t* G; int qb; int dry; };
struct Seam { bf16x8 qr[12]; bf16x8 st_v0, st_v1, st_k0, st_k1, st_k2; };

#define VMW() asm volatile("s_waitcnt vmcnt(0)" ::: "memory")
#define VMWN(n) asm volatile("s_waitcnt vmcnt(%0)" :: "i"(n) : "memory")
#define LD8(p) (*reinterpret_cast<const bf16x8*>(p))
#define SLOAD_H(Kp, Vp, k0) do { S.st_v0 = LD8((Vp) + (size_t)((k0) + sr) * 128 + sc); S.st_v1 = LD8((Vp) + (size_t)((k0) + 32 + sr) * 128 + sc); \
        const bf16_t* kt_ = (Kp) + (size_t)(k0) * 192 + tid * 8; S.st_k0 = LD8(kt_); S.st_k1 = LD8(kt_ + 4096); S.st_k2 = LD8(kt_ + 8192); } while (0)
#define SWRITE_HK(bf) do { *(bf16x8*)(K_lds + (bf) * SHM_K + kw0) = S.st_k0; *(bf16x8*)(K_lds + (bf) * SHM_K + kw1) = S.st_k1; *(bf16x8*)(K_lds + (bf) * SHM_K + kw2) = S.st_k2; } while (0)
#define SWRITE_HV(bf) do { *(bf16x8*)(V_lds + (bf) * SHM_V + vst0) = S.st_v0; *(bf16x8*)(V_lds + (bf) * SHM_V + vst1) = S.st_v1; } while (0)
#define SWRITE_H(bf) do { SWRITE_HV(bf); SWRITE_HK(bf); } while (0)
#define KW_OFFS() const int g0_ = tid, g1_ = tid + 512, g2_ = tid + 1024; \
    const int kw0 = KSWZ(g0_ / 24, (g0_ % 24) * 16), kw1 = KSWZ(g1_ / 24, (g1_ % 24) * 16), kw2 = KSWZ(g2_ / 24, (g2_ % 24) * 16)

__device__ __forceinline__ void prime(const BlockRef& cur, char* lds, Seam& S) {
    int tid_ = threadIdx.x; asm volatile("" : "+v"(tid_));
    const int tid = tid_;
    const int sr = tid >> 4, sc = (tid & 15) * 8; char* K_lds = lds + 2 * SHM_V;
    KW_OFFS();
    SLOAD_H(cur.K, cur.V, 0); VMW(); SWRITE_HK(0);
    __syncthreads();
}
__device__ __forceinline__ void block(const BlockRef& cur, const BlockRef& nxt, char* lds, Seam& S) {
    int tid_ = threadIdx.x; asm volatile("" : "+v"(tid_));
    const int tid = tid_, wid = __builtin_amdgcn_readfirstlane(tid >> 6), lane = tid & 63, r32 = lane & 31, hi = lane >> 5;
    const int NT = 4 * cur.qb + 4;
    const int tmax = 4 * cur.qb + (wid >> 1);
    char* V_lds = lds; char* K_lds = lds + 2 * SHM_V;
    float* wsf = (float*)(lds + 2 * SHM_V + 2 * SHM_K) + wid * 64; float* li_l = wsf, * al_l = wsf + 32;
    float m_reg = -1e30f, l_reg = 0; f32x16 o[4] = {};
    const int sr = tid >> 4, sc = (tid & 15) * 8, vst0 = v_st(sr, sc), vst1 = v_st(32 + sr, sc);
    KW_OFFS();
    const int vb0 = (int)(uintptr_t)V_lds + v_rd_base(lane);
    const bf16_t* Kh = cur.K; const bf16_t* Vh = cur.V;
#define RESC(a) do { if (__any((a) < 1.f)) { if (hi == 0) al_l[r32] = (a); asm volatile("s_waitcnt lgkmcnt(0)" ::: "memory");              \
                     _Pragma("unroll") for (int d_ = 0; d_ < 4; ++d_) _Pragma("unroll") for (int r = 0; r < 16; ++r) o[d_][r] *= al_l[crow(r, hi)]; } } while (0)
#define KBASE(t) ((t) * KVBLK)
#define MASKT(P0_, P1_, t) do { if ((t) > tmax) { const float NEG_ = -__builtin_inff(); _Pragma("unroll") for (int r = 0; r < 16; ++r) { P0_[r] = NEG_; P1_[r] = NEG_; } } } while (0)
    constexpr int NQL = 0;
#define SEAM_K0() do { VMWN(NQL); SWRITE_HK(0); SBAR(); } while (0)
    f32x16 pA0, pA1, pB0, pB1; float mnA, mnB, alA, alB; bf16x8 pa0, pa1, pa2, pa3;
#pragma unroll
    for (int d0 = 0; d0 < 12; ++d0) S.qr[d0] = LD8(cur.Q + (size_t)(wid * QBLK + r32) * 192 + d0 * 16 + hi * 8);
    SWRITE_HV(0); SBAR();
    SLOAD_H(Kh, Vh, KBASE(1));
    SBAR(); qkt<0>(pA0, pA1, K_lds, r32, hi, S.qr);
    MASKT(pA0, pA1, 0); partialSM(pA0, pA1, m_reg, mnA, alA);
    VMW(); SWRITE_H(1);
    __syncthreads();
#define HALF_STEP(PX0, PX1, mnX, alX, PY0, PY1, alY, t, KB, VB, SB) do {                                                      \
        SBAR(); qkt<KB>(PX0, PX1, K_lds, r32, hi, S.qr);                                                          \
        finishSM(PY0, PY1, alY, l_reg, pa0, pa1, pa2, pa3); SBAR();                                                           \
        if ((t) + 1 < NT) { SLOAD_H(Kh, Vh, KBASE((t) + 1)); SBAR(); }                                               \
        pv_tile<VB>(o, vb0, pa0, pa1, pa2, pa3); MASKT(PX0, PX1, (t)); partialSM(PX0, PX1, m_reg, mnX, alX);                                        \
        __syncthreads();                                                                                                      \
        if ((t) + 1 < NT) { VMW(); SWRITE_H(SB); }                                                                          \
        RESC(alX); __syncthreads(); } while (0)
    for (int t = 1; t + 1 < NT; t += 2) {
        HALF_STEP(pB0, pB1, mnB, alB, pA0, pA1, alA, t, 1, 0, 0);
        HALF_STEP(pA0, pA1, mnA, alA, pB0, pB1, alB, t + 1, 0, 1, 1);
    }
    SBAR(); qkt<1>(pB0, pB1, K_lds, r32, hi, S.qr); SBAR();
    SLOAD_H(nxt.K, nxt.V, 0); SBAR();
    finishSM(pA0, pA1, alA, l_reg, pa0, pa1, pa2, pa3); SBAR();
    pv_tile<0>(o, vb0, pa0, pa1, pa2, pa3);
    MASKT(pB0, pB1, NT - 1); partialSM(pB0, pB1, m_reg, mnB, alB); __syncthreads(); RESC(alB);
    finishSM(pB0, pB1, alB, l_reg, pa0, pa1, pa2, pa3); SBAR(); pv_tile<1>(o, vb0, pa0, pa1, pa2, pa3);
    SBAR(); SEAM_K0();
    if (hi == 0) li_l[r32] = l_reg; asm volatile("s_waitcnt lgkmcnt(0)" ::: "memory");
    float rli[16];
#pragma unroll
    for (int r = 0; r < 16; ++r) rli[r] = __builtin_amdgcn_rcpf(li_l[crow(r, hi)]);
    bf16_t* Gw = cur.G + (size_t)(wid * QBLK) * 2048;
#pragma unroll
    for (int r = 0; r < 16; ++r) { const int orow = crow(r, hi);
#pragma unroll
        for (int d0 = 0; d0 < 4; ++d0) {
            bf16_t* gp = Gw + (size_t)orow * 2048 + d0 * 32 + r32;
            const float gate = bf2f(*gp);
            const float v = o[d0][r] * rli[r] * sigmoidf_(gate);
            const float vn = __shfl_xor(v, 1);
            if ((r32 & 1) == 0 && !cur.dry) *(unsigned*)gp = cvtpk(v, vn); } }
    __syncthreads();
#undef RESC
#undef KBASE
#undef MASKT
#undef SEAM_K0
#undef HALF_STEP
}
#undef VMW
#undef VMWN
#undef LD8
#undef SLOAD_H
#undef SWRITE_HK
#undef SWRITE_HV
#undef SWRITE_H
#undef KW_OFFS
#undef KSWZ
#undef SBAR
}

#define LDS_WAIT() asm volatile("s_waitcnt lgkmcnt(0)" ::: "memory")
__device__ __forceinline__ unsigned pk2(float lo, float hi) { return cvt_pk_bf16(lo, hi); }

__device__ __forceinline__ void tr_item(const float* src, size_t ldn, bf16_t* dst, size_t ldk, int k0, int ndst0, int srcn, const float* kscale, LAS float* scr, int lane) {
#pragma unroll 8
    for (int i = 0; i < 32; ++i) { const int kk = 2 * i + (lane >> 5);
        float v = 0.f; if (srcn >= 0) { v = src[(size_t)(k0 + kk) * ldn + srcn]; if (kscale) v *= kscale[k0 + kk]; }
        scr[kk * 33 + (lane & 31)] = v; }
    LDS_WAIT(); asm volatile("" ::: "memory");
    const int c = lane & 7;
#pragma unroll
    for (int j = 0; j < 4; ++j) { const int n = (lane >> 3) + 8 * j; const LAS float* s = scr + (8 * c) * 33 + n;
        u32x4 o; o.x = pk2(s[0 * 33], s[1 * 33]); o.y = pk2(s[2 * 33], s[3 * 33]); o.z = pk2(s[4 * 33], s[5 * 33]); o.w = pk2(s[6 * 33], s[7 * 33]);
        *(u32x4*)(dst + (size_t)(ndst0 + n) * ldk + k0 + 8 * c) = o; }
    LDS_WAIT(); asm volatile("" ::: "memory");
}
__device__ __forceinline__ int win_src(int n) {
    if (n < 1024) return n;
    if (n < 5120) return n + 64;
    if (n < 11264) return n + 80;
    const int lc = n - 11264;
    if (lc < 64) return 1024 + lc;
    if (lc < 80) return 5184 + (lc - 64);
    return -1;
}

__device__ __forceinline__ void p0_prologue(Frame& F) {
    LAS float* scr = (LAS float*)(F.lds + F.wave * 16384);
    const int gw = F.vcu * 8 + F.wave, NGW = F.G * 8, lane = F.lane;
    const int gt = gw * 64 + lane, NGT = NGW * 64;
    unsigned char* ws = F.ws; bf16_t* wsm = (bf16_t*)(ws + WS_WSM); float* fsm = (float*)(ws + WS_FSM);
    {
        const float* g = F.in[5]; bf16_t* hb = (bf16_t*)(ws + WS_R2);
        for (int row = gw; row < NTOK; row += NGW) {
            const float* xr = row < SEQ ? F.in[0] + (size_t)row * DM : F.in[1] + (size_t)(row - SEQ) * DM;
            f32x4 v[8]; float s = 0.f;
#pragma unroll
            for (int j = 0; j < 8; ++j) { v[j] = *(const f32x4*)(xr + (lane + 64 * j) * 4); s += (v[j][0] * v[j][0] + v[j][1] * v[j][1]) + (v[j][2] * v[j][2] + v[j][3] * v[j][3]); }
            const float inv = rsqrtf(wave_sum(s) * (1.f / DM) + EPS);
#pragma unroll
            for (int j = 0; j < 8; ++j) { const f32x4 gg = *(const f32x4*)(g + (lane + 64 * j) * 4);
                u32x2 o; o.x = pk2(v[j][0] * inv * gg[0], v[j][1] * inv * gg[1]); o.y = pk2(v[j][2] * inv * gg[2], v[j][3] * inv * gg[3]);
                *(u32x2*)(hb + (size_t)row * DM + (lane + 64 * j) * 4) = o; }
        }
    }
    {
        const float* wukv = F.in[10]; bf16_t* wk = wsm + W_KNABS;
        for (int i = gt; i < 16 * 512 * 32; i += NGT) { const int j8 = (i & 31) * 8, c = (i >> 5) & 511, h = i >> 14;
            u32x4 o = {0u, 0u, 0u, 0u};
            if (j8 < 128) { const float* s = wukv + (size_t)c * 4096 + h * 256 + j8; const f32x4 a = *(const f32x4*)s, b = *(const f32x4*)(s + 4);
                o.x = pk2(a[0], a[1]); o.y = pk2(a[2], a[3]); o.z = pk2(b[0], b[1]); o.w = pk2(b[2], b[3]); }
            *(u32x4*)(wk + ((size_t)h * 512 + c) * 256 + j8) = o; }
    }
    constexpr int I_IN = 32 * 360, I_UQ = 8 * 96, I_UKV = 8 * 128, I_KN = 8 * 64, I_V = 8 * 64, I_O = 32 * 64;
    constexpr int NIT = I_IN + I_UQ + I_UKV + I_KN + I_V + I_O;
    for (int it = gw; it < NIT; it += NGW) {
        int r = it; const int n = lane & 31;
        if (r < I_IN) { const int kb = r / 360, nb = r % 360; tr_item(F.in[6], DIN, (bf16_t*)(ws + WS_R1), 2048, kb * 64, nb * 32, win_src(nb * 32 + n), nullptr, scr, lane); continue; } r -= I_IN;
        if (r < I_UQ) { const int kb = r / 96, nb = r % 96; tr_item(F.in[8], 3072, wsm + W_UQ, 512, kb * 64, nb * 32, nb * 32 + n, F.in[7], scr, lane); continue; } r -= I_UQ;
        if (r < I_UKV) { const int kb = r / 128, nb = r % 128; tr_item(F.in[10], 4096, wsm + W_UKVG, 512, kb * 64, nb * 32, nb * 32 + n, F.in[9], scr, lane); continue; } r -= I_UKV;
        if (r < I_KN) { const int kb = r / 64, nb = r % 64; const int nd = nb * 32 + n; tr_item(F.in[10], 4096, wsm + W_KNP, 512, kb * 64, nb * 32, (nd >> 7) * 256 + (nd & 127), nullptr, scr, lane); continue; } r -= I_KN;
        if (r < I_V) { const int kb = r / 64, nb = r % 64; const int nd = nb * 32 + n; tr_item(F.in[10], 4096, wsm + W_VP, 512, kb * 64, nb * 32, (nd >> 7) * 256 + 128 + (nd & 127), nullptr, scr, lane); continue; } r -= I_V;
        { const int kb = r / 64, nb = r % 64; tr_item(F.in[18], 2048, wsm + W_O, 2048, kb * 64, nb * 32, nb * 32 + n, nullptr, scr, lane); }
    }
}

__device__ __forceinline__ void p2_ckv_krope(Frame& F) {
    const int gw = F.vcu * 8 + F.wave, NGW = F.G * 8, lane = F.lane;
    unsigned char* ws = F.ws; float* fsm = (float*)(ws + WS_FSM);
    const bf16_t* ZL = (const bf16_t*)(ws + WS_ZL); const bf16_t* ZM = (const bf16_t*)(ws + WS_ZM);
    const float* gkv = F.in[9]; const float* cs = fsm + F_ROPE;
    for (int t = gw; t < NTOK; t += NGW) {
        const float inv = rsqrtf((fsm[F_SSQ_KV + 2 * t] + fsm[F_SSQ_KV + 2 * t + 1]) * (1.f / 512.f) + EPS);
        const u32x4 w = *(const u32x4*)(ZL + (size_t)t * 1024 + 512 + lane * 8);
        const f32x4 g0 = *(const f32x4*)(gkv + lane * 8), g1 = *(const f32x4*)(gkv + lane * 8 + 4);
        f32x4 o0, o1;
        o0[0] = bflo(w.x) * inv * g0[0]; o0[1] = bfhi(w.x) * inv * g0[1]; o0[2] = bflo(w.y) * inv * g0[2]; o0[3] = bfhi(w.y) * inv * g0[3];
        o1[0] = bflo(w.z) * inv * g1[0]; o1[1] = bfhi(w.z) * inv * g1[1]; o1[2] = bflo(w.w) * inv * g1[2]; o1[3] = bfhi(w.w) * inv * g1[3];
        float* oc = t < SEQ ? F.out + O_CKVP + (size_t)t * 512 : F.out + O_CKVS + (size_t)(t - SEQ) * 512;
        *(f32x4*)(oc + lane * 8) = o0; *(f32x4*)(oc + lane * 8 + 4) = o1;
        float ss = 0.f;
        if (lane < 32) {
            const float x1 = bf2f(ZM[(size_t)t * 256 + lane]), x2 = bf2f(ZM[(size_t)t * 256 + 32 + lane]);
            const int pos = t < SEQ ? t : PAST + ((t - SEQ) & 15);
            const float c = cs[pos * 64 + lane], s = cs[pos * 64 + 32 + lane];
            const float y1 = x1 * c - x2 * s, y2 = x2 * c + x1 * s;
            float* ok = t < SEQ ? F.out + O_KRP + (size_t)t * 64 : F.out + O_KRS + (size_t)(t - SEQ) * 64;
            ok[lane] = y1; ok[32 + lane] = y2; ss = y1 * y1 + y2 * y2;
        }
        ss = wave_sum(ss);
        if (lane == 0) fsm[F_KRSS + t] = ss;
    }
}

__device__ __forceinline__ void p3_finalize_qk(Frame& F) {
    const int gw = F.vcu * 8 + F.wave, NGW = F.G * 8, lane = F.lane, l = lane & 31;
    unsigned char* ws = F.ws; float* fsm = (float*)(ws + WS_FSM); const float* cs = fsm + F_ROPE;
    bf16_t* Qp = (bf16_t*)(ws + WS_R1); bf16_t* Kp = (bf16_t*)(F.out + O_Y);
    bf16_t* Qcat = (bf16_t*)(F.out + O_Y) + 48 * MiB / 2; bf16_t* QnA = (bf16_t*)(F.out + O_Y) + 53 * MiB / 2;
    const float* gqn = F.in[11]; const float* gqr = F.in[12]; const float* gkn = F.in[13]; const float* gkr = F.in[14];
    const float* ssq_qg = (const float*)((const char*)(F.out + O_Y) + 56 * MiB);
    for (int p = gw * 2 + (lane >> 5); p < NTOK * 16; p += NGW * 2) {
        const int t = p >> 4, h = p & 15;
        const float al = rsqrtf((fsm[F_SSQ_QL + 2 * t] + fsm[F_SSQ_QL + 2 * t + 1]) * (1.f / 512.f) + EPS);
        const float* qg = ssq_qg + (size_t)t * 96 + h * 6;
        const float ssq_h = ((qg[0] + qg[1]) + (qg[2] + qg[3])) + (qg[4] + qg[5]);
        const float invq = rsqrtf(al * al * ssq_h * (1.f / 192.f) + EPS);
        const float sc = al * invq * MLA_SCALE * LOG2E;
        bf16_t* q = Qp + ((size_t)h * NTOK + t) * 192;
        const int r = t - SEQ, b = r >> 4, qi = r & 15;
        if (l < 16) {
            const u32x4 w = *(const u32x4*)(q + l * 8);
            const f32x4 a0 = *(const f32x4*)(gqn + l * 8), a1 = *(const f32x4*)(gqn + l * 8 + 4), b0 = *(const f32x4*)(gkn + l * 8), b1 = *(const f32x4*)(gkn + l * 8 + 4);
            u32x4 o;
            o.x = pk2(bflo(w.x) * sc * a0[0] * b0[0], bfhi(w.x) * sc * a0[1] * b0[1]); o.y = pk2(bflo(w.y) * sc * a0[2] * b0[2], bfhi(w.y) * sc * a0[3] * b0[3]);
            o.z = pk2(bflo(w.z) * sc * a1[0] * b1[0], bfhi(w.z) * sc * a1[1] * b1[1]); o.w = pk2(bflo(w.w) * sc * a1[2] * b1[2], bfhi(w.w) * sc * a1[3] * b1[3]);
            *(u32x4*)(q + l * 8) = o;
            if (t >= SEQ) { bf16_t* qa = QnA + ((size_t)h * 256 + r) * 256; *(u32x4*)(qa + l * 8) = o; *(u32x4*)(qa + 128 + l * 8) = (u32x4){0u, 0u, 0u, 0u}; }
        } else if (l < 20) {
            const int k = l - 16; const int pos = t < SEQ ? t : PAST + qi;
            const u32x4 w1 = *(const u32x4*)(q + 128 + 8 * k), w2 = *(const u32x4*)(q + 160 + 8 * k);
            float x1[8] = {bflo(w1.x), bfhi(w1.x), bflo(w1.y), bfhi(w1.y), bflo(w1.z), bfhi(w1.z), bflo(w1.w), bfhi(w1.w)};
            float x2[8] = {bflo(w2.x), bfhi(w2.x), bflo(w2.y), bfhi(w2.y), bflo(w2.z), bfhi(w2.z), bflo(w2.w), bfhi(w2.w)};
            float y1[8], y2[8];
#pragma unroll
            for (int i = 0; i < 8; ++i) { const int ii = 8 * k + i; const float c = cs[pos * 64 + ii], s = cs[pos * 64 + 32 + ii], g = gqr[ii] * gkr[ii] * sc;
                y1[i] = (x1[i] * c - x2[i] * s) * g; y2[i] = (x2[i] * c + x1[i] * s) * g; }
            u32x4 o1 = {pk2(y1[0], y1[1]), pk2(y1[2], y1[3]), pk2(y1[4], y1[5]), pk2(y1[6], y1[7])};
            u32x4 o2 = {pk2(y2[0], y2[1]), pk2(y2[2], y2[3]), pk2(y2[4], y2[5]), pk2(y2[6], y2[7])};
            *(u32x4*)(q + 128 + 8 * k) = o1; *(u32x4*)(q + 160 + 8 * k) = o2;
            if (t >= SEQ) { bf16_t* qc = Qcat + ((size_t)b * 256 + h * 16 + qi) * DQC; *(u32x4*)(qc + 512 + 8 * k) = o1; *(u32x4*)(qc + 544 + 8 * k) = o2; }
        } else if (l < 28) {
            if (t >= SEQ) { bf16_t* qc = Qcat + ((size_t)b * 256 + h * 16 + qi) * DQC; *(u32x4*)(qc + 576 + 8 * (l - 20)) = (u32x4){0u, 0u, 0u, 0u}; }
        }
    }
    for (int p = gw * 2 + (lane >> 5); p < SEQ * 16; p += NGW * 2) {
        const int t = p >> 4, h = p & 15;
        const float invk = rsqrtf((fsm[F_SSQ_K + p] + fsm[F_KRSS + t]) * (1.f / 192.f) + EPS);
        bf16_t* k = Kp + ((size_t)h * SEQ + t) * 192;
        if (l < 16) {
            const u32x4 w = *(const u32x4*)(k + l * 8); u32x4 o;
            o.x = pk2(bflo(w.x) * invk, bfhi(w.x) * invk); o.y = pk2(bflo(w.y) * invk, bfhi(w.y) * invk); o.z = pk2(bflo(w.z) * invk, bfhi(w.z) * invk); o.w = pk2(bflo(w.w) * invk, bfhi(w.w) * invk);
            *(u32x4*)(k + l * 8) = o;
        } else if (l < 24) {
            const float* kr = F.out + O_KRP + (size_t)t * 64 + (l - 16) * 8; const f32x4 a = *(const f32x4*)kr, b = *(const f32x4*)(kr + 4);
            u32x4 o = {pk2(a[0] * invk, a[1] * invk), pk2(a[2] * invk, a[3] * invk), pk2(b[0] * invk, b[1] * invk), pk2(b[2] * invk, b[3] * invk)};
            *(u32x4*)(k + 128 + (l - 16) * 8) = o;
        }
    }
}
__device__ __forceinline__ void p3_kcat_ct(Frame& F) {
    LAS float* scr = (LAS float*)(F.lds + F.wave * 16384);
    const int gw = F.vcu * 8 + F.wave, NGW = F.G * 8, lane = F.lane;
    const int gt = gw * 64 + lane, NGT = NGW * 64;
    unsigned char* ws = F.ws; float* fsm = (float*)(ws + WS_FSM);
    bf16_t* Kcat = (bf16_t*)(ws + WS_R3); bf16_t* CT = (bf16_t*)(ws + WS_R4);
    const float* cckv = F.in[2]; const float* ckr = F.in[3];
    for (int row = gw; row < DECB * NKP; row += NGW) {
        const int b = row / NKP, k = row - b * NKP;
        bf16_t* dst = Kcat + (size_t)row * DQC;
        float ss = 0.f;
#pragma unroll
        for (int j = 0; j < 2; ++j) { const int ch = lane + 64 * j; if (ch >= 80) break;
            u32x4 o = {0u, 0u, 0u, 0u};
            if (k < NKEY && ch < 72) {
                const float* s;
                if (ch < 64) s = (k < PAST ? cckv + ((size_t)b * PAST + k) * 512 : F.out + O_CKVS + (size_t)(b * 16 + k - PAST) * 512) + ch * 8;
                else s = (k < PAST ? ckr + ((size_t)b * PAST + k) * 64 : F.out + O_KRS + (size_t)(b * 16 + k - PAST) * 64) + (ch - 64) * 8;
                const f32x4 a = *(const f32x4*)s, c = *(const f32x4*)(s + 4);
                o.x = pk2(a[0], a[1]); o.y = pk2(a[2], a[3]); o.z = pk2(c[0], c[1]); o.w = pk2(c[2], c[3]);
                if (ch >= 64) ss = (a[0] * a[0] + a[1] * a[1]) + (a[2] * a[2] + a[3] * a[3]) + (c[0] * c[0] + c[1] * c[1]) + (c[2] * c[2] + c[3] * c[3]);
            }
            *(u32x4*)(dst + ch * 8) = o; }
        ss = wave_sum(ss);
        if (lane == 0) fsm[F_KRSS_C + row] = ss;
    }
    for (int it = gw; it < 16 * 32 * 16; it += NGW) {
        const int b = it >> 9, r = it & 511, kb = r >> 4, nb = r & 15;
        tr_item(cckv + (size_t)b * PAST * 512, 512, CT + (size_t)b * 512 * NKP, NKP, kb * 64, nb * 32, nb * 32 + (lane & 31), nullptr, scr, lane);
    }
    for (int i = gt; i < 16 * 512 * 32; i += NGT) { const int ch = i & 31, c = (i >> 5) & 511, b = i >> 14;
        u32x4 o = {0u, 0u, 0u, 0u};
        if (ch < 2) { const float* s = F.out + O_CKVS + (size_t)(b * 16 + ch * 8) * 512 + c;
            o.x = pk2(s[0], s[512]); o.y = pk2(s[1024], s[1536]); o.z = pk2(s[2048], s[2560]); o.w = pk2(s[3072], s[3584]); }
        *(u32x4*)(CT + ((size_t)b * 512 + c) * NKP + PAST + ch * 8) = o; }
}
__device__ __forceinline__ float logsig16(float x) { return (fminf(x, 0.f) - log1pf(__expf(-fabsf(x)))) * (1.f / 16.f); }
__device__ __forceinline__ void p3_gla_prep(Frame& F) {
    unsigned char* ws = F.ws; float* fsm = (float*)(ws + WS_FSM);
    const bf16_t* ZQK = (const bf16_t*)(ws + WS_ZQK); const bf16_t* ZV = (const bf16_t*)(ws + WS_ZV); const bf16_t* ZM = (const bf16_t*)(ws + WS_ZM);
    bf16_t* qt = (bf16_t*)(ws + WS_ZL); bf16_t* kt = (bf16_t*)(ws + WS_R5); bf16_t* kendT = (bf16_t*)(ws + WS_R5) + 8 * MiB; bf16_t* vT = (bf16_t*)(F.out + O_STS);
    const float* wa2 = F.in[15]; const float* ba_ = F.in[16];
    LAS float* alr_s = (LAS float*)F.lds;
    LAS float* tot_s = (LAS float*)(F.lds + 16384);
    LAS unsigned char* tile = F.lds + 16384 + 2048;
    const int tid = F.tid;
    for (int un = F.vcu; un < 256; un += F.G) {
        const int hc = un >> 1, dh = un & 1, h = hc >> 5, c = hc & 31;
        const int dl = tid & 127, qtr = tid >> 7, d = dh * 128 + dl;
        { const int tt = tid >> 1, half = tid & 1; const u32x4 w = *(const u32x4*)(ZM + (size_t)(c * 256 + tt) * 256 + 64 + half * 8);
          LAS float* a = alr_s + tt * 16 + half * 8;
          a[0] = bflo(w.x); a[1] = bfhi(w.x); a[2] = bflo(w.y); a[3] = bfhi(w.y); a[4] = bflo(w.z); a[5] = bfhi(w.z); a[6] = bflo(w.w); a[7] = bfhi(w.w); }
        float wa[16];
#pragma unroll
        for (int r = 0; r < 16; ++r) wa[r] = wa2[r * 1024 + h * 256 + d];
        const float ba = ba_[h * 256 + d];
        __syncthreads();
        float tot = 0.f;
        for (int i = 0; i < 64; ++i) { const LAS float* a = alr_s + (qtr * 64 + i) * 16; float x = ba;
#pragma unroll
            for (int r = 0; r < 16; ++r) x += a[r] * wa[r];
            tot += logsig16(x); }
        tot_s[qtr * 128 + dl] = tot;
        __syncthreads();
        float off = 0.f, bend = 0.f;
#pragma unroll
        for (int q = 0; q < 4; ++q) { const float v = tot_s[q * 128 + dl]; bend += v; if (q < qtr) off += v; }
        if (qtr == 0) fsm[F_GAMMA + hc * 256 + d] = __expf(bend);
        float bcum = off;
        for (int i = 0; i < 64; ++i) { const int tl = qtr * 64 + i; const LAS float* a = alr_s + tl * 16; float x = ba;
#pragma unroll
            for (int r = 0; r < 16; ++r) x += a[r] * wa[r];
            bcum += logsig16(x);
            const size_t trow = (size_t)(c * 256 + tl) * 2048;
            const float gq = bf2f(ZQK[trow + h * 256 + d]), gk = bf2f(ZQK[trow + 1024 + h * 256 + d]);
            qt[(size_t)hc * 65536 + tl * 256 + d] = f2bf(gq * 0.0625f * __expf(bcum));
            kt[(size_t)hc * 65536 + tl * 256 + d] = f2bf(gk * __expf(-bcum));
            *(LAS bf16_t*)(tile + dl * 520 + tl * 2) = f2bf(gk * __expf(bend - bcum)); }
        __syncthreads();
#pragma unroll 4
        for (int j = 0; j < 16; ++j) { const int g = tid + 512 * j, row = g >> 6, ch = g & 63;
            const u32x2 v = *(const LAS u32x2*)(tile + row * 520 + ch * 8);
            *(u32x2*)(kendT + (size_t)hc * 65536 + (size_t)(dh * 128 + row) * 256 + ch * 4) = v; }
        __syncthreads();
    }
    LAS unsigned char* tl2 = F.lds;
    for (int it = F.vcu; it < 1024; it += F.G) {
        const int hc = it >> 3, eb = it & 7, h = hc >> 5, c = hc & 31, e0 = eb * 64;
#pragma unroll
        for (int j = 0; j < 4; ++j) { const int g = tid + 512 * j, t = g >> 3, ch = g & 7;
            const u32x4 w = *(const u32x4*)(ZV + (size_t)(c * 256 + t) * 2048 + h * 512 + e0 + ch * 8);
            LAS unsigned char* p = tl2 + (ch * 8) * 520 + t * 2;
            *(LAS bf16_t*)(p) = (bf16_t)(w.x & 0xffff); *(LAS bf16_t*)(p + 520) = (bf16_t)(w.x >> 16);
            *(LAS bf16_t*)(p + 2 * 520) = (bf16_t)(w.y & 0xffff); *(LAS bf16_t*)(p + 3 * 520) = (bf16_t)(w.y >> 16);
            *(LAS bf16_t*)(p + 4 * 520) = (bf16_t)(w.z & 0xffff); *(LAS bf16_t*)(p + 5 * 520) = (bf16_t)(w.z >> 16);
            *(LAS bf16_t*)(p + 6 * 520) = (bf16_t)(w.w & 0xffff); *(LAS bf16_t*)(p + 7 * 520) = (bf16_t)(w.w >> 16); }
        __syncthreads();
#pragma unroll
        for (int j = 0; j < 8; ++j) { const int g = tid + 512 * j, row = g >> 6, ch = g & 63;
            const u32x2 v = *(const LAS u32x2*)(tl2 + row * 520 + ch * 8);
            *(u32x2*)(vT + ((size_t)hc * 512 + e0 + row) * 256 + ch * 4) = v; }
        __syncthreads();
    }
}

__device__ __forceinline__ void p6_softmax_scan(Frame& F) {
    const int gw = F.vcu * 8 + F.wave, NGW = F.G * 8, lane = F.lane;
    unsigned char* ws = F.ws; float* fsm = (float*)(ws + WS_FSM);
    const float* Sb = F.out + O_Y; bf16_t* P = (bf16_t*)(ws + WS_R5);
    for (int R = gw; R < 16 * 256; R += NGW) {
        const float* sr = Sb + (size_t)R * NKP; f32x4 v[9]; float m = -3.0e38f;
#pragma unroll
        for (int j = 0; j < 9; ++j) { const int k = (lane + 64 * j) * 4; v[j] = *(const f32x4*)(sr + k);
#pragma unroll
            for (int i = 0; i < 4; ++i) { if (k + i >= NKEY) v[j][i] = -__builtin_inff(); m = fmaxf(m, v[j][i]); } }
        m = wave_max(m); float s = 0.f;
#pragma unroll
        for (int j = 0; j < 9; ++j)
#pragma unroll
            for (int i = 0; i < 4; ++i) { v[j][i] = __builtin_amdgcn_exp2f(v[j][i] - m); s += v[j][i]; }
        const float inv = 1.f / wave_sum(s);
#pragma unroll
        for (int j = 0; j < 9; ++j) { const int k = (lane + 64 * j) * 4; u32x2 o = {pk2(v[j][0] * inv, v[j][1] * inv), pk2(v[j][2] * inv, v[j][3] * inv)};
            *(u32x2*)(P + (size_t)R * NKP + k) = o; }
    }
    const bf16_t* dS = (const bf16_t*)(ws + WS_R1); bf16_t* Sst = (bf16_t*)(ws + WS_R2); const float* gam = fsm + F_GAMMA;
    for (int gid = (F.vcu * 8 + F.wave) * 64 + lane; gid < 4 * 512 * 64; gid += F.G * 512) {
        const int dq = gid & 63, e = (gid >> 6) & 511, h = gid >> 15;
        f32x4 st = {0.f, 0.f, 0.f, 0.f};
#pragma unroll 8
        for (int c = 0; c < 32; ++c) { const int hc = h * 32 + c; const size_t idx = ((size_t)hc * 512 + e) * 256 + dq * 4;
            const u32x2 w = *(const u32x2*)(dS + idx); const f32x4 g = *(const f32x4*)(gam + hc * 256 + dq * 4);
            u32x2 o = {pk2(st[0], st[1]), pk2(st[2], st[3])}; *(u32x2*)(Sst + idx) = o;
            st[0] = g[0] * st[0] + bflo(w.x); st[1] = g[1] * st[1] + bfhi(w.x); st[2] = g[2] * st[2] + bflo(w.y); st[3] = g[3] * st[3] + bfhi(w.y); }
        float* op = F.out + O_STP + ((size_t)h * 256 + dq * 4) * 512 + e;
        op[0] = st[0]; op[512] = st[1]; op[1024] = st[2]; op[1536] = st[3];
    }
}

__device__ __forceinline__ void p8_pc_convert(Frame& F) {
    const int gt = (F.vcu * 8 + F.wave) * 64 + F.lane, NGT = F.G * 512;
    const float* PCp = (const float*)(F.ws + WS_R1); bf16_t* PCb = (bf16_t*)(F.ws + WS_ZQK) + 8 * MiB;
    for (int i = gt; i < 16 * 256 * 64; i += NGT) { const size_t e = (size_t)i * 8; f32x4 a = {0.f, 0.f, 0.f, 0.f}, b = a;
#pragma unroll
        for (int ks = 0; ks < 3; ++ks) { const float* s = PCp + (size_t)ks * 16 * 256 * 512 + e; a += *(const f32x4*)s; b += *(const f32x4*)(s + 4); }
        u32x4 o = {pk2(a[0], a[1]), pk2(a[2], a[3]), pk2(b[0], b[1]), pk2(b[2], b[3])}; *(u32x4*)(PCb + e) = o; }
}

__device__ __forceinline__ void p9_ffn_weights(Frame& F) {
    LAS float* scr = (LAS float*)(F.lds + F.wave * 16384);
    const int gw = F.vcu * 8 + F.wave, NGW = F.G * 8, lane = F.lane, n = lane & 31;
    for (int it = gw; it < 16384; it += NGW) {
        if (it < 8192) { const int kb = it / 256, nb = it % 256; tr_item(F.in[20], DFF, (bf16_t*)(F.ws + WS_R1), 2048, kb * 64, nb * 32, nb * 32 + n, F.in[19], scr, lane); }
        else { const int r = it - 8192, kb = r / 64, nb = r % 64; tr_item(F.in[21], 2048, (bf16_t*)(F.ws + WS_R3), DFF, kb * 64, nb * 32, nb * 32 + n, nullptr, scr, lane); }
    }
}
__device__ __forceinline__ void p9_gla_sample(Frame& F) {
    unsigned char* ws = F.ws; float* fsm = (float*)(ws + WS_FSM);
    const bf16_t* ZQK = (const bf16_t*)(ws + WS_ZQK); bf16_t* ZV = (bf16_t*)(ws + WS_ZV); const bf16_t* ZM = (const bf16_t*)(ws + WS_ZM);
    const float* wa2 = F.in[15]; const float* ba_ = F.in[16]; const float* S0 = F.in[4];
    LAS float* alr_s = (LAS float*)F.lds;
    LAS float* qt_s = alr_s + 256;
    LAS float* kt_s = qt_s + 4096;
    LAS float* ke_s = kt_s + 4096;
    LAS float* gam_s = ke_s + 4096;
    LAS float* A_s = gam_s + 256;
    const int tid = F.tid;
    for (int un = F.vcu; un < 64; un += F.G) {
        const int b = un >> 2, h = un & 3; const int row0 = SEQ + b * 16;
        if (tid < 256) alr_s[tid] = bf2f(ZM[(size_t)(row0 + (tid >> 4)) * 256 + 64 + (tid & 15)]);
        __syncthreads();
        if (tid < 256) { const int d = tid; float bb[16]; float bc = 0.f; const float ba = ba_[h * 256 + d]; float wa[16];
#pragma unroll
            for (int r = 0; r < 16; ++r) wa[r] = wa2[r * 1024 + h * 256 + d];
#pragma unroll
            for (int t = 0; t < 16; ++t) { float x = ba;
#pragma unroll
                for (int r = 0; r < 16; ++r) x += alr_s[t * 16 + r] * wa[r];
                bc += logsig16(x); bb[t] = bc; }
#pragma unroll
            for (int t = 0; t < 16; ++t) { const size_t tr = (size_t)(row0 + t) * 2048;
                const float gq = bf2f(ZQK[tr + h * 256 + d]), gk = bf2f(ZQK[tr + 1024 + h * 256 + d]);
                qt_s[d * 16 + t] = gq * 0.0625f * __expf(bb[t]); kt_s[d * 16 + t] = gk * __expf(-bb[t]); ke_s[d * 16 + t] = gk * __expf(bc - bb[t]); }
            gam_s[d] = __expf(bc); }
        __syncthreads();
        if (tid < 256) { const int t = tid >> 4, s = tid & 15; float a = 0.f;
            for (int d = 0; d < 256; ++d) a += qt_s[d * 16 + t] * kt_s[d * 16 + s];
            A_s[tid] = (s <= t) ? a : 0.f; }
        __syncthreads();
        const int e = tid; float v[16], o[16];
#pragma unroll
        for (int t = 0; t < 16; ++t) v[t] = bf2f(ZV[(size_t)(row0 + t) * 2048 + h * 512 + e]);
#pragma unroll
        for (int t = 0; t < 16; ++t) { float a = 0.f;
#pragma unroll
            for (int s = 0; s < 16; ++s) a += A_s[t * 16 + s] * v[s];
            o[t] = a; }
        const float* sp = S0 + ((size_t)(b * 4 + h) * 256) * 512 + e; float* op = F.out + O_STS + ((size_t)(b * 4 + h) * 256) * 512 + e;
#pragma unroll 4
        for (int d = 0; d < 256; ++d) { const float s0 = sp[(size_t)d * 512]; float sn = gam_s[d] * s0;
            const LAS f32x4* q4 = (const LAS f32x4*)(qt_s + d * 16); const LAS f32x4* k4 = (const LAS f32x4*)(ke_s + d * 16);
#pragma unroll
            for (int j = 0; j < 4; ++j) { const f32x4 qv = q4[j], kv = k4[j];
#pragma unroll
                for (int i = 0; i < 4; ++i) { o[j * 4 + i] += qv[i] * s0; sn += kv[i] * v[j * 4 + i]; } }
            op[(size_t)d * 512] = sn; }
#pragma unroll
        for (int t = 0; t < 16; ++t) { ZV[(size_t)(row0 + t) * 2048 + h * 512 + e] = f2bf(o[t]);
            const float s = wave_sum(o[t] * o[t]); if (F.lane == 0) alr_s[t * 8 + F.wave] = s; }
        __syncthreads();
        if (tid < 16) { float s = 0.f;
#pragma unroll
            for (int w = 0; w < 8; ++w) s += alr_s[tid * 8 + w];
            fsm[F_SSQ_OG + ((size_t)(row0 + tid) * 4 + h) * 2] = s; fsm[F_SSQ_OG + ((size_t)(row0 + tid) * 4 + h) * 2 + 1] = 0.f; }
        __syncthreads();
    }
}

__device__ __forceinline__ void p10_mix(Frame& F) {
    const int gt = (F.vcu * 8 + F.wave) * 64 + F.lane, NGT = F.G * 512;
    unsigned char* ws = F.ws; const float* fsm = (const float*)(ws + WS_FSM); const float* gn = F.in[17];
    bf16_t* ZOG = (bf16_t*)(ws + WS_ZOG); const bf16_t* ZGM = (const bf16_t*)(ws + WS_ZGM); const bf16_t* ZGG = (const bf16_t*)(ws + WS_ZGG); const bf16_t* ZV = (const bf16_t*)(ws + WS_ZV);
    for (int i = gt; i < NTOK * 256; i += NGT) { const int t = i >> 8, c8 = (i & 255) * 8, hg = c8 >> 9; const size_t e = (size_t)t * 2048 + c8;
        const float inv = rsqrtf((fsm[F_SSQ_OG + ((size_t)t * 4 + hg) * 2] + fsm[F_SSQ_OG + ((size_t)t * 4 + hg) * 2 + 1]) * (1.f / 512.f) + EPS);
        const u32x4 wm = *(const u32x4*)(ZGM + e), wg = *(const u32x4*)(ZGG + e), wo = *(const u32x4*)(ZOG + e), wv = *(const u32x4*)(ZV + e);
        const f32x4 g0 = *(const f32x4*)(gn + (c8 & 511)), g1 = *(const f32x4*)(gn + (c8 & 511) + 4);
        const float m[8] = {bflo(wm.x), bfhi(wm.x), bflo(wm.y), bfhi(wm.y), bflo(wm.z), bfhi(wm.z), bflo(wm.w), bfhi(wm.w)};
        const float gg[8] = {bflo(wg.x), bfhi(wg.x), bflo(wg.y), bfhi(wg.y), bflo(wg.z), bfhi(wg.z), bflo(wg.w), bfhi(wg.w)};
        const float og[8] = {bflo(wo.x), bfhi(wo.x), bflo(wo.y), bfhi(wo.y), bflo(wo.z), bfhi(wo.z), bflo(wo.w), bfhi(wo.w)};
        const float ov[8] = {bflo(wv.x), bfhi(wv.x), bflo(wv.y), bfhi(wv.y), bflo(wv.z), bfhi(wv.z), bflo(wv.w), bfhi(wv.w)};
        const float gnv[8] = {g0[0], g0[1], g0[2], g0[3], g1[0], g1[1], g1[2], g1[3]};
        float r[8];
#pragma unroll
        for (int k = 0; k < 8; ++k) r[k] = m[k] + sigmoidf_(gg[k]) * (og[k] * sigmoidf_(og[k])) * (ov[k] * inv * gnv[k]);
        u32x4 o = {pk2(r[0], r[1]), pk2(r[2], r[3]), pk2(r[4], r[5]), pk2(r[6], r[7])}; *(u32x4*)(ZOG + e) = o; }
}

__device__ __forceinline__ void t_reduce_wo(Frame& F) {
    const int gw = F.vcu * 8 + F.wave, NGW = F.G * 8, lane = F.lane;
    float* fsm = (float*)(F.ws + WS_FSM); const float* Yp = (const float*)(F.ws + WS_R4); bf16_t* x1b = (bf16_t*)(F.ws + WS_R2);
    for (int r = gw; r < NSAMP; r += NGW) { float ss = 0.f;
#pragma unroll
        for (int j = 0; j < 4; ++j) { const int c = (lane + 64 * j) * 8; const float* xr = F.in[1] + (size_t)r * DM + c;
            f32x4 a = *(const f32x4*)xr, b = *(const f32x4*)(xr + 4);
#pragma unroll
            for (int ks = 0; ks < 8; ++ks) { const float* s = Yp + ((size_t)ks * 256 + r) * DM + c; a += *(const f32x4*)s; b += *(const f32x4*)(s + 4); }
            float* yp = F.out + O_Y + (size_t)(SEQ + r) * DM + c; *(f32x4*)yp = a; *(f32x4*)(yp + 4) = b;
            u32x4 o = {pk2(a[0], a[1]), pk2(a[2], a[3]), pk2(b[0], b[1]), pk2(b[2], b[3])}; *(u32x4*)(x1b + (size_t)(SEQ + r) * DM + c) = o;
            ss += (a[0] * a[0] + a[1] * a[1]) + (a[2] * a[2] + a[3] * a[3]) + (b[0] * b[0] + b[1] * b[1]) + (b[2] * b[2] + b[3] * b[3]); }
        ss = wave_sum(ss);
        if (lane < 8) fsm[F_SSQ_X1 + (size_t)(SEQ + r) * 8 + lane] = lane == 0 ? ss : 0.f; }
}
__device__ __forceinline__ void t_reduce_up(Frame& F) {
    const int gt = (F.vcu * 8 + F.wave) * 64 + F.lane, NGT = F.G * 512;
    const float* fsm = (const float*)(F.ws + WS_FSM); const float* U = (const float*)(F.ws + WS_R5); bf16_t* Hb = (bf16_t*)(F.ws + WS_ZL);
    for (int i = gt; i < NSAMP * 1024; i += NGT) { const int r = i >> 10, c = (i & 1023) * 8;
        const float inv2 = 1.f / (fsm[F_SSQ_X1 + (size_t)(SEQ + r) * 8] * (1.f / 2048.f) + EPS);
        f32x4 a = {0.f, 0.f, 0.f, 0.f}, b = a;
#pragma unroll
        for (int ks = 0; ks < 4; ++ks) { const float* s = U + ((size_t)ks * 256 + r) * DFF + c; a += *(const f32x4*)s; b += *(const f32x4*)(s + 4); }
#pragma unroll
        for (int k = 0; k < 4; ++k) { const float x = fmaxf(a[k], 0.f), y = fmaxf(b[k], 0.f); a[k] = x * x * inv2; b[k] = y * y * inv2; }
        u32x4 o = {pk2(a[0], a[1]), pk2(a[2], a[3]), pk2(b[0], b[1]), pk2(b[2], b[3])}; *(u32x4*)(Hb + (size_t)(SEQ + r) * DFF + c) = o; }
}
__device__ __forceinline__ void t_reduce_down(Frame& F) {
    const int gt = (F.vcu * 8 + F.wave) * 64 + F.lane, NGT = F.G * 512;
    const float* Dp = (const float*)(F.ws + WS_R4);
    for (int i = gt; i < NSAMP * 256; i += NGT) { const int r = i >> 8, c = (i & 255) * 8;
        float* yp = F.out + O_Y + (size_t)(SEQ + r) * DM + c; f32x4 a = *(const f32x4*)yp, b = *(const f32x4*)(yp + 4);
#pragma unroll
        for (int ks = 0; ks < 16; ++ks) { const float* s = Dp + ((size_t)ks * 256 + r) * DM + c; a += *(const f32x4*)s; b += *(const f32x4*)(s + 4); }
        *(f32x4*)yp = a; *(f32x4*)(yp + 4) = b; }
}

#ifndef N_LAUNCHES
#define N_LAUNCHES 1
#endif
constexpr int N_PHASES = 17;

__device__ __forceinline__ att::BlockRef att_ref(Frame& F, int h, int qb, int dry) {
    att::BlockRef r;
    r.Q = (const bf16_t*)(F.ws + WS_R1) + ((size_t)h * NTOK + (size_t)qb * 256) * 192;
    r.K = (const bf16_t*)(F.out + O_Y) + (size_t)h * SEQ * 192;
    r.V = (const bf16_t*)(F.ws + WS_R2) + (size_t)h * SEQ * 128;
    r.G = (bf16_t*)(F.ws + WS_ZGM) + (size_t)qb * 256 * 2048 + h * 128;
    r.qb = qb; r.dry = dry; return r;
}
__device__ __forceinline__ void p4_attention(Frame& F, int dry) {
    const int nblk = 512;
    int n = F.vcu * 2; if (n >= nblk) return;
    att::Seam S;
    att::BlockRef cur = att_ref(F, n >> 5, (n & 1) ? 31 - ((n >> 1) & 15) : ((n >> 1) & 15), dry);
    att::prime(cur, (char*)F.lds, S);
    for (;;) {
        int nn = (n & 1) ? (n - 1 + 2 * F.G) : n + 1;
        const bool last = nn >= nblk;
        const att::BlockRef nxt = last ? cur : att_ref(F, nn >> 5, (nn & 1) ? 31 - ((nn >> 1) & 15) : ((nn >> 1) & 15), dry);
        att::block(cur, nxt, (char*)F.lds, S);
        if (last) break;
        cur = nxt; n = nn;
    }
}

struct Args { const float* in[22]; float* out; unsigned char* ws; float freq[32]; int ph_lo, ph_hi, li, probe; };

__global__ void __launch_bounds__(512, 2) mega_fwd(Args args) {
    extern __shared__ __attribute__((aligned(16))) unsigned char lds_raw[];
    Frame F;
    F.lds = (LAS unsigned char*)lds_raw; F.ws = args.ws; F.out = args.out; F.in = args.in;
    F.tid = threadIdx.x; F.lane = F.tid & 63; F.wave = __builtin_amdgcn_readfirstlane(F.tid >> 6);
    F.G = gridDim.x; { const int bx = blockIdx.x; F.vcu = (F.G % 8 == 0) ? (bx % 8) * (F.G / 8) + bx / 8 : bx; }
    volatile LAS unsigned* MISC = (volatile LAS unsigned*)(F.lds + MISC_OFF);
    for (int u = F.tid; u < (LDS_BYTES - LDSCTL_OFF) / 4; u += 512) ((LAS unsigned*)(F.lds + LDSCTL_OFF))[u] = 0u;
    __syncthreads();
    XcdBarrier bar; bar.bar = (unsigned*)(F.ws + WS_CTL) + 4096; bar.x = 0; bar.st = nullptr;
    if (N_LAUNCHES == 1) bar = xcd_barrier_post((unsigned*)(F.ws + WS_CTL) + 4096, MISC + 8);
    EP ep; ep.ws = F.ws; ep.out = F.out; ep.xp = args.in[0]; ep.xs = args.in[1]; ep.lds = F.lds; ep.dry = 0;
    const int lo = args.ph_lo, hi = args.ph_hi;
#ifndef PH_MASK
#define PH_MASK 0xffffffff
#endif
#define IN(k) ((((unsigned)PH_MASK >> (k)) & 1u) && lo <= (k) && (k) < hi)
#define SEAM(k) do { if (IN(k) && IN((k) + 1)) xcd_barrier(bar); { int t_ = threadIdx.x; asm volatile("" : "+v"(t_)); F.tid = t_; F.lane = t_ & 63; } } while (0)
    int rot = 0;
    if (IN(0)) {
        p0_prologue(F);
        { float* cs = (float*)(F.ws + WS_FSM) + F_ROPE; const int gt = (F.vcu * 8 + F.wave) * 64 + F.lane;
          for (int i = gt; i < SEQ * 32; i += F.G * 512) { const int p = i >> 5, k = i & 31;
              const float ang = (float)p * args.freq[k];
              const double xd = (double)ang; const double kq = __builtin_rint(xd * 0.63661977236758134308); const float r = (float)(xd - kq * 1.57079632679489661923);
              const float sr = __sinf(r), cr = __cosf(r); const int q = ((int)kq) & 3;
              const float c = (q == 0) ? cr : (q == 1) ? -sr : (q == 2) ? -cr : sr;
              const float s = (q == 0) ? sr : (q == 1) ? cr : (q == 2) ? -sr : -cr;
              cs[p * 64 + k] = c; cs[p * 64 + 32 + k] = s; } }
    }
#if defined(PROBE) && (PROBE & 4)
    if (IN(0) && args.probe) { p0_prologue(F); }
#endif
#if defined(PROBE) && (PROBE & 64)
    if (args.probe) { for (int i = 0; i < 10; ++i) xcd_barrier(bar); }
#endif
    SEAM(0);
    if (IN(1)) { rot = 0; run_gemm<M_INPROJ>(F, ep, 33 * 45, 4096, 4096, 32, 32, rot);
#if defined(PROBE) && (PROBE & 1)
        if (args.probe) { EP ed = ep; ed.dry = args.probe; rot = 0; run_gemm<M_INPROJ>(F, ed, 33 * 45, 4096, 4096, 32, 32, rot); }
#endif
    }
    SEAM(1);
    if (IN(2)) { rot = 0; run_gemm<M_QUP>(F, ep, 33 * 12, 2048, 1024, 8, 8, rot); run_gemm<M_KVUP>(F, ep, 33 * 16, 2048, 1024, 8, 8, rot); p2_ckv_krope(F); }
#if defined(PROBE) && (PROBE & 128)
    if (IN(2) && args.probe) { EP ed = ep; ed.dry = args.probe; rot = 0; run_gemm<M_QUP>(F, ed, 33 * 12, 2048, 1024, 8, 8, rot); run_gemm<M_KVUP>(F, ed, 33 * 16, 2048, 1024, 8, 8, rot);
        run_gemm<M_CNORM>(F, ed, 144 * 8, 1280, 1024, 8, 8, rot); }
#endif
    SEAM(2);
    if (IN(3)) { p3_finalize_qk(F); p3_kcat_ct(F); p3_gla_prep(F); }
#if defined(PROBE) && (PROBE & 8)
    if (IN(3) && args.probe) { p3_kcat_ct(F); }
#endif
#if defined(PROBE) && (PROBE & 256)
    if (IN(3) && args.probe) { p3_gla_prep(F); }
#endif
    SEAM(3);
#if defined(PROBE) && (PROBE & 2)
    if (IN(4) && args.probe) { p4_attention(F, args.probe); }
#endif
    if (IN(4)) { rot = 0; p4_attention(F, 0); run_gemm<M_QABS>(F, ep, 32, 512, 512, 4, 4, rot); run_gemm<M_CNORM>(F, ep, 144 * 8, 1280, 1024, 8, 8, rot); }
    SEAM(4);
    if (IN(5)) { rot = 0; run_gemm<M_S>(F, ep, 144, 1280, 1280, 10, 10, rot); run_gemm<M_GLA_A>(F, ep, 128, 512, 512, 4, 4, rot); run_gemm<M_GLA_DS>(F, ep, 256, 512, 512, 4, 4, rot); }
    SEAM(5);
    if (IN(6)) { p6_softmax_scan(F); }
#if defined(PROBE) && (PROBE & 16)
    if (IN(6) && args.probe) { p6_softmax_scan(F); }
#endif
    SEAM(6);
    if (IN(7)) { rot = 0; run_gemm<M_PC>(F, ep, 96, 4608, 4608, 12, 12, rot); { int r2 = rot; run_gemm<M_GLA_O>(F, ep, 256, 512, 512, 4, 4, r2); } run_gemm<M_GLA_O2>(F, ep, 256, 512, 512, 4, 4, rot);     }
    SEAM(7);
    if (IN(8)) { p8_pc_convert(F); }
    SEAM(8);
    if (IN(9)) { rot = 0; run_gemm<M_O>(F, ep, 16, 1024, 1024, 8, 8, rot); p9_gla_sample(F); p9_ffn_weights(F); }
#if defined(PROBE) && (PROBE & 32)
    if (IN(9) && args.probe) { p9_ffn_weights(F); }
#endif
    SEAM(9);
    if (IN(10)) { p10_mix(F); }
    SEAM(10);
    if (IN(11)) { rot = 0; run_gemm<M_WO_S>(F, ep, 64, 4096, 4096, 4, 4, rot); run_gemm<M_WO>(F, ep, 32 * 8, 4096, 4096, 32, 32, rot); }
    SEAM(11);
    if (IN(12)) { t_reduce_wo(F); }
    SEAM(12);
    if (IN(13)) { rot = 0; run_gemm<M_UP_S>(F, ep, 128, 4096, 4096, 8, 8, rot); run_gemm<M_UP>(F, ep, 32 * 32, 4096, 4096, 32, 32, rot); }
    SEAM(13);
    if (IN(14)) { t_reduce_up(F); }
    SEAM(14);
    if (IN(15)) { rot = 0; run_gemm<M_DOWN_S>(F, ep, 128, 16384, 16384, 8, 8, rot); run_gemm<M_DOWN>(F, ep, 32 * 8, 16384, 16384, 128, 128, rot); }
    SEAM(15);
    if (IN(16)) { t_reduce_down(F); }
#undef IN
#undef SEAM
}

extern "C" void kernel_launch(void* const* d_in, const int* in_sizes, int n_in, void* d_out, int out_size, void* d_ws, size_t ws_size, hipStream_t stream) {
    static int grid = 0;
    if (grid == 0) {
        if (n_in != 22 || out_size != (int)O_END || ws_size < WS_END) { fprintf(stderr, "kernel_launch: unexpected shapes (n_in %d out %d ws %zu)\n", n_in, out_size, ws_size); grid = -1; return; }
        int dev = 0, cus = 0, per_cu = 0;
        if (hipGetDevice(&dev) != hipSuccess || hipDeviceGetAttribute(&cus, hipDeviceAttributeMultiprocessorCount, dev) != hipSuccess) { grid = -1; return; }
        if (hipFuncSetAttribute((const void*)mega_fwd, hipFuncAttributeMaxDynamicSharedMemorySize, LDS_BYTES) != hipSuccess) { fprintf(stderr, "kernel_launch: hipFuncSetAttribute failed\n"); grid = -1; return; }
        if (hipOccupancyMaxActiveBlocksPerMultiprocessor(&per_cu, (const void*)mega_fwd, 512, LDS_BYTES) != hipSuccess || per_cu < 1) { fprintf(stderr, "kernel_launch: occupancy query says %d blocks per CU\n", per_cu); (void)hipGetLastError(); grid = -1; return; }
        grid = cus;
    }
    if (grid < 0) return;
    (void)hipMemsetAsync((char*)d_ws + WS_CTL, 0, CTL_BYTES, stream);
    Args a{};
    for (int i = 0; i < 22; ++i) a.in[i] = (const float*)d_in[i];
    a.out = (float*)d_out; a.ws = (unsigned char*)d_ws;
#ifdef PROBE
    a.probe = 1;
#endif
    for (int k = 0; k < 32; ++k) a.freq[k] = powf(10000.f, -(float)k / 32.f);
    if (N_LAUNCHES == 1) { a.ph_lo = 0; a.ph_hi = N_PHASES; a.li = 0; hipLaunchKernelGGL(mega_fwd, dim3(grid), dim3(512), LDS_BYTES, stream, a); }
    else { for (int p = 0; p < N_PHASES; ++p) { a.ph_lo = p; a.ph_hi = p + 1; a.li = p; hipLaunchKernelGGL(mega_fwd, dim3(grid), dim3(512), LDS_BYTES, stream, a); } }
}
```

```cpp
#include <hip/hip_runtime.h>
#include <hip/hip_bf16.h>
#include <cstdio>
#include <cstdint>

#define LAS __attribute__((address_space(3)))
#define GAS __attribute__((address_space(1)))
typedef unsigned short bf16_t;
typedef short bf16x8 __attribute__((ext_vector_type(8)));
typedef short s16x4 __attribute__((ext_vector_type(4)));
typedef float f32x4 __attribute__((ext_vector_type(4)));
typedef float f32x2 __attribute__((ext_vector_type(2)));
typedef float f32x16 __attribute__((ext_vector_type(16)));
typedef unsigned u32x4 __attribute__((ext_vector_type(4)));
typedef unsigned u32x2 __attribute__((ext_vector_type(2)));

constexpr int DM = 2048, SEQ = 8192, NSAMP = 256, NTOK = 8448, NZ = 11520, DFF = 8192, DIN = 11344;
constexpr int NH = 16, QKD = 192, NOPE = 128, ROPE = 64, VD = 128, QR = 512, KVR = 512;
constexpr int GH = 4, GDK = 256, GDV = 512, GC = 256, NCH = 32;
constexpr int PAST = 2048, NKEY = 2064, NKP = 2304, DQC = 640, DECB = 16, DECS = 16;
constexpr float EPS = 1e-6f;
constexpr float LOG2E = 1.4426950408889634f;
constexpr float MLA_SCALE = 0.07216878364870322f;

constexpr size_t MiB = 1u << 20;
constexpr size_t WS_CTL = 0, CTL_BYTES = 1 * MiB;
constexpr size_t WS_FSM = 1 * MiB;
constexpr size_t WS_WSM = 7 * MiB;
constexpr size_t WS_ZL = 30 * MiB, WS_ZM = 47 * MiB, WS_ZQK = 52 * MiB, WS_ZV = 85 * MiB, WS_ZOG = 118 * MiB, WS_ZGM = 151 * MiB, WS_ZGG = 184 * MiB;
constexpr size_t WS_R1 = 217 * MiB, WS_R2 = 267 * MiB, WS_R3 = 300 * MiB, WS_R4 = 345 * MiB, WS_R5 = 381 * MiB, WS_END = 413 * MiB;
constexpr size_t F_SSQ_QL = 0  , F_SSQ_KV = F_SSQ_QL + 16896  , F_SSQ_X1 = F_SSQ_KV + 16896  , F_KRSS = F_SSQ_X1 + 67584, F_SSQ_K = F_KRSS + 8448  ,
                 F_SSQ_OG = F_SSQ_K + 135168  , F_KNSS_C = F_SSQ_OG + 135168, F_KRSS_C = F_KNSS_C + 589824, F_GAMMA = F_KRSS_C + 36864, F_ROPE = F_GAMMA + 32768, F_END = F_ROPE + 524288;
static_assert(F_END * 4 <= 6 * MiB, "FSM");
constexpr size_t W_UQ = 0, W_UKVG = W_UQ + 3072 * 512, W_KNP = W_UKVG + 4096 * 512, W_VP = W_KNP + 2048 * 512, W_KNABS = W_VP + 2048 * 512, W_O = W_KNABS + 16 * 512 * 256, W_END = W_O + 2048 * 2048;
static_assert(W_END * 2 <= 23 * MiB, "WSM");
constexpr size_t O_Y = 0, O_CKVP = 17301504, O_KRP = 21495808, O_STP = 22020096, O_CKVS = 22544384, O_KRS = 22675456, O_STS = 22691840, O_END = 31080448;

#define RLX_AGENT __ATOMIC_RELAXED, __HIP_MEMORY_SCOPE_AGENT
__device__ __forceinline__ unsigned cvt_pk_bf16(float lo, float hi) { unsigned r; asm volatile("v_cvt_pk_bf16_f32 %0, %1, %2" : "=v"(r) : "v"(lo), "v"(hi)); return r; }
__device__ __forceinline__ float bf2f(unsigned short b) { return __uint_as_float(((unsigned)b) << 16); }
__device__ __forceinline__ float bflo(unsigned w) { return __uint_as_float(w << 16); }
__device__ __forceinline__ float bfhi(unsigned w) { return __uint_as_float(w & 0xffff0000u); }
__device__ __forceinline__ unsigned short f2bf(float f) { return (unsigned short)(cvt_pk_bf16(f, 0.f) & 0xffffu); }
__device__ __forceinline__ float sigmoidf_(float x) { return 1.f / (1.f + __expf(-x)); }
__device__ __forceinline__ int lane_id_() { int l_; asm volatile("v_mbcnt_lo_u32_b32 %0, -1, 0\n\tv_mbcnt_hi_u32_b32 %0, -1, %0" : "=v"(l_)); return l_; }
__device__ __forceinline__ float wave_sum(float v) {
#pragma unroll
    for (int o = 1; o < 64; o <<= 1) v += __shfl_xor(v, o);
    return v;
}
__device__ __forceinline__ float wave_max(float v) {
#pragma unroll
    for (int o = 1; o < 64; o <<= 1) v = fmaxf(v, __shfl_xor(v, o));
    return v;
}

#ifndef XCD_LOCAL_TAIL
#define XCD_LOCAL_TAIL 1
#endif
#define XB_TMO      128
#define XB_XCNT(j)  (256  + 64 * (j))
#define XB_XSUB(j)  (1280 + 64 * (j))
#define XB_XGEN(j)  (2304 + 64 * (j))
#define XB_TOP      3328
#define XB_TOPGEN   3392
#define XCD_BAR_WORDS 3456
#define XB_SPIN_CAP (1u << 22)
__device__ __forceinline__ unsigned xb_ld(unsigned* p)              { return __hip_atomic_load(p, __ATOMIC_RELAXED, __HIP_MEMORY_SCOPE_AGENT); }
__device__ __forceinline__ unsigned xb_add(unsigned* p, unsigned v) { return __hip_atomic_fetch_add(p, v, __ATOMIC_RELAXED, __HIP_MEMORY_SCOPE_AGENT); }
__device__ __forceinline__ unsigned xb_xcc_id() { return (unsigned)__builtin_amdgcn_s_getreg((3 << 11) | 20) & 0xFu; }
#define XB_SPIN(cond, bar) do { unsigned _sp = 0; while (cond) { __builtin_amdgcn_s_sleep(1); \
    if ((++_sp & 255u) == 0u) { if (xb_ld(&(bar)[XB_TMO])) break; if (_sp > XB_SPIN_CAP) { atomicAdd(&(bar)[XB_TMO], 1u); break; } } } } while (0)
struct XcdBarrier { unsigned* bar; unsigned x; volatile LAS unsigned* st; };
__device__ __forceinline__ XcdBarrier xcd_barrier_post(unsigned* bar, volatile LAS unsigned* st, bool t0) {
    XcdBarrier b; b.bar = bar; b.x = xb_xcc_id(); b.st = st;
    if (t0) st[4] = xb_add(&bar[XB_XCNT(b.x)], 1u);
    return b;
}
__device__ __forceinline__ void xcd_barrier_complete(unsigned* bar, unsigned x, unsigned& nloc, unsigned& nx, unsigned& minc, unsigned& xi) {
    const unsigned G = gridDim.x * gridDim.y * gridDim.z;
    unsigned sum, cnt, mine, mn, below, sp = 0u;
    for (;;) {
        sum = 0u; cnt = 0u; mine = 0u; mn = ~0u; below = 0u;
#pragma unroll
        for (unsigned j = 0; j < 16; ++j) { const unsigned c = xb_ld(&bar[XB_XCNT(j)]); sum += c; cnt += (c > 0u) ? 1u : 0u; mine = (j == x) ? c : mine; mn = (c > 0u && c < mn) ? c : mn; below += (c > 0u && j < x) ? 1u : 0u; }
        if (sum == G) break;
        __builtin_amdgcn_s_sleep(1);
        if ((++sp & 255u) == 0u) { if (xb_ld(&bar[XB_TMO])) break; if (sp > XB_SPIN_CAP) { atomicAdd(&bar[XB_TMO], 1u); break; } }
    }
    nloc = mine > 0u ? mine : 1u; nx = cnt > 0u ? cnt : 1u; minc = mn; xi = below;
}
__device__ __forceinline__ void xcd_local_join(unsigned* ctr, unsigned target, unsigned* bar, bool t0) {
    asm volatile("s_waitcnt vmcnt(0)" ::: "memory");
    __syncthreads();
    if (t0) {
        __builtin_amdgcn_s_waitcnt(0);
        (void)xb_add(ctr, 1u);
        XB_SPIN(xb_ld(ctr) < target, bar);
        __builtin_amdgcn_fence(__ATOMIC_ACQUIRE, "agent");
        asm volatile("s_waitcnt vmcnt(0)" ::: "memory");
    }
    __syncthreads();
}
__device__ __forceinline__ void xcd_barrier(const XcdBarrier& b, bool t0) {
    asm volatile("s_waitcnt vmcnt(0)" ::: "memory");
    __syncthreads();
    if (t0) {
        unsigned* bar = b.bar;
        __builtin_amdgcn_s_waitcnt(0);
        unsigned nloc = b.st[0], nx = b.st[1];
        if (nloc == 0u) { unsigned minc, xi; xcd_barrier_complete(bar, b.x, nloc, nx, minc, xi); b.st[0] = nloc; b.st[1] = nx; b.st[2] = minc; b.st[3] = xi; }
        const unsigned old = xb_add(&bar[XB_XSUB(b.x)], 1u);
        const unsigned gen = old / nloc;
        if (old + 1u == (gen + 1u) * nloc) {
            __builtin_amdgcn_fence(__ATOMIC_RELEASE, "agent");
            asm volatile("s_waitcnt vmcnt(0)" ::: "memory");
            const unsigned og = xb_add(&bar[XB_TOP], 1u);
            const unsigned tg = og / nx;
            if (og + 1u == (tg + 1u) * nx) xb_add(&bar[XB_TOPGEN], 1u);
            else XB_SPIN(xb_ld(&bar[XB_TOPGEN]) == tg, bar);
            __builtin_amdgcn_fence(__ATOMIC_ACQUIRE, "agent");
            xb_add(&bar[XB_XGEN(b.x)], 1u);
            asm volatile("s_waitcnt vmcnt(0)" ::: "memory");
        } else {
            XB_SPIN(xb_ld(&bar[XB_XGEN(b.x)]) == gen, bar);
            __builtin_amdgcn_fence(__ATOMIC_ACQUIRE, "agent");
            asm volatile("s_waitcnt vmcnt(0)" ::: "memory");
        }
    }
    __syncthreads();
}

constexpr int RING_BYTES = 131072, LDSCTL_OFF = RING_BYTES, MISC_OFF = LDSCTL_OFF + 320, LDS_BYTES = 147456;

struct Frame {
    LAS unsigned char* lds; unsigned char* ws; float* out; const float* const* in;
    int tid, lane, wave, vcu, G;
};

namespace pg8 {
constexpr int BM = 256, BK = 64, HALF = 128, HTB = HALF * BK * 2, STAGE_BYTES = 8 * HTB;
__device__ __forceinline__ int lds_byte(int r, int c) { const int st = (r >> 4) * 2 + (c >> 5), rr = r & 15, cc = c & 31, ob = rr * 64 + cc * 2; return st * 1024 + (ob ^ (((ob >> 9) & 1) << 5)); }
__device__ __forceinline__ void stage_rc(int b, int& R, int& C) { const int st = b / 1024, sb = b % 1024, swz = sb ^ (((sb >> 9) & 1) << 5); R = (st >> 1) * 16 + swz / 64; C = (st & 1) * 32 + (swz % 64) / 2; }
__device__ __forceinline__ int perm32(int rho) { const int n = rho >> 4, i = rho & 15; return 8 * (i >> 2) + 4 * n + (i & 3); }

struct GUnit { const char* A; const char* B; int pm, pn, aux; };
struct GCfg { unsigned lda, ldb; int nt, t1; };

typedef f32x4 Acc[2][2][4][2];

template <class Epi, class Sched>
__device__ __forceinline__ void gemm_phase(LAS unsigned char* lds, const GCfg g, const Sched& S, const Epi& E, int wave) {
    int lane_ = lane_id_(); asm volatile("" : "+v"(lane_));
    const int wid = wave, lane = lane_, tid = wid * 64 + lane, wr = wid >> 2, wc = wid & 3, fr = lane & 15, fq = lane >> 4;
    const int nt = g.nt;
    unsigned voffA[2], voffB[2];
#pragma unroll
    for (int i = 0; i < 2; ++i) { int R, C; stage_rc(tid * 16 + i * 8192, R, C); const int Rb = (R & ~31) + perm32(R & 31);
        voffA[i] = (unsigned)R * g.lda + (unsigned)C * 2u; voffB[i] = (unsigned)Rb * g.ldb + (unsigned)C * 2u; }
    const size_t kstep = (size_t)(BK * 2);
    const size_t hstepA = (size_t)HALF * g.lda, hstepB = (size_t)HALF * g.ldb;
    const unsigned ldsw = (unsigned)wid * 1024u;
    const int aoff = lds_byte(wr * 64 + fr, fq * 8), boff = lds_byte(wc * 32 + fr, fq * 8);
#define PG8_SA(b, h) (((b) * 2 + (h)) * HTB)
#define PG8_SB(b, h) ((4 + (b) * 2 + (h)) * HTB)
#define PG8_STAGE(bufoff, gbase, voff) do { _Pragma("unroll") for (int _i = 0; _i < 2; ++_i) \
        __builtin_amdgcn_global_load_lds((const unsigned*)((const char*)(gbase) + (voff)[_i]), (LAS unsigned*)(lds + (bufoff) + ldsw + _i * 8192), 16, 0, 0); } while (0)
#define PG8_LDA(dst, b, h) do { _Pragma("unroll") for (int m = 0; m < 4; ++m) _Pragma("unroll") for (int k = 0; k < 2; ++k) dst[m][k] = *(const LAS bf16x8*)(lds + PG8_SA(b, h) + aoff + m * 2048 + k * 1024); } while (0)
#define PG8_LDB(dst, b, h) do { _Pragma("unroll") for (int n = 0; n < 2; ++n) _Pragma("unroll") for (int k = 0; k < 2; ++k) dst[n][k] = *(const LAS bf16x8*)(lds + PG8_SB(b, h) + boff + n * 2048 + k * 1024); } while (0)
#define PG8_MMA(ai, bj, At, Bt) do { __builtin_amdgcn_s_setprio(1); _Pragma("unroll") for (int m = 0; m < 4; ++m) _Pragma("unroll") for (int n = 0; n < 2; ++n) _Pragma("unroll") for (int k = 0; k < 2; ++k) \
        acc[ai][bj][m][n] = __builtin_amdgcn_mfma_f32_16x16x32_bf16(Bt[n][k], At[m][k], acc[ai][bj][m][n], 0, 0, 0); __builtin_amdgcn_s_setprio(0); } while (0)
#define PG8_WAIT_V(n) asm volatile("s_waitcnt vmcnt(" #n ")" ::: "memory")
#define PG8_WAIT_L(n) asm volatile("s_waitcnt lgkmcnt(" #n ")" ::: "memory")
#define PG8_BAR __builtin_amdgcn_s_barrier()
#define PG8_SCHED __builtin_amdgcn_sched_barrier(0)
#define PG8_APTR(u, t) ((u).A + (size_t)(t) * kstep)
#define PG8_BPTR(u, t) ((u).B + (size_t)(t) * kstep)
    GUnit cur, nxt; int ui = 0;
    if (!S.next(0, cur)) return;
    Acc acc;
#pragma unroll
    for (int a = 0; a < 2; ++a)
#pragma unroll
        for (int b = 0; b < 2; ++b)
#pragma unroll
            for (int m = 0; m < 4; ++m)
#pragma unroll
                for (int n = 0; n < 2; ++n) acc[a][b][m][n] = (f32x4){0.f, 0.f, 0.f, 0.f};
    bf16x8 At[4][2], B0[2][2], B1[2][2];
    {
        const char* cA = cur.A; const char* cB = cur.B;
        PG8_STAGE(PG8_SB(0, 0), cB, voffB); PG8_STAGE(PG8_SB(0, 1), cB + hstepB, voffB); PG8_STAGE(PG8_SA(0, 0), cA, voffA); PG8_STAGE(PG8_SA(0, 1), cA + hstepA, voffA);
        if (wr == 1) PG8_BAR;
        PG8_WAIT_V(2); PG8_BAR;
        PG8_STAGE(PG8_SB(1, 0), cB + kstep, voffB); PG8_STAGE(PG8_SA(1, 0), cA + kstep, voffA); PG8_STAGE(PG8_SB(1, 1), cB + hstepB + kstep, voffB);
        PG8_WAIT_V(6); PG8_BAR;
    }
    for (;;) {
        const bool has_next = S.next(ui + 1, nxt);
        if (!has_next) nxt = cur;
        for (int t = 0; t < nt; t += 2) {
            const bool last = (t == nt - 2);
            const char* a1 = PG8_APTR(cur, t + 1);
            const char* a2 = last ? nxt.A : PG8_APTR(cur, t + 2); const char* b2 = last ? nxt.B : PG8_BPTR(cur, t + 2);
            const char* a3 = last ? nxt.A + kstep : PG8_APTR(cur, t + 3); const char* b3 = last ? nxt.B + kstep : PG8_BPTR(cur, t + 3);
            PG8_LDB(B0, 0, 0); PG8_LDB(B1, 0, 1); PG8_SCHED; PG8_LDA(At, 0, 0); PG8_STAGE(PG8_SA(1, 1), a1 + hstepA, voffA);
            PG8_WAIT_V(8); PG8_WAIT_L(0); PG8_BAR; PG8_MMA(0, 0, At, B0); PG8_MMA(0, 1, At, B1); PG8_BAR; PG8_SCHED;
            PG8_LDA(At, 0, 1); PG8_STAGE(PG8_SB(0, 0), b2, voffB); PG8_STAGE(PG8_SB(0, 1), b2 + hstepB, voffB); PG8_STAGE(PG8_SA(0, 0), a2, voffA);
            PG8_WAIT_V(8); PG8_WAIT_L(0); PG8_BAR; PG8_MMA(1, 0, At, B0); PG8_MMA(1, 1, At, B1); PG8_BAR; PG8_SCHED;
            PG8_LDB(B0, 1, 0); PG8_LDB(B1, 1, 1); PG8_SCHED; PG8_LDA(At, 1, 0); PG8_STAGE(PG8_SA(0, 1), a2 + hstepA, voffA);
            PG8_WAIT_V(8); PG8_WAIT_L(0); PG8_BAR; PG8_MMA(0, 0, At, B0); PG8_MMA(0, 1, At, B1); PG8_BAR; PG8_SCHED;
            PG8_LDA(At, 1, 1); PG8_STAGE(PG8_SB(1, 0), b3, voffB); PG8_STAGE(PG8_SB(1, 1), b3 + hstepB, voffB); PG8_STAGE(PG8_SA(1, 0), a3, voffA);
            PG8_WAIT_V(8); PG8_WAIT_L(0); PG8_BAR; PG8_MMA(1, 0, At, B0); PG8_MMA(1, 1, At, B1); PG8_BAR; PG8_SCHED;
        }
        if (wr == 0) PG8_BAR;
        { int fr_ = fr, fq_ = fq; asm volatile("" : "+v"(fr_), "+v"(fq_));
          E(acc, cur, wr, wc, fr_, fq_); }
        if (!has_next) break;
#pragma unroll
        for (int a = 0; a < 2; ++a)
#pragma unroll
            for (int b = 0; b < 2; ++b)
#pragma unroll
                for (int m = 0; m < 4; ++m)
#pragma unroll
                    for (int n = 0; n < 2; ++n) acc[a][b][m][n] = (f32x4){0.f, 0.f, 0.f, 0.f};
        cur = nxt; ++ui;
        if (wr == 1) PG8_BAR;
    }
    PG8_WAIT_V(0);
    PG8_BAR;
#undef PG8_SA
#undef PG8_SB
#undef PG8_STAGE
#undef PG8_LDA
#undef PG8_LDB
#undef PG8_MMA
#undef PG8_WAIT_V
#undef PG8_WAIT_L
#undef PG8_BAR
#undef PG8_SCHED
#undef PG8_APTR
#undef PG8_BPTR
}

__device__ __forceinline__ void tile_of(int L, int nM, int nN, int& pm, int& pn) {
    const int nig = 8 * nN, gid = L / nig, fm = gid * 8, gsz = (nM - fm) < 8 ? (nM - fm) : 8, r = L % nig;
    pm = fm + r % gsz; pn = r / gsz;
}
}

enum { M_INPROJ = 0, M_QUP, M_KVUP, M_CNORM, M_QABS, M_S, M_PC, M_O, M_GLA_A, M_GLA_DS, M_GLA_O, M_GLA_O2, M_WO, M_UP, M_DOWN, M_WO_S, M_UP_S, M_DOWN_S };

struct EP { unsigned char* ws; float* out; const float* xp; const float* xs; const float* gqn; const float* gqr; const float* gkn; const float* gkr; LAS unsigned char* lds; int dry; };
constexpr int EPI_RED_OFF = 131072 + 1024;

__device__ __forceinline__ u32x4 pack8(const f32x4 v0, const f32x4 v1) {
    u32x4 w; w.x = cvt_pk_bf16(v0[0], v0[1]); w.y = cvt_pk_bf16(v0[2], v0[3]); w.z = cvt_pk_bf16(v1[0], v1[1]); w.w = cvt_pk_bf16(v1[2], v1[3]); return w;
}
#ifndef WT_STORES
#define WT_STORES 0
#endif
__device__ __forceinline__ void st16(void* ptr, const u32x4 v) {
#if WT_STORES
    asm volatile("global_store_dwordx4 %0, %1, off sc1\n\ts_nop 1" :: "v"(ptr), "v"(v) : "memory");
#else
    *(u32x4*)ptr = v;
#endif
}
__device__ __forceinline__ float sumsq8(const f32x4 a, const f32x4 b) {
    return (a[0] * a[0] + a[1] * a[1]) + (a[2] * a[2] + a[3] * a[3]) + (b[0] * b[0] + b[1] * b[1]) + (b[2] * b[2] + b[3] * b[3]);
}
__device__ __forceinline__ float red_fq(float s) { s += __shfl_xor(s, 16); s += __shfl_xor(s, 32); return s; }


__device__ __forceinline__ void epi_red_put(LAS unsigned char* lds, int slot, const float (&part)[2][4], int rt0, int wc, int fq) {
    LAS float* red = (LAS float*)(lds + EPI_RED_OFF) + slot * 1024;
    if (fq == 0) {
#pragma unroll
        for (int ai = 0; ai < 2; ++ai)
#pragma unroll
            for (int m = 0; m < 4; ++m) red[(rt0 + ai * 128 + m * 16) * 4 + wc] = part[ai][m];
    }
}
__device__ __forceinline__ void epi_red_sync() { asm volatile("s_waitcnt lgkmcnt(0)" ::: "memory"); __builtin_amdgcn_s_barrier(); asm volatile("" ::: "memory"); }
__device__ __forceinline__ float epi_red_get(LAS unsigned char* lds, int slot, int row) {
    const LAS f32x4* red = (const LAS f32x4*)(lds + EPI_RED_OFF) + slot * 256; const f32x4 v = red[row]; return (v[0] + v[1]) + (v[2] + v[3]);
}

template <int MODE> struct Epi {
    EP p;
    __device__ __forceinline__ void operator()(const pg8::Acc& acc, const pg8::GUnit& u, int wr, int wc, int fr, int fq) const {
        unsigned char* ws = p.ws;
        float* fsm = (float*)(ws + WS_FSM);
#ifdef PROBE
        if (p.dry == 1) {
#pragma unroll
            for (int a = 0; a < 2; ++a)
#pragma unroll
                for (int b = 0; b < 2; ++b)
#pragma unroll
                    for (int m = 0; m < 4; ++m) asm volatile("" :: "v"(acc[a][b][m][0]), "v"(acc[a][b][m][1]));
            return; }
#endif
        const int rt0 = wr * 64 + fr;
        const int ct0 = wc * 32 + 8 * fq;
        if constexpr (MODE == M_INPROJ) {
            const int pn = u.pn;
            if (pn >= 20 && pn < 36) {
                bf16_t* base = (bf16_t*)(ws + WS_ZGG) + (pn - 20) * 128 + ct0;
#pragma unroll
                for (int ai = 0; ai < 2; ++ai)
#pragma unroll
                    for (int m = 0; m < 4; ++m) {
                        const int row = u.pm * 256 + rt0 + ai * 128 + m * 16;
                        f32x4 o0, o1;
#pragma unroll
                        for (int i = 0; i < 4; ++i) { const float g0 = acc[ai][0][m][0][i], g1 = acc[ai][0][m][1][i], x0 = acc[ai][1][m][0][i], x1 = acc[ai][1][m][1][i];
                            o0[i] = sigmoidf_(g0) * x0 * sigmoidf_(x0); o1[i] = sigmoidf_(g1) * x1 * sigmoidf_(x1); }
                        *(u32x4*)(base + (size_t)row * 2048) = pack8(o0, o1);
                    }
            } else {
            bf16_t* base; int ld;
            if (pn < 4) { base = (bf16_t*)(ws + WS_ZL) + pn * 256; ld = 1024; }
            else if (pn < 12) { base = (bf16_t*)(ws + WS_ZQK) + (pn - 4) * 256; ld = 2048; }
            else if (pn < 20) { base = (bf16_t*)(ws + WS_ZV) + (pn - 12) * 256; ld = 2048; }
            else if (pn < 44) { base = (bf16_t*)(ws + WS_ZGM) + (pn - 36) * 256; ld = 2048; }
            else { base = (bf16_t*)(ws + WS_ZM); ld = 256; }
            float part[2][4];
#pragma unroll
            for (int ai = 0; ai < 2; ++ai)
#pragma unroll
                for (int m = 0; m < 4; ++m) {
                    const int row = u.pm * 256 + rt0 + ai * 128 + m * 16;
                    bf16_t* rowp = base + (size_t)row * ld + ct0;
                    *(u32x4*)(rowp) = pack8(acc[ai][0][m][0], acc[ai][0][m][1]);
                    *(u32x4*)(rowp + 128) = pack8(acc[ai][1][m][0], acc[ai][1][m][1]);
                    part[ai][m] = red_fq(sumsq8(acc[ai][0][m][0], acc[ai][0][m][1]) + sumsq8(acc[ai][1][m][0], acc[ai][1][m][1]));
                }
            if (pn < 4) {
                epi_red_put(p.lds, 0, part, rt0, wc, fq); epi_red_sync();
                const int tid = (wr * 4 + wc) * 64 + fq * 16 + fr;
                if (tid < 256) fsm[(pn < 2 ? F_SSQ_QL : F_SSQ_KV) + (size_t)(u.pm * 256 + tid) * 2 + (pn & 1)] = epi_red_get(p.lds, 0, tid);
            }
            }
        } else if constexpr (MODE == M_QUP) {
            bf16_t* Qp = (bf16_t*)(ws + WS_R1);
            float* ssq = (float*)((char*)(p.out + O_Y) + 56 * MiB);
#pragma unroll
            for (int bj = 0; bj < 2; ++bj) {
                const int c = u.pn * 256 + bj * 128 + ct0, h = c / 192, j = c - h * 192;
                const int grp = u.pn * 8 + bj * 4 + wc;
#pragma unroll
                for (int ai = 0; ai < 2; ++ai)
#pragma unroll
                    for (int m = 0; m < 4; ++m) {
                        const int row = u.pm * 256 + rt0 + ai * 128 + m * 16;
                        st16(Qp + ((size_t)h * NTOK + row) * 192 + j, pack8(acc[ai][bj][m][0], acc[ai][bj][m][1]));
                        float s = red_fq(sumsq8(acc[ai][bj][m][0], acc[ai][bj][m][1]));
                        if (fq == 0) ssq[(size_t)row * 96 + grp] = s;
                    }
            }
        } else if constexpr (MODE == M_KVUP) {
            bf16_t* Kp = (bf16_t*)(p.out + O_Y); bf16_t* Vp = (bf16_t*)(ws + WS_R2);
            const float* ssq_kv = fsm + F_SSQ_KV; const bf16_t* ZM = (const bf16_t*)(ws + WS_ZM);
            const int h = u.pn, tid = (wr * 4 + wc) * 64 + fq * 16 + fr; float part[2][4], invr[2][4];
            { f32x2 sq[2][4];
#pragma unroll
              for (int ai = 0; ai < 2; ++ai)
#pragma unroll
                  for (int m = 0; m < 4; ++m) sq[ai][m] = *(const f32x2*)(ssq_kv + (size_t)(u.pm * 256 + rt0 + ai * 128 + m * 16) * 2);
              asm volatile("" ::: "memory");
#pragma unroll
              for (int ai = 0; ai < 2; ++ai)
#pragma unroll
                  for (int m = 0; m < 4; ++m) invr[ai][m] = rsqrtf((sq[ai][m][0] + sq[ai][m][1]) * (1.f / 512.f) + EPS); }
#pragma unroll
            for (int ai = 0; ai < 2; ++ai)
#pragma unroll
                for (int m = 0; m < 4; ++m) {
                    const int row = u.pm * 256 + rt0 + ai * 128 + m * 16;
                    const float inv = invr[ai][m];
                    if (row < SEQ) *(u32x4*)(Vp + ((size_t)h * SEQ + row) * 128 + ct0) = pack8(acc[ai][1][m][0] * inv, acc[ai][1][m][1] * inv);
                    part[ai][m] = red_fq(sumsq8(acc[ai][0][m][0], acc[ai][0][m][1])) * inv * inv;
                }
            epi_red_put(p.lds, 0, part, rt0, wc, fq);
            LAS float* invk_s = (LAS float*)(p.lds + EPI_RED_OFF + 8192);
            u32x4 kr[8]; const int krow = u.pm * 256 + (tid & 255);
            if (tid < 256) {
#pragma unroll
                for (int i = 0; i < 8; ++i) kr[i] = *(const u32x4*)(ZM + (size_t)krow * 256 + i * 8);
            }
            epi_red_sync();
            if (tid < 256) {
                float x[64];
#pragma unroll
                for (int i = 0; i < 8; ++i) { x[8 * i] = bflo(kr[i].x); x[8 * i + 1] = bfhi(kr[i].x); x[8 * i + 2] = bflo(kr[i].y); x[8 * i + 3] = bfhi(kr[i].y);
                    x[8 * i + 4] = bflo(kr[i].z); x[8 * i + 5] = bfhi(kr[i].z); x[8 * i + 6] = bflo(kr[i].w); x[8 * i + 7] = bfhi(kr[i].w); }
                float krss = 0.f;
#pragma unroll
                for (int i = 0; i < 64; ++i) krss += x[i] * x[i];
                const float invk = rsqrtf((epi_red_get(p.lds, 0, tid) + krss) * (1.f / 192.f) + EPS);
                invk_s[tid] = invk;
                if (krow >= SEQ) { const int r_ = krow - SEQ; fsm[F_KNSS_C + ((size_t)(r_ >> 4) * 16 + h) * NKP + PAST + (r_ & 15)] = invk; }
                if (krow < SEQ) {
                    const float* cs = fsm + F_ROPE + (size_t)krow * 64; const float* gqr = p.gqr; const float* gkr = p.gkr;
                    bf16_t* kd = Kp + ((size_t)h * SEQ + krow) * 192 + 128;
#pragma unroll
                    for (int i8 = 0; i8 < 4; ++i8) { float y1[8], y2[8];
#pragma unroll
                        for (int j = 0; j < 8; ++j) { const int i = i8 * 8 + j; const float c = cs[i], sn = cs[32 + i], g = gqr[i] * gkr[i] * invk;
                            y1[j] = (x[i] * c - x[32 + i] * sn) * g; y2[j] = (x[32 + i] * c + x[i] * sn) * g; }
                        *(u32x4*)(kd + i8 * 8) = (u32x4){cvt_pk_bf16(y1[0], y1[1]), cvt_pk_bf16(y1[2], y1[3]), cvt_pk_bf16(y1[4], y1[5]), cvt_pk_bf16(y1[6], y1[7])};
                        *(u32x4*)(kd + 32 + i8 * 8) = (u32x4){cvt_pk_bf16(y2[0], y2[1]), cvt_pk_bf16(y2[2], y2[3]), cvt_pk_bf16(y2[4], y2[5]), cvt_pk_bf16(y2[6], y2[7])}; }
                }
            }
            epi_red_sync();
            if (u.pm < 32) {
                const f32x4 g0 = *(const f32x4*)(p.gqn + ct0) * *(const f32x4*)(p.gkn + ct0), g1 = *(const f32x4*)(p.gqn + ct0 + 4) * *(const f32x4*)(p.gkn + ct0 + 4);
#pragma unroll
                for (int ai = 0; ai < 2; ++ai)
#pragma unroll
                    for (int m = 0; m < 4; ++m) {
                        const int rt = rt0 + ai * 128 + m * 16; const float ik = invk_s[rt] * invr[ai][m];
                        *(u32x4*)(Kp + ((size_t)h * SEQ + u.pm * 256 + rt) * 192 + ct0) = pack8(acc[ai][0][m][0] * ik * g0, acc[ai][0][m][1] * ik * g1);
                    }
            }
        } else if constexpr (MODE == M_CNORM) {
            float* knss = fsm + F_KNSS_C; float part[2][2][4];
#pragma unroll
            for (int bj = 0; bj < 2; ++bj)
#pragma unroll
                for (int ai = 0; ai < 2; ++ai)
#pragma unroll
                    for (int m = 0; m < 4; ++m) part[bj][ai][m] = red_fq(sumsq8(acc[ai][bj][m][0], acc[ai][bj][m][1]));
            epi_red_put(p.lds, 0, part[0], rt0, wc, fq); epi_red_put(p.lds, 1, part[1], rt0, wc, fq); epi_red_sync();
            { const int tid = (wr * 4 + wc) * 64 + fq * 16 + fr, row = tid & 255, bj = tid >> 8; const int R = u.pm * 256 + row, b = R / NKP, k = R - b * NKP, h = u.pn * 2 + bj;
              knss[((size_t)b * 16 + h) * NKP + k] = rsqrtf((epi_red_get(p.lds, bj, row) + fsm[F_KRSS_C + R]) * (1.f / 192.f) + EPS); }
        } else if constexpr (MODE == M_QABS) {
            bf16_t* Qcat = (bf16_t*)(p.out + O_Y) + 48 * MiB / 2;
            const int h = u.aux;
#pragma unroll
            for (int ai = 0; ai < 2; ++ai)
#pragma unroll
                for (int m = 0; m < 4; ++m) {
                    const int r = rt0 + ai * 128 + m * 16, b = r >> 4, q = r & 15;
                    bf16_t* rowp = Qcat + ((size_t)b * 256 + h * 16 + q) * DQC + u.pn * 256 + ct0;
                    *(u32x4*)(rowp) = pack8(acc[ai][0][m][0], acc[ai][0][m][1]);
                    *(u32x4*)(rowp + 128) = pack8(acc[ai][1][m][0], acc[ai][1][m][1]);
                }
        } else if constexpr (MODE == M_S) {
            bf16_t* Pb = (bf16_t*)(p.out + O_Y); const float* invk_t = fsm + F_KNSS_C; const int b = u.aux; float part[2][4];
#pragma unroll
            for (int ai = 0; ai < 2; ++ai) {
                f32x4 ia[4][2], ib[4][2];
#pragma unroll
                for (int m = 0; m < 4; ++m) { const int h = (rt0 + ai * 128 + m * 16) >> 4;
#pragma unroll
                    for (int bj = 0; bj < 2; ++bj) { const float* ik = invk_t + ((size_t)b * 16 + h) * NKP + u.pn * 256 + bj * 128 + ct0; ia[m][bj] = *(const f32x4*)ik; ib[m][bj] = *(const f32x4*)(ik + 4); } }
                asm volatile("" ::: "memory");
#pragma unroll
                for (int m = 0; m < 4; ++m) {
                    const int r = rt0 + ai * 128 + m * 16; float s_ = 0.f;
#pragma unroll
                    for (int bj = 0; bj < 2; ++bj) {
                        const int k = u.pn * 256 + bj * 128 + ct0; const f32x4 i0 = ia[m][bj], i1 = ib[m][bj];
                        f32x4 o0, o1;
#pragma unroll
                        for (int i = 0; i < 4; ++i) { o0[i] = (k + i < NKEY) ? __builtin_amdgcn_exp2f(acc[ai][bj][m][0][i] * i0[i]) : 0.f; o1[i] = (k + 4 + i < NKEY) ? __builtin_amdgcn_exp2f(acc[ai][bj][m][1][i] * i1[i]) : 0.f; }
                        *(u32x4*)(Pb + ((size_t)b * 256 + r) * NKP + k) = pack8(o0, o1);
                        s_ += ((o0[0] + o0[1]) + (o0[2] + o0[3])) + ((o1[0] + o1[1]) + (o1[2] + o1[3]));
                    }
                    part[ai][m] = red_fq(s_);
                }
            }
            epi_red_put(p.lds, 0, part, rt0, wc, fq); epi_red_sync();
            { const int tid = (wr * 4 + wc) * 64 + fq * 16 + fr; if (tid < 256) fsm[F_SSQ_K + ((size_t)b * 256 + tid) * 9 + u.pn] = epi_red_get(p.lds, 0, tid); }
        } else if constexpr (MODE == M_PC) {
            float* PCp = (float*)(ws + WS_R5);
            const int b = u.aux >> 2, ks = u.aux & 3;
#pragma unroll
            for (int ai = 0; ai < 2; ++ai)
#pragma unroll
                for (int m = 0; m < 4; ++m) {
                    const int r = rt0 + ai * 128 + m * 16, h = r >> 4, q = r & 15;
                    float* rowp = PCp + (((size_t)ks * 16 + h) * 256 + b * 16 + q) * 512 + u.pn * 256 + ct0;
#pragma unroll
                    for (int bj = 0; bj < 2; ++bj) { *(f32x4*)(rowp + bj * 128) = acc[ai][bj][m][0]; *(f32x4*)(rowp + bj * 128 + 4) = acc[ai][bj][m][1]; }
                }
        } else if constexpr (MODE == M_O) {
            bf16_t* Zgm = (bf16_t*)(ws + WS_ZGM);
            const int h = u.aux, bj = h & 1;
            u32x4 g8[2][4];
#pragma unroll
            for (int ai = 0; ai < 2; ++ai)
#pragma unroll
                for (int m = 0; m < 4; ++m) g8[ai][m] = *(const u32x4*)(Zgm + (size_t)(SEQ + rt0 + ai * 128 + m * 16) * 2048 + h * 128 + ct0);
            asm volatile("" ::: "memory");
#pragma unroll
            for (int ai = 0; ai < 2; ++ai)
#pragma unroll
                for (int m = 0; m < 4; ++m) {
                    const int r = rt0 + ai * 128 + m * 16;
                    bf16_t* gp = Zgm + (size_t)(SEQ + r) * 2048 + h * 128 + ct0;
                    const u32x4 g = g8[ai][m];
                    const f32x4 a0 = bj ? acc[ai][1][m][0] : acc[ai][0][m][0], a1 = bj ? acc[ai][1][m][1] : acc[ai][0][m][1];
                    f32x4 o0, o1;
                    o0[0] = a0[0] * sigmoidf_(bflo(g.x)); o0[1] = a0[1] * sigmoidf_(bfhi(g.x)); o0[2] = a0[2] * sigmoidf_(bflo(g.y)); o0[3] = a0[3] * sigmoidf_(bfhi(g.y));
                    o1[0] = a1[0] * sigmoidf_(bflo(g.z)); o1[1] = a1[1] * sigmoidf_(bfhi(g.z)); o1[2] = a1[2] * sigmoidf_(bflo(g.w)); o1[3] = a1[3] * sigmoidf_(bfhi(g.w));
                    *(u32x4*)gp = pack8(o0, o1);
                }
        } else if constexpr (MODE == M_GLA_A) {
          if (u.aux < 128) {
            bf16_t* Am = (bf16_t*)(ws + WS_ZQK) + (size_t)u.aux * 65536;
#pragma unroll
            for (int ai = 0; ai < 2; ++ai)
#pragma unroll
                for (int m = 0; m < 4; ++m) {
                    const int t = rt0 + ai * 128 + m * 16;
#pragma unroll
                    for (int bj = 0; bj < 2; ++bj) {
                        const int s0 = bj * 128 + ct0;
                        f32x4 a0 = acc[ai][bj][m][0], a1 = acc[ai][bj][m][1];
#pragma unroll
                        for (int i = 0; i < 4; ++i) { if (s0 + i > t) a0[i] = 0.f; if (s0 + 4 + i > t) a1[i] = 0.f; }
                        *(u32x4*)(Am + (size_t)t * 256 + s0) = pack8(a0, a1);
                        asm volatile("" ::: "memory");
                    }
                }
          } else {
            bf16_t* dS = (bf16_t*)(ws + WS_R1) + (size_t)(u.aux - 128) * 131072;
#pragma unroll
            for (int ai = 0; ai < 2; ++ai)
#pragma unroll
                for (int m = 0; m < 4; ++m) {
                    const int e = u.pm * 256 + rt0 + ai * 128 + m * 16;
                    bf16_t* rowp = dS + (size_t)e * 256 + ct0;
                    *(u32x4*)(rowp) = pack8(acc[ai][0][m][0], acc[ai][0][m][1]);
                    *(u32x4*)(rowp + 128) = pack8(acc[ai][1][m][0], acc[ai][1][m][1]);
                }
          }
        } else if constexpr (MODE == M_GLA_O) {
            bf16_t* Zv = (bf16_t*)(ws + WS_ZV); float* ssq = fsm + F_SSQ_OG;
            const bool second = (u.aux & 128) != 0; const int hc = u.aux & 127, h = hc >> 5, c = hc & 31; float part[2][4];
#pragma unroll
            for (int ai = 0; ai < 2; ++ai) {
                u32x4 wa[4], wb[4];
                if (second) {
#pragma unroll
                    for (int m = 0; m < 4; ++m) { const bf16_t* rowp = Zv + (size_t)(c * 256 + rt0 + ai * 128 + m * 16) * 2048 + h * 512 + u.pn * 256 + ct0; wa[m] = *(const u32x4*)(rowp); wb[m] = *(const u32x4*)(rowp + 128); }
                } else {
#pragma unroll
                    for (int m = 0; m < 4; ++m) { wa[m] = (u32x4){0u, 0u, 0u, 0u}; wb[m] = wa[m]; }
                }
                asm volatile("" ::: "memory");
#pragma unroll
                for (int m = 0; m < 4; ++m) {
                    const int t = c * 256 + rt0 + ai * 128 + m * 16;
                    bf16_t* rowp = Zv + (size_t)t * 2048 + h * 512 + u.pn * 256 + ct0;
                    f32x4 a0 = acc[ai][0][m][0], a1 = acc[ai][0][m][1], b0 = acc[ai][1][m][0], b1 = acc[ai][1][m][1];
                    a0[0] += bflo(wa[m].x); a0[1] += bfhi(wa[m].x); a0[2] += bflo(wa[m].y); a0[3] += bfhi(wa[m].y); a1[0] += bflo(wa[m].z); a1[1] += bfhi(wa[m].z); a1[2] += bflo(wa[m].w); a1[3] += bfhi(wa[m].w);
                    b0[0] += bflo(wb[m].x); b0[1] += bfhi(wb[m].x); b0[2] += bflo(wb[m].y); b0[3] += bfhi(wb[m].y); b1[0] += bflo(wb[m].z); b1[1] += bfhi(wb[m].z); b1[2] += bflo(wb[m].w); b1[3] += bfhi(wb[m].w);
                    *(u32x4*)(rowp) = pack8(a0, a1);
                    *(u32x4*)(rowp + 128) = pack8(b0, b1);
                    part[ai][m] = red_fq(sumsq8(a0, a1) + sumsq8(b0, b1));
                }
            }
            if (second) {
                epi_red_put(p.lds, 0, part, rt0, wc, fq); epi_red_sync();
                const int tid = (wr * 4 + wc) * 64 + fq * 16 + fr; if (tid < 256) { float* q = ssq + ((size_t)(c * 256 + tid) * 4 + h) * 4 + u.pn; q[0] = epi_red_get(p.lds, 0, tid); q[2] = 0.f; }
            }
        } else if constexpr (MODE == M_WO) {
            bf16_t* x1b = (bf16_t*)(ws + WS_R2); float* ssq = fsm + F_SSQ_X1; float part[2][4];
#pragma unroll
            for (int ai = 0; ai < 2; ++ai) {
                f32x4 xa[4][2], xb[4][2];
#pragma unroll
                for (int m = 0; m < 4; ++m) { const int row = u.pm * 256 + rt0 + ai * 128 + m * 16;
                    const float* xr = (row < SEQ ? p.xp + (size_t)row * DM : p.xs + (size_t)(row - SEQ) * DM) + u.pn * 256 + ct0;
#pragma unroll
                    for (int bj = 0; bj < 2; ++bj) { xa[m][bj] = *(const f32x4*)(xr + bj * 128); xb[m][bj] = *(const f32x4*)(xr + bj * 128 + 4); } }
                asm volatile("" ::: "memory");
#pragma unroll
                for (int m = 0; m < 4; ++m) { const int row = u.pm * 256 + rt0 + ai * 128 + m * 16; float s_ = 0.f;
#pragma unroll
                    for (int bj = 0; bj < 2; ++bj) {
                        const f32x4 x0 = xa[m][bj] + acc[ai][bj][m][0], x1 = xb[m][bj] + acc[ai][bj][m][1];
                        st16(x1b + (size_t)row * DM + u.pn * 256 + bj * 128 + ct0, pack8(x0, x1));
                        s_ += sumsq8(x0, x1);
                    }
                    part[ai][m] = red_fq(s_); }
            }
            epi_red_put(p.lds, 0, part, rt0, wc, fq); epi_red_sync();
            { const int tid = (wr * 4 + wc) * 64 + fq * 16 + fr; if (tid < 256) ssq[(size_t)(u.pm * 256 + tid) * 8 + u.pn] = epi_red_get(p.lds, 0, tid); }
        } else if constexpr (MODE == M_UP) {
            bf16_t* Hb = (bf16_t*)(ws + WS_ZL); const float* ssq = fsm + F_SSQ_X1;
            f32x4 q0[2][4], q1[2][4];
#pragma unroll
            for (int ai = 0; ai < 2; ++ai)
#pragma unroll
                for (int m = 0; m < 4; ++m) { const int row = u.pm * 256 + rt0 + ai * 128 + m * 16; q0[ai][m] = *(const f32x4*)(ssq + (size_t)row * 8); q1[ai][m] = *(const f32x4*)(ssq + (size_t)row * 8 + 4); }
            asm volatile("" ::: "memory");
#pragma unroll
            for (int ai = 0; ai < 2; ++ai)
#pragma unroll
                for (int m = 0; m < 4; ++m) {
                    const int row = u.pm * 256 + rt0 + ai * 128 + m * 16;
                    const f32x4 a_ = q0[ai][m], b_ = q1[ai][m];
                    const float inv2 = 1.f / (((a_[0] + a_[1]) + (a_[2] + a_[3]) + (b_[0] + b_[1]) + (b_[2] + b_[3])) * (1.f / 2048.f) + EPS);
#pragma unroll
                    for (int bj = 0; bj < 2; ++bj) {
                        f32x4 a0 = acc[ai][bj][m][0], a1 = acc[ai][bj][m][1];
#pragma unroll
                        for (int i = 0; i < 4; ++i) { const float r0 = fmaxf(a0[i], 0.f), r1 = fmaxf(a1[i], 0.f); a0[i] = r0 * r0 * inv2; a1[i] = r1 * r1 * inv2; }
                        st16(Hb + (size_t)row * DFF + u.pn * 256 + bj * 128 + ct0, pack8(a0, a1));
                    }
                }
        } else if constexpr (MODE == M_DOWN) {
            float* Y = p.out + O_Y; const bf16_t* x1b = (const bf16_t*)(ws + WS_R2);
#pragma unroll
            for (int ai = 0; ai < 2; ++ai) {
                u32x4 w[4][2];
#pragma unroll
                for (int m = 0; m < 4; ++m)
#pragma unroll
                    for (int bj = 0; bj < 2; ++bj) w[m][bj] = *(const u32x4*)(x1b + (size_t)(u.pm * 256 + rt0 + ai * 128 + m * 16) * DM + u.pn * 256 + bj * 128 + ct0);
                asm volatile("" ::: "memory");
#pragma unroll
                for (int m = 0; m < 4; ++m)
#pragma unroll
                    for (int bj = 0; bj < 2; ++bj) {
                        const size_t e = (size_t)(u.pm * 256 + rt0 + ai * 128 + m * 16) * DM + u.pn * 256 + bj * 128 + ct0; const u32x4 w_ = w[m][bj];
                        f32x4 y0 = acc[ai][bj][m][0], y1 = acc[ai][bj][m][1];
                        y0[0] += bflo(w_.x); y0[1] += bfhi(w_.x); y0[2] += bflo(w_.y); y0[3] += bfhi(w_.y); y1[0] += bflo(w_.z); y1[1] += bfhi(w_.z); y1[2] += bflo(w_.w); y1[3] += bfhi(w_.w);
                        *(f32x4*)(Y + e) = y0; *(f32x4*)(Y + e + 4) = y1;
                    }
            }
        } else if constexpr (MODE == M_WO_S || MODE == M_UP_S || MODE == M_DOWN_S) {
            constexpr int ld = (MODE == M_UP_S) ? DFF : DM;
            float* slab = (float*)(ws + (MODE == M_UP_S ? WS_R5 : WS_R4)) + (size_t)u.aux * 256 * ld;
#pragma unroll
            for (int ai = 0; ai < 2; ++ai)
#pragma unroll
                for (int m = 0; m < 4; ++m) {
                    float* rowp = slab + (size_t)(rt0 + ai * 128 + m * 16) * ld + u.pn * 256 + ct0;
#pragma unroll
                    for (int bj = 0; bj < 2; ++bj) { *(f32x4*)(rowp + bj * 128) = acc[ai][bj][m][0]; *(f32x4*)(rowp + bj * 128 + 4) = acc[ai][bj][m][1]; }
                }
        }
    }
};

template <int MODE> struct Sched {
    unsigned char* ws; float* out; int G, c, n;
    __device__ __forceinline__ bool next(int i, pg8::GUnit& u) const {
        int L = i * G + c;
        if constexpr (MODE == M_GLA_O) { const int j = (i >> 1) * G + c; if (j >= 256) return false; L = j + 256 * (i & 1); }
        else { if (L >= n) return false; }
        u.aux = 0;
        if constexpr (MODE == M_INPROJ) {
            pg8::tile_of(L, 33, 45, u.pm, u.pn);
            u.A = (const char*)(ws + WS_R2) + (size_t)u.pm * 256 * 4096; u.B = (const char*)(ws + WS_R1) + (size_t)u.pn * 256 * 4096;
        } else if constexpr (MODE == M_QUP) {
            pg8::tile_of(L, 33, 12, u.pm, u.pn);
            u.A = (const char*)(ws + WS_ZL) + (size_t)u.pm * 256 * 2048; u.B = (const char*)(ws + WS_WSM) + (W_UQ + (size_t)u.pn * 256 * 512) * 2;
        } else if constexpr (MODE == M_KVUP) {
            pg8::tile_of(L, 33, 16, u.pm, u.pn);
            u.A = (const char*)(ws + WS_ZL) + (size_t)u.pm * 256 * 2048 + 1024; u.B = (const char*)(ws + WS_WSM) + (W_UKVG + (size_t)u.pn * 256 * 512) * 2;
        } else if constexpr (MODE == M_CNORM) {
            pg8::tile_of(L, 128, 8, u.pm, u.pn); u.pm = (u.pm >> 3) * 9 + (u.pm & 7);
            u.A = (const char*)(ws + WS_R3) + (size_t)u.pm * 256 * (DQC * 2); u.B = (const char*)(ws + WS_WSM) + (W_KNP + (size_t)u.pn * 256 * 512) * 2;
        } else if constexpr (MODE == M_QABS) {
            const int h = L >> 1; u.pm = 0; u.pn = L & 1; u.aux = h;
            u.A = (const char*)(out + O_Y) + 53 * MiB + (size_t)h * 256 * 512; u.B = (const char*)(ws + WS_WSM) + (W_KNABS + ((size_t)h * 512 + u.pn * 256) * 256) * 2;
        } else if constexpr (MODE == M_S) {
            const int b = L / 9; u.pm = 0; u.pn = L - b * 9; u.aux = b;
            u.A = (const char*)(out + O_Y) + 48 * MiB + (size_t)b * 256 * (DQC * 2); u.B = (const char*)(ws + WS_R3) + ((size_t)b * NKP + u.pn * 256) * (DQC * 2);
        } else if constexpr (MODE == M_PC) {
            const int b = L / 6, r = L - b * 6, ks = r >> 1; u.pm = 0; u.pn = r & 1; u.aux = b * 4 + ks;
            u.A = (const char*)(out + O_Y) + ((size_t)b * 256 * NKP + ks * 768) * 2; u.B = (const char*)(ws + WS_R4) + (((size_t)b * 512 + u.pn * 256) * NKP + ks * 768) * 2;
        } else if constexpr (MODE == M_O) {
            const int h = L; u.pm = 0; u.pn = 0; u.aux = h;
            u.A = (const char*)(ws + WS_ZQK) + 16 * MiB + (size_t)h * 256 * 1024; u.B = (const char*)(ws + WS_WSM) + (W_VP + (size_t)(h & ~1) * 128 * 512) * 2;
        } else if constexpr (MODE == M_GLA_A) {
            if (L < 128) { u.pm = 0; u.pn = 0; u.aux = L;
                u.A = (const char*)(ws + WS_ZOG) + (size_t)L * 131072; u.B = (const char*)(ws + WS_R5) + (size_t)L * 131072;
            } else { const int l2 = L - 128, hc = l2 >> 1; u.pm = l2 & 1; u.pn = 0; u.aux = 128 + hc;
                u.A = (const char*)(out + O_STS) + ((size_t)hc * 512 + u.pm * 256) * 512; u.B = (const char*)(ws + WS_R5) + 16 * MiB + (size_t)hc * 131072; }
        } else if constexpr (MODE == M_GLA_O) {
            const int second = L >= 256, l2 = L & 255, hc = l2 >> 1; u.pm = 0; u.pn = l2 & 1; u.aux = hc | (second ? 128 : 0);
            if (!second) { u.A = (const char*)(ws + WS_ZQK) + (size_t)hc * 131072; u.B = (const char*)(out + O_STS) + ((size_t)hc * 512 + u.pn * 256) * 512; }
            else { u.A = (const char*)(ws + WS_ZOG) + (size_t)hc * 131072; u.B = (const char*)(ws + WS_R2) + ((size_t)hc * 512 + u.pn * 256) * 512; }
        } else if constexpr (MODE == M_WO) {
            pg8::tile_of(L, 32, 8, u.pm, u.pn);
            u.A = (const char*)(ws + WS_ZOG) + (size_t)u.pm * 256 * 4096; u.B = (const char*)(ws + WS_WSM) + (W_O + (size_t)u.pn * 256 * 2048) * 2;
        } else if constexpr (MODE == M_UP) {
            pg8::tile_of(L, 32, 32, u.pm, u.pn);
            u.A = (const char*)(ws + WS_R2) + (size_t)u.pm * 256 * 4096; u.B = (const char*)(out + O_Y) + 20 * MiB + (size_t)u.pn * 256 * 4096;
        } else if constexpr (MODE == M_DOWN) {
            pg8::tile_of(L, 32, 8, u.pm, u.pn);
            u.A = (const char*)(ws + WS_ZL) + (size_t)u.pm * 256 * 16384; u.B = (const char*)(ws + WS_R3) + (size_t)u.pn * 256 * 16384;
        } else if constexpr (MODE == M_WO_S) {
            u.pm = 0; u.pn = L & 7; u.aux = L >> 3;
            u.A = (const char*)(ws + WS_ZOG) + (size_t)SEQ * 4096 + u.aux * 512; u.B = (const char*)(ws + WS_WSM) + (W_O + (size_t)u.pn * 256 * 2048) * 2 + u.aux * 512;
        } else if constexpr (MODE == M_UP_S) {
            u.pm = 0; u.pn = L & 31; u.aux = L >> 5;
            u.A = (const char*)(ws + WS_R2) + (size_t)SEQ * 4096 + u.aux * 1024; u.B = (const char*)(out + O_Y) + 20 * MiB + (size_t)u.pn * 256 * 4096 + u.aux * 1024;
        } else if constexpr (MODE == M_DOWN_S) {
            u.pm = 0; u.pn = L & 7; u.aux = L >> 3;
            u.A = (const char*)(ws + WS_ZL) + (size_t)SEQ * 16384 + u.aux * 1024; u.B = (const char*)(ws + WS_R3) + (size_t)u.pn * 256 * 16384 + u.aux * 1024;
        }
        return true;
    }
};

#ifndef STAG_TICKS
#define STAG_TICKS 0
#endif
template <int MODE>
__device__ __forceinline__ void run_gemm_cg(Frame& F, const EP& ep, int c, int stride, int n_units, unsigned lda, unsigned ldb, int nt) {
    Sched<MODE> S; S.ws = F.ws; S.out = F.out; S.G = stride; S.c = c; S.n = n_units;
    Epi<MODE> E; E.p = ep;
    pg8::GCfg g; g.lda = lda; g.ldb = ldb; g.nt = nt; g.t1 = nt;
    pg8::gemm_phase<Epi<MODE>, Sched<MODE>>(F.lds, g, S, E, F.wave);
}
template <int MODE>
__device__ __forceinline__ void run_gemm(Frame& F, const EP& ep, int n_units, unsigned lda, unsigned ldb, int nt, int t1, int& rot, int stag = 0) {
    if (stag && STAG_TICKS) {
        const unsigned long long t0 = __builtin_amdgcn_s_memrealtime(); const unsigned long long wait = (unsigned long long)((F.vcu & 3) * STAG_TICKS);
        while (__builtin_amdgcn_s_memrealtime() - t0 < wait) __builtin_amdgcn_s_sleep(8);
    }
    Sched<MODE> S; S.ws = F.ws; S.out = F.out; S.G = F.G; S.c = (F.vcu + F.G - rot) % F.G; S.n = n_units;
    Epi<MODE> E; E.p = ep;
    pg8::GCfg g; g.lda = lda; g.ldb = ldb; g.nt = nt; g.t1 = t1;
    pg8::gemm_phase<Epi<MODE>, Sched<MODE>>(F.lds, g, S, E, F.wave);
    rot = (rot + n_units) % F.G;
}

namespace att {
constexpr int NW = 8, QBLK = 32, KVBLK = 64, QB = 256;
constexpr int SHM_V = KVBLK * 128 * 2, SHM_K = KVBLK * 192 * 2;
constexpr int NBUF = 3;
constexpr int LDS_ATT = NBUF * SHM_V + NBUF * SHM_K + NW * 64 * 4;
constexpr float THR = 8.f;
#define KSWZ(row, colB) ((row) * 384 + ((colB) ^ ((((row) >> 1) & 7) << 4)))
#define SBAR() __builtin_amdgcn_sched_barrier(0)
__device__ __forceinline__ int v_st(int k, int c) { const int kk = (k & ~0xC) | ((k & 4) << 1) | ((k & 8) >> 1); return ((kk >> 3) * 4 + (c >> 5)) * 512 + ((kk & 7) * 32 + (c & 31)) * 2; }
__device__ __forceinline__ int v_rd_base(int lane) { return ((lane & 3) << 3) | (((lane >> 2) & 3) << 6) | (((lane >> 4) & 1) << 5) | (((lane >> 5) & 1) << 8); }
constexpr int v_rd_off(int d0, int ks, int half) { return d0 * 512 + ks * 4096 + half * 2048; }
__device__ __forceinline__ int crow(int r, int hi) { return (r & 3) + 8 * (r >> 2) + 4 * hi; }
__device__ __forceinline__ unsigned cvtpk(float lo, float hi) { unsigned r; asm volatile("v_cvt_pk_bf16_f32 %0, %1, %2" : "=v"(r) : "v"(lo), "v"(hi)); return r; }

__device__ __forceinline__ void partialSM(f32x16& p0, f32x16& p1, float& m_reg, float& mn, float& alpha) {
    mn = 0.f; alpha = 1.f;
#pragma unroll
    for (int r = 0; r < 16; ++r) p0[r] = __builtin_amdgcn_exp2f(p0[r]);
}
__device__ __forceinline__ void finishSM(f32x16& p0, f32x16& p1, float alpha, float& l_reg, bf16x8& pa0, bf16x8& pa1, bf16x8& pa2, bf16x8& pa3) {
#pragma unroll
    for (int r = 0; r < 16; ++r) p1[r] = __builtin_amdgcn_exp2f(p1[r]);
    float ps = 0;
#pragma unroll
    for (int r = 0; r < 16; ++r) ps += p0[r];
#pragma unroll
    for (int r = 0; r < 16; ++r) ps += p1[r];
    { auto rr = __builtin_amdgcn_permlane32_swap(__float_as_uint(ps), __float_as_uint(ps), false, false);
      ps = __uint_as_float(rr[0]) + __uint_as_float(rr[1]); }
    l_reg = l_reg * alpha + ps;
#define PK4(P, B_, OUT) do { unsigned a0 = cvtpk(P[B_+0], P[B_+1]), a1 = cvtpk(P[B_+2], P[B_+3]);                          \
        unsigned b0 = cvtpk(P[B_+4], P[B_+5]), b1 = cvtpk(P[B_+6], P[B_+7]);                                             \
        auto r0 = __builtin_amdgcn_permlane32_swap(a0, b0, false, false); auto r1 = __builtin_amdgcn_permlane32_swap(a1, b1, false, false); \
        u32x4 w = {r0[0], r1[0], r0[1], r1[1]}; OUT = *reinterpret_cast<bf16x8*>(&w); } while (0)
    PK4(p0, 0, pa0); PK4(p0, 8, pa1); PK4(p1, 0, pa2); PK4(p1, 8, pa3);
#undef PK4
}
__device__ __forceinline__ void qkt(int kboff, f32x16& p0, f32x16& p1, const char* K_lds, int r32, int hi, const bf16x8* qr) {
    p0 = f32x16{}; p1 = f32x16{};
    const char* kb[4];
#pragma unroll
    for (int dd = 0; dd < 4; ++dd) kb[dd] = K_lds + kboff + KSWZ(r32, (dd * 16 + hi * 8) * 2);
#pragma unroll
    for (int d0 = 0; d0 < 12; ++d0) { const char* a = kb[d0 & 3] + (d0 >> 2) * 128;
        bf16x8 b0 = *reinterpret_cast<const bf16x8*>(a);
        bf16x8 b1 = *reinterpret_cast<const bf16x8*>(a + 32 * 384);
        p0 = __builtin_amdgcn_mfma_f32_32x32x16_bf16(b0, qr[d0], p0, 0, 0, 0);
        p1 = __builtin_amdgcn_mfma_f32_32x32x16_bf16(b1, qr[d0], p1, 0, 0, 0); }
}
__device__ __forceinline__ void pv_tile(f32x16* o, int vb0, bf16x8 pa0, bf16x8 pa1, bf16x8 pa2, bf16x8 pa3) {
#define TRRD(dst, off) asm volatile("ds_read_b64_tr_b16 %0, %1 offset:%2" : "=&v"(dst) : "v"(vb0), "i"(off) : "memory")
#define PV_RD(L, H, d0) do { constexpr int b_ = v_rd_off(d0, 0, 0); TRRD(L[0], b_); TRRD(H[0], b_ + 2048); TRRD(L[1], b_ + 4096); TRRD(H[1], b_ + 6144); TRRD(L[2], b_ + 8192); TRRD(H[2], b_ + 10240); TRRD(L[3], b_ + 12288); TRRD(H[3], b_ + 14336); } while (0)
#define PV_FR(L, H, k) (bf16x8){L[k][0], L[k][1], L[k][2], L[k][3], H[k][0], H[k][1], H[k][2], H[k][3]}
#define PV_MM(L, H, d0) do { o[d0] = __builtin_amdgcn_mfma_f32_32x32x16_bf16(pa0, PV_FR(L, H, 0), o[d0], 0, 0, 0); o[d0] = __builtin_amdgcn_mfma_f32_32x32x16_bf16(pa1, PV_FR(L, H, 1), o[d0], 0, 0, 0); \
        o[d0] = __builtin_amdgcn_mfma_f32_32x32x16_bf16(pa2, PV_FR(L, H, 2), o[d0], 0, 0, 0); o[d0] = __builtin_amdgcn_mfma_f32_32x32x16_bf16(pa3, PV_FR(L, H, 3), o[d0], 0, 0, 0); } while (0)
    s16x4 la[4], ha[4], lb[4], hb[4];
    PV_RD(la, ha, 0);
    PV_RD(lb, hb, 1); asm volatile("s_waitcnt lgkmcnt(8)" ::: "memory"); SBAR(); PV_MM(la, ha, 0); SBAR();
    PV_RD(la, ha, 2); asm volatile("s_waitcnt lgkmcnt(8)" ::: "memory"); SBAR(); PV_MM(lb, hb, 1); SBAR();
    PV_RD(lb, hb, 3); asm volatile("s_waitcnt lgkmcnt(8)" ::: "memory"); SBAR(); PV_MM(la, ha, 2); SBAR();
    asm volatile("s_waitcnt lgkmcnt(0)" ::: "memory"); SBAR(); PV_MM(lb, hb, 3);
#undef PV_MM
#undef PV_FR
#undef PV_RD
#undef TRRD
}

struct BlockRef { const bf16_t* Q; const bf16_t* K; const bf16_t* V; bf16_t* G; const float* fsm; const float* ssq_qg; int qb; int h; int dry; };
struct Seam { bf16x8 qr[12]; bf16x8 st_v0, st_v1, st_k0, st_k1, st_k2; };

#define VMW() asm volatile("s_waitcnt vmcnt(0)" ::: "memory")
#define VMWN(n) asm volatile("s_waitcnt vmcnt(%0)" :: "i"(n) : "memory")
#define LD8(p) (*reinterpret_cast<const bf16x8*>(p))
#define SLOAD_H(Kp, Vp, k0) do { S.st_v0 = LD8((Vp) + (size_t)((k0) + sr) * 128 + sc); S.st_v1 = LD8((Vp) + (size_t)((k0) + 32 + sr) * 128 + sc); \
        const bf16_t* kt_ = (Kp) + (size_t)(k0) * 192 + tid * 8; S.st_k0 = LD8(kt_); S.st_k1 = LD8(kt_ + 4096); S.st_k2 = LD8(kt_ + 8192); } while (0)
#define SWRITE_HK(bf) do { *(bf16x8*)(K_lds + (bf) * SHM_K + kw0) = S.st_k0; *(bf16x8*)(K_lds + (bf) * SHM_K + kw1) = S.st_k1; *(bf16x8*)(K_lds + (bf) * SHM_K + kw2) = S.st_k2; } while (0)
#define SWRITE_HV(bf) do { *(bf16x8*)(V_lds + (bf) * SHM_V + vst0) = S.st_v0; *(bf16x8*)(V_lds + (bf) * SHM_V + vst1) = S.st_v1; } while (0)
#define SWRITE_H(bf) do { SWRITE_HV(bf); SWRITE_HK(bf); } while (0)
#define KW_OFFS() const int g0_ = tid, g1_ = tid + 512, g2_ = tid + 1024; \
    const int kw0 = KSWZ(g0_ / 24, (g0_ % 24) * 16), kw1 = KSWZ(g1_ / 24, (g1_ % 24) * 16), kw2 = KSWZ(g2_ / 24, (g2_ % 24) * 16)

__device__ __forceinline__ void prime(const BlockRef& cur, char* lds, Seam& S, int wave) {
    int lane_ = lane_id_(); asm volatile("" : "+v"(lane_));
    const int tid = wave * 64 + lane_;
    const int sr = tid >> 4, sc = (tid & 15) * 8; char* K_lds = lds + NBUF * SHM_V;
    KW_OFFS();
    SLOAD_H(cur.K, cur.V, 0); VMW(); SWRITE_HK(0);
    __syncthreads();
}
__device__ __forceinline__ void block(const BlockRef& cur, const BlockRef& nxt, char* lds, Seam& S, int wave) {
    int lane_ = lane_id_(); asm volatile("" : "+v"(lane_));
    const int wid = wave, lane = lane_, tid = wid * 64 + lane, r32 = lane & 31, hi = lane >> 5;
    const int NT = 4 * cur.qb + 4;
    const int tmax = 4 * cur.qb + (wid >> 1);
    char* V_lds = lds; char* K_lds = lds + NBUF * SHM_V;
    float* wsf = (float*)(lds + NBUF * SHM_V + NBUF * SHM_K) + wid * 64; float* li_l = wsf, * al_l = wsf + 32;
    float m_reg = -1e30f, l_reg = 0; f32x16 o[4] = {};
    const int sr = tid >> 4, sc = (tid & 15) * 8, vst0 = v_st(sr, sc), vst1 = v_st(32 + sr, sc);
    KW_OFFS();
    const int vb0 = (int)(uintptr_t)V_lds + v_rd_base(lane);
    const bf16_t* Kh = cur.K; const bf16_t* Vh = cur.V;
#define RESC(a) do { if (__any((a) < 1.f)) { if (hi == 0) al_l[r32] = (a); asm volatile("s_waitcnt lgkmcnt(0)" ::: "memory");              \
                     _Pragma("unroll") for (int d_ = 0; d_ < 4; ++d_) _Pragma("unroll") for (int r = 0; r < 16; ++r) o[d_][r] *= al_l[crow(r, hi)]; } } while (0)
#define KBASE(t) ((t) * KVBLK)
#define MASKT(P0_, P1_, t) do { if ((t) > tmax) { const float NEG_ = -__builtin_inff(); _Pragma("unroll") for (int r = 0; r < 16; ++r) { P0_[r] = NEG_; P1_[r] = NEG_; } } } while (0)
    constexpr int NQL = 0;
#define SEAM_K0() do { VMWN(NQL); SWRITE_HK(0); SBAR(); } while (0)
    f32x16 pA0, pA1, pB0, pB1; float mnA, mnB, alA, alB; bf16x8 pa0, pa1, pa2, pa3;
    {
        const int t = cur.qb * QB + wid * QBLK + r32;
        const float* fsm = cur.fsm;
        const float al = rsqrtf((fsm[F_SSQ_QL + 2 * t] + fsm[F_SSQ_QL + 2 * t + 1]) * (1.f / 512.f) + EPS);
        const float* qg = cur.ssq_qg + (size_t)t * 96 + cur.h * 6;
        const float ssh = ((qg[0] + qg[1]) + (qg[2] + qg[3])) + (qg[4] + qg[5]);
        const float sc = al * rsqrtf(al * al * ssh * (1.f / 192.f) + EPS) * (MLA_SCALE * LOG2E);
        const bf16_t* qrow = cur.Q + (size_t)(wid * QBLK + r32) * 192 + hi * 8;
#define UNPK(src_, f) do { const u32x4 w_ = __builtin_bit_cast(u32x4, (src_)); f[0] = bflo(w_.x); f[1] = bfhi(w_.x); f[2] = bflo(w_.y); f[3] = bfhi(w_.y); f[4] = bflo(w_.z); f[5] = bfhi(w_.z); f[6] = bflo(w_.w); f[7] = bfhi(w_.w); } while (0)
#define REPK(f) __builtin_bit_cast(bf16x8, (u32x4){cvtpk(f[0], f[1]), cvtpk(f[2], f[3]), cvtpk(f[4], f[5]), cvtpk(f[6], f[7])})
#pragma unroll
        for (int d0 = 0; d0 < 8; ++d0) { float f[8]; UNPK(LD8(qrow + d0 * 16), f);
#pragma unroll
            for (int j = 0; j < 8; ++j) f[j] *= sc;
            S.qr[d0] = REPK(f); }
        const float* cs = fsm + F_ROPE + (size_t)t * 64;
#pragma unroll
        for (int dd = 0; dd < 2; ++dd) { float x1[8], x2[8], y1[8], y2[8]; UNPK(LD8(qrow + (8 + dd) * 16), x1); UNPK(LD8(qrow + (10 + dd) * 16), x2);
            const int i0 = dd * 16 + hi * 8;
#pragma unroll
            for (int j = 0; j < 8; ++j) { const float c = cs[i0 + j], sn = cs[32 + i0 + j]; y1[j] = (x1[j] * c - x2[j] * sn) * sc; y2[j] = (x2[j] * c + x1[j] * sn) * sc; }
            S.qr[8 + dd] = REPK(y1); S.qr[10 + dd] = REPK(y2); }
#undef UNPK
#undef REPK
    }
    SWRITE_HV(0); SBAR();
    SLOAD_H(Kh, Vh, KBASE(1));
    SBAR(); qkt(0, pA0, pA1, K_lds, r32, hi, S.qr);
    MASKT(pA0, pA1, 0); partialSM(pA0, pA1, m_reg, mnA, alA);
    VMW(); SWRITE_H(1);
    __syncthreads();
    int b_prev = 0, b_cur = 1, b_next = 2;
#define ROT3() do { const int t_ = b_prev; b_prev = b_cur; b_cur = b_next; b_next = t_; } while (0)
#define HALF_STEP(PX0, PX1, mnX, alX, PY0, PY1, alY, t) do {                                                      \
        SBAR(); qkt(b_cur * SHM_K, PX0, PX1, K_lds, r32, hi, S.qr);                                                          \
        finishSM(PY0, PY1, alY, l_reg, pa0, pa1, pa2, pa3); SBAR();                                                           \
        if ((t) + 1 < NT) { SLOAD_H(Kh, Vh, KBASE((t) + 1)); SBAR(); }                                               \
        pv_tile(o, vb0 + b_prev * SHM_V, pa0, pa1, pa2, pa3); MASKT(PX0, PX1, (t)); partialSM(PX0, PX1, m_reg, mnX, alX);                                        \
        if ((t) + 1 < NT) { VMW(); SWRITE_H(b_next); }                                                                          \
        RESC(alX); __syncthreads(); ROT3(); } while (0)
    for (int t = 1; t + 1 < NT; t += 2) {
        HALF_STEP(pB0, pB1, mnB, alB, pA0, pA1, alA, t);
        HALF_STEP(pA0, pA1, mnA, alA, pB0, pB1, alB, t + 1);
    }
    SBAR(); qkt(b_cur * SHM_K, pB0, pB1, K_lds, r32, hi, S.qr); SBAR();
    SLOAD_H(nxt.K, nxt.V, 0); SBAR();
    finishSM(pA0, pA1, alA, l_reg, pa0, pa1, pa2, pa3); SBAR();
    pv_tile(o, vb0 + b_prev * SHM_V, pa0, pa1, pa2, pa3);
    MASKT(pB0, pB1, NT - 1); partialSM(pB0, pB1, m_reg, mnB, alB); __syncthreads(); RESC(alB);
    finishSM(pB0, pB1, alB, l_reg, pa0, pa1, pa2, pa3); SBAR(); pv_tile(o, vb0 + b_cur * SHM_V, pa0, pa1, pa2, pa3);
    SBAR(); SEAM_K0();
    if (hi == 0) li_l[r32] = l_reg; asm volatile("s_waitcnt lgkmcnt(0)" ::: "memory");
    float rli[16];
#pragma unroll
    for (int r = 0; r < 16; ++r) rli[r] = __builtin_amdgcn_rcpf(li_l[crow(r, hi)]);
    bf16_t* Gw = cur.G + (size_t)(wid * QBLK) * 2048;
#pragma unroll
    for (int dp = 0; dp < 4; dp += 2) {
        bf16_t gt_[2][16];
#pragma unroll
        for (int dd = 0; dd < 2; ++dd)
#pragma unroll
            for (int r = 0; r < 16; ++r) gt_[dd][r] = Gw[(size_t)crow(r, hi) * 2048 + (dp + dd) * 32 + r32];
        asm volatile("" ::: "memory");
#pragma unroll
        for (int dd = 0; dd < 2; ++dd)
#pragma unroll
            for (int r = 0; r < 16; ++r) { const int d0 = dp + dd;
                bf16_t* gp = Gw + (size_t)crow(r, hi) * 2048 + d0 * 32 + r32;
                const float v = o[d0][r] * rli[r] * sigmoidf_(bf2f(gt_[dd][r]));
                const float vn = __shfl_xor(v, 1);
                if ((r32 & 1) == 0 && !cur.dry) *(unsigned*)gp = cvtpk(v, vn); }
        asm volatile("" ::: "memory");
    }
    __syncthreads();
#undef RESC
#undef KBASE
#undef MASKT
#undef SEAM_K0
#undef HALF_STEP
#undef ROT3
}
#undef VMW
#undef VMWN
#undef LD8
#undef SLOAD_H
#undef SWRITE_HK
#undef SWRITE_HV
#undef SWRITE_H
#undef KW_OFFS
#undef KSWZ
#undef SBAR
}

#define LDS_WAIT() asm volatile("s_waitcnt lgkmcnt(0)" ::: "memory")
__device__ __forceinline__ unsigned pk2(float lo, float hi) { return cvt_pk_bf16(lo, hi); }

__device__ __forceinline__ int lane_fresh_() { int l_ = lane_id_(); asm volatile("" : "+v"(l_)); return l_; }
struct TrDesc { const float* sp; size_t ldn; bf16_t* dp; size_t ldk; const float* ks; int valid; };
__device__ __forceinline__ TrDesc tr_desc(const float* src, size_t ldn, bf16_t* dst, size_t ldk, int k0, int ndst0, int srcn, const float* kscale, int lane) {
    lane = lane_id_();
    TrDesc d; d.sp = src + (size_t)(k0 + (lane >> 3)) * ldn + (srcn >= 0 ? srcn : 0); d.ldn = ldn; d.dp = dst + (size_t)(ndst0 + (lane >> 3)) * ldk + k0 + 8 * (lane & 7); d.ldk = ldk;
    d.ks = kscale ? kscale + k0 + (lane >> 3) : nullptr; d.valid = srcn >= 0; return d;
}
__device__ __forceinline__ void tr_load(const TrDesc& d, float (&v)[32]) {
#pragma unroll
    for (int j = 0; j < 8; ++j) { const f32x4 w = *(const f32x4*)(d.sp + (size_t)(8 * j) * d.ldn); v[4 * j] = w[0]; v[4 * j + 1] = w[1]; v[4 * j + 2] = w[2]; v[4 * j + 3] = w[3]; }
}
__device__ __forceinline__ void tr_finish(const TrDesc& d, float (&v)[32], LAS float* scr, int lane) {
    lane = lane_id_();
    if (d.ks) {
#pragma unroll
        for (int j = 0; j < 8; ++j) { const float g = d.ks[8 * j]; v[4 * j] *= g; v[4 * j + 1] *= g; v[4 * j + 2] *= g; v[4 * j + 3] *= g; }
    }
#pragma unroll
    for (int j = 0; j < 8; ++j)
#pragma unroll
        for (int e = 0; e < 4; ++e) scr[(8 * j + (lane >> 3)) * 33 + 4 * (lane & 7) + e] = d.valid ? v[4 * j + e] : 0.f;
    LDS_WAIT(); asm volatile("" ::: "memory");
    const int c = lane & 7;
#pragma unroll
    for (int j = 0; j < 4; ++j) { const int n = (lane >> 3) + 8 * j; const LAS float* s_ = scr + (8 * c) * 33 + n;
        u32x4 o; o.x = pk2(s_[0 * 33], s_[1 * 33]); o.y = pk2(s_[2 * 33], s_[3 * 33]); o.z = pk2(s_[4 * 33], s_[5 * 33]); o.w = pk2(s_[6 * 33], s_[7 * 33]);
        *(u32x4*)(d.dp + (size_t)(8 * j) * d.ldk) = o; }
    LDS_WAIT(); asm volatile("" ::: "memory");
}
template <class Dec>
__device__ __forceinline__ void tr_loop(int first, int n, int stride, const Dec& dec, LAS float* scr, int lane) {
    if (first >= n) return;
    float va[32], vb[32];
    TrDesc da = dec(first), db = da;
    tr_load(da, va);
    for (int it = first;; it += 2 * stride) {
        const bool hb = it + stride < n;
        if (hb) { db = dec(it + stride); tr_load(db, vb); }
        tr_finish(da, va, scr, lane);
        if (!hb) break;
        const bool ha = it + 2 * stride < n;
        if (ha) { da = dec(it + 2 * stride); tr_load(da, va); }
        tr_finish(db, vb, scr, lane);
        if (!ha) break;
    }
}
__device__ __forceinline__ int win_src(int n) {
    if (n < 1024) return n;
    if (n < 5120) return n + 64;
    if (n < 9216) { const int w = n - 5120, c = (w >> 8) * 128 + (w & 127); return (w & 128) ? 5200 + c : 9296 + c; }
    if (n < 11264) return 7248 + (n - 9216);
    const int lc = n - 11264;
    if (lc < 64) return 1024 + lc;
    if (lc < 80) return 5184 + (lc - 64);
    return -1;
}

__device__ __forceinline__ void p0_prologue(Frame& F, int parts, int wi, int nw) {
    LAS float* scr = (LAS float*)(F.lds + F.wave * 16384);
    const int gw = wi * 8 + F.wave, NGW = nw * 8, lane = lane_fresh_();
    const int gt = gw * 64 + lane, NGT = NGW * 64;
    unsigned char* ws = F.ws; bf16_t* wsm = (bf16_t*)(ws + WS_WSM);
    if (parts & 1) {
        const float* g = F.in[5]; bf16_t* hb = (bf16_t*)(ws + WS_R2);
        f32x4 gg8[8];
#pragma unroll
        for (int j = 0; j < 8; ++j) gg8[j] = *(const f32x4*)(g + (lane + 64 * j) * 4);
#define H_ROWPTR(row_) ((row_) < SEQ ? F.in[0] + (size_t)(row_) * DM : F.in[1] + (size_t)((row_) - SEQ) * DM)
        f32x4 v[8], vn[8];
        if (gw < NTOK) { const float* xr = H_ROWPTR(gw);
#pragma unroll
            for (int j = 0; j < 8; ++j) v[j] = *(const f32x4*)(xr + (lane + 64 * j) * 4); }
        for (int row = gw; row < NTOK; row += NGW) {
            const bool more = row + NGW < NTOK;
            if (more) { const float* xn = H_ROWPTR(row + NGW);
#pragma unroll
                for (int j = 0; j < 8; ++j) vn[j] = *(const f32x4*)(xn + (lane + 64 * j) * 4); }
            asm volatile("" ::: "memory");
            float s = 0.f;
#pragma unroll
            for (int j = 0; j < 8; ++j) s += (v[j][0] * v[j][0] + v[j][1] * v[j][1]) + (v[j][2] * v[j][2] + v[j][3] * v[j][3]);
            const float inv = rsqrtf(wave_sum(s) * (1.f / DM) + EPS);
#pragma unroll
            for (int j = 0; j < 8; ++j) { const f32x4 gg = gg8[j];
                u32x2 o; o.x = pk2(v[j][0] * inv * gg[0], v[j][1] * inv * gg[1]); o.y = pk2(v[j][2] * inv * gg[2], v[j][3] * inv * gg[3]);
                *(u32x2*)(hb + (size_t)row * DM + (lane + 64 * j) * 4) = o; }
            if (more) {
#pragma unroll
                for (int j = 0; j < 8; ++j) v[j] = vn[j]; }
        }
#undef H_ROWPTR
    }
    if (parts & 2) {
        const float* wukv = F.in[10]; bf16_t* wk = wsm + W_KNABS;
        for (int i = gt; i < 16 * 512 * 32; i += NGT) { const int j8 = (i & 31) * 8, c = (i >> 5) & 511, h = i >> 14;
            u32x4 o = {0u, 0u, 0u, 0u};
            if (j8 < 128) { const float* s = wukv + (size_t)c * 4096 + h * 256 + j8; const f32x4 a = *(const f32x4*)s, b = *(const f32x4*)(s + 4);
                o.x = pk2(a[0], a[1]); o.y = pk2(a[2], a[3]); o.z = pk2(b[0], b[1]); o.w = pk2(b[2], b[3]); }
            *(u32x4*)(wk + ((size_t)h * 512 + c) * 256 + j8) = o; }
    }
    constexpr int I_IN = 32 * 360, I_UQ = 8 * 96, I_UKV = 8 * 128, I_KN = 8 * 64, I_V = 8 * 64, I_O = 32 * 64;
    constexpr int NIT = I_IN + I_UQ + I_UKV + I_KN + I_V + I_O;
    const float* const* in = F.in;
    auto dec = [=](int it) -> TrDesc {
        int r = it; const int n = (lane_id_() & 7) * 4;
        if (r < I_IN) { const int kb = r / 360, nb = r % 360; return tr_desc(in[6], DIN, (bf16_t*)(ws + WS_R1), 2048, kb * 64, nb * 32, win_src(nb * 32 + n), nullptr, lane); } r -= I_IN;
        if (r < I_UQ) { const int kb = r / 96, nb = r % 96; return tr_desc(in[8], 3072, wsm + W_UQ, 512, kb * 64, nb * 32, nb * 32 + n, in[7], lane); } r -= I_UQ;
        if (r < I_UKV) { const int kb = r / 128, nb = r % 128; return tr_desc(in[10], 4096, wsm + W_UKVG, 512, kb * 64, nb * 32, nb * 32 + n, in[9], lane); } r -= I_UKV;
        if (r < I_KN) { const int kb = r / 64, nb = r % 64; const int nd = nb * 32 + n; return tr_desc(in[10], 4096, wsm + W_KNP, 512, kb * 64, nb * 32, (nd >> 7) * 256 + (nd & 127), nullptr, lane); } r -= I_KN;
        if (r < I_V) { const int kb = r / 64, nb = r % 64; const int nd = nb * 32 + n; return tr_desc(in[10], 4096, wsm + W_VP, 512, kb * 64, nb * 32, (nd >> 7) * 256 + 128 + (nd & 127), nullptr, lane); } r -= I_V;
        { const int kb = r / 64, nb = r % 64; return tr_desc(in[18], 2048, wsm + W_O, 2048, kb * 64, nb * 32, nb * 32 + n, nullptr, lane); }
    };
    const int lo = (parts & 1) ? 0 : I_IN, hi = (parts & 2) ? NIT : I_IN;
    tr_loop(lo + gw, hi, NGW, dec, scr, lane);
}

__device__ __forceinline__ void p2_ckv_krope(Frame& F) {
    const int gw = F.vcu * 8 + F.wave, NGW = F.G * 8, lane = F.lane;
    unsigned char* ws = F.ws; float* fsm = (float*)(ws + WS_FSM);
    const bf16_t* ZL = (const bf16_t*)(ws + WS_ZL); const bf16_t* ZM = (const bf16_t*)(ws + WS_ZM);
    const float* gkv = F.in[9]; const float* cs = fsm + F_ROPE;
    for (int t = gw; t < NTOK; t += NGW) {
        const float inv = rsqrtf((fsm[F_SSQ_KV + 2 * t] + fsm[F_SSQ_KV + 2 * t + 1]) * (1.f / 512.f) + EPS);
        const u32x4 w = *(const u32x4*)(ZL + (size_t)t * 1024 + 512 + lane * 8);
        const f32x4 g0 = *(const f32x4*)(gkv + lane * 8), g1 = *(const f32x4*)(gkv + lane * 8 + 4);
        f32x4 o0, o1;
        o0[0] = bflo(w.x) * inv * g0[0]; o0[1] = bfhi(w.x) * inv * g0[1]; o0[2] = bflo(w.y) * inv * g0[2]; o0[3] = bfhi(w.y) * inv * g0[3];
        o1[0] = bflo(w.z) * inv * g1[0]; o1[1] = bfhi(w.z) * inv * g1[1]; o1[2] = bflo(w.w) * inv * g1[2]; o1[3] = bfhi(w.w) * inv * g1[3];
        float* oc = t < SEQ ? F.out + O_CKVP + (size_t)t * 512 : F.out + O_CKVS + (size_t)(t - SEQ) * 512;
        *(f32x4*)(oc + lane * 8) = o0; *(f32x4*)(oc + lane * 8 + 4) = o1;
        const int r_ = t - SEQ, kb_ = r_ >> 4, kq_ = r_ & 15; const int krow = kb_ * NKP + PAST + kq_;
        bf16_t* kc = (bf16_t*)(ws + WS_R3) + (size_t)(t >= SEQ ? krow : 0) * DQC;
        if (t >= SEQ) {
            u32x4 o; o.x = pk2(o0[0], o0[1]); o.y = pk2(o0[2], o0[3]); o.z = pk2(o1[0], o1[1]); o.w = pk2(o1[2], o1[3]);
            *(u32x4*)(kc + lane * 8) = o;
            if (lane < 8) *(u32x4*)(kc + 576 + lane * 8) = (u32x4){0u, 0u, 0u, 0u};
            bf16_t* ct = (bf16_t*)(ws + WS_R4) + ((size_t)kb_ * 512 + lane * 8) * NKP + PAST + kq_;
            ((unsigned short*)ct)[0] = (unsigned short)(o.x & 0xffffu); ((unsigned short*)(ct + NKP))[0] = (unsigned short)(o.x >> 16);
            ((unsigned short*)(ct + 2 * NKP))[0] = (unsigned short)(o.y & 0xffffu); ((unsigned short*)(ct + 3 * NKP))[0] = (unsigned short)(o.y >> 16);
            ((unsigned short*)(ct + 4 * NKP))[0] = (unsigned short)(o.z & 0xffffu); ((unsigned short*)(ct + 5 * NKP))[0] = (unsigned short)(o.z >> 16);
            ((unsigned short*)(ct + 6 * NKP))[0] = (unsigned short)(o.w & 0xffffu); ((unsigned short*)(ct + 7 * NKP))[0] = (unsigned short)(o.w >> 16);
        }
        float ss = 0.f;
        if (lane < 32) {
            const float x1 = bf2f(ZM[(size_t)t * 256 + lane]), x2 = bf2f(ZM[(size_t)t * 256 + 32 + lane]);
            const int pos = t < SEQ ? t : PAST + ((t - SEQ) & 15);
            const float c = cs[pos * 64 + lane], s = cs[pos * 64 + 32 + lane];
            const float y1 = x1 * c - x2 * s, y2 = x2 * c + x1 * s;
            float* ok = t < SEQ ? F.out + O_KRP + (size_t)t * 64 : F.out + O_KRS + (size_t)(t - SEQ) * 64;
            ok[lane] = y1; ok[32 + lane] = y2; ss = y1 * y1 + y2 * y2;
            if (t >= SEQ) { const unsigned p_ = pk2(y1, y2); ((unsigned short*)(kc + 512 + lane))[0] = (unsigned short)(p_ & 0xffffu); ((unsigned short*)(kc + 544 + lane))[0] = (unsigned short)(p_ >> 16); }
        }
        ss = wave_sum(ss);
        if (lane == 0) { fsm[F_KRSS + t] = ss; if (t >= SEQ) fsm[F_KRSS_C + krow] = ss; }
    }
}

__device__ __forceinline__ void p4_finalize_q_head(Frame& F, int h) {
    const int tid = F.wave * 64 + F.lane;
    unsigned char* ws = F.ws; float* fsm = (float*)(ws + WS_FSM); const float* cs = fsm + F_ROPE;
    const bf16_t* Qp = (const bf16_t*)(ws + WS_R1);
    bf16_t* Qcat = (bf16_t*)(F.out + O_Y) + 48 * MiB / 2; bf16_t* QnA = (bf16_t*)(F.out + O_Y) + 53 * MiB / 2;
    const float* gqn = F.in[11]; const float* gqr = F.in[12]; const float* gkn = F.in[13]; const float* gkr = F.in[14];
    const float* ssq_qg = (const float*)((const char*)(F.out + O_Y) + 56 * MiB);
#define QSCALE(t, h) ({ const float al_ = rsqrtf((fsm[F_SSQ_QL + 2 * (t)] + fsm[F_SSQ_QL + 2 * (t) + 1]) * (1.f / 512.f) + EPS); const float* qg_ = ssq_qg + (size_t)(t) * 96 + (h) * 6; \
        const float ssh_ = ((qg_[0] + qg_[1]) + (qg_[2] + qg_[3])) + (qg_[4] + qg_[5]); al_ * rsqrtf(al_ * al_ * ssh_ * (1.f / 192.f) + EPS) * (MLA_SCALE * LOG2E); })
#pragma unroll 4
    for (int i = tid; i < NSAMP * 16; i += 512) { const int l = i & 15, r = i >> 4, t = SEQ + r;
        const float sc = QSCALE(t, h);
        const bf16_t* q = Qp + ((size_t)h * NTOK + t) * 192 + l * 8;
        const u32x4 w = *(const u32x4*)q;
        const f32x4 a0 = *(const f32x4*)(gqn + l * 8), a1 = *(const f32x4*)(gqn + l * 8 + 4), b0 = *(const f32x4*)(gkn + l * 8), b1 = *(const f32x4*)(gkn + l * 8 + 4);
        u32x4 o;
        o.x = pk2(bflo(w.x) * sc * a0[0] * b0[0], bfhi(w.x) * sc * a0[1] * b0[1]); o.y = pk2(bflo(w.y) * sc * a0[2] * b0[2], bfhi(w.y) * sc * a0[3] * b0[3]);
        o.z = pk2(bflo(w.z) * sc * a1[0] * b1[0], bfhi(w.z) * sc * a1[1] * b1[1]); o.w = pk2(bflo(w.w) * sc * a1[2] * b1[2], bfhi(w.w) * sc * a1[3] * b1[3]);
        bf16_t* qa = QnA + ((size_t)h * 256 + r) * 256; *(u32x4*)(qa + l * 8) = o; *(u32x4*)(qa + 128 + l * 8) = (u32x4){0u, 0u, 0u, 0u};
    }
#pragma unroll 2
    for (int i = tid; i < NSAMP * 4; i += 512) { const int k = i & 3, r = i >> 2, t = SEQ + r;
        const float sc = QSCALE(t, h);
        const bf16_t* q = Qp + ((size_t)h * NTOK + t) * 192;
        const int b = r >> 4, qi = r & 15; const int pos = PAST + qi;
        const u32x4 w1 = *(const u32x4*)(q + 128 + 8 * k), w2 = *(const u32x4*)(q + 160 + 8 * k);
        const float x1[8] = {bflo(w1.x), bfhi(w1.x), bflo(w1.y), bfhi(w1.y), bflo(w1.z), bfhi(w1.z), bflo(w1.w), bfhi(w1.w)};
        const float x2[8] = {bflo(w2.x), bfhi(w2.x), bflo(w2.y), bfhi(w2.y), bflo(w2.z), bfhi(w2.z), bflo(w2.w), bfhi(w2.w)};
        float y1[8], y2[8];
#pragma unroll
        for (int j = 0; j < 8; ++j) { const int ii = 8 * k + j; const float c = cs[pos * 64 + ii], sn = cs[pos * 64 + 32 + ii], g = gqr[ii] * gkr[ii] * sc;
            y1[j] = (x1[j] * c - x2[j] * sn) * g; y2[j] = (x2[j] * c + x1[j] * sn) * g; }
        const u32x4 o1 = {pk2(y1[0], y1[1]), pk2(y1[2], y1[3]), pk2(y1[4], y1[5]), pk2(y1[6], y1[7])};
        const u32x4 o2 = {pk2(y2[0], y2[1]), pk2(y2[2], y2[3]), pk2(y2[4], y2[5]), pk2(y2[6], y2[7])};
        bf16_t* qc = Qcat + ((size_t)b * 256 + h * 16 + qi) * DQC; *(u32x4*)(qc + 512 + 8 * k) = o1; *(u32x4*)(qc + 544 + 8 * k) = o2;
        *(u32x4*)(qc + 576 + 8 * k) = (u32x4){0u, 0u, 0u, 0u}; *(u32x4*)(qc + 608 + 8 * k) = (u32x4){0u, 0u, 0u, 0u};
    }
#undef QSCALE
}
__device__ __forceinline__ void kcat_rows(Frame& F, int klo, int khi, int wi, int nw) {
    const int gt = (wi * 8 + F.wave) * 64 + F.lane, NGT = nw * 512, nk = khi - klo;
    unsigned char* ws = F.ws; float* fsm = (float*)(ws + WS_FSM);
    bf16_t* Kcat = (bf16_t*)(ws + WS_R3);
    const float* cckv = F.in[2]; const float* ckr = F.in[3];
#pragma unroll 4
    for (int i = gt; i < DECB * nk * 80; i += NGT) { const int rr = i / 80, ch = i - rr * 80, b = rr / nk, k = klo + (rr - b * nk); const int row = b * NKP + k;
        u32x4 o = {0u, 0u, 0u, 0u};
        if (k < NKEY && ch < 72) {
            const float* s_;
            if (ch < 64) s_ = (k < PAST ? cckv + ((size_t)b * PAST + k) * 512 : F.out + O_CKVS + (size_t)(b * 16 + k - PAST) * 512) + ch * 8;
            else s_ = (k < PAST ? ckr + ((size_t)b * PAST + k) * 64 : F.out + O_KRS + (size_t)(b * 16 + k - PAST) * 64) + (ch - 64) * 8;
            const f32x4 a_ = *(const f32x4*)s_, c_ = *(const f32x4*)(s_ + 4);
            o.x = pk2(a_[0], a_[1]); o.y = pk2(a_[2], a_[3]); o.z = pk2(c_[0], c_[1]); o.w = pk2(c_[2], c_[3]);
        }
        *(u32x4*)(Kcat + (size_t)row * DQC + ch * 8) = o; }
#pragma unroll 4
    for (int i = gt; i < DECB * nk * 16; i += NGT) { const int rr = i >> 4, l = i & 15, b = rr / nk, k = klo + (rr - b * nk); const int row = b * NKP + k;
        float ss = 0.f;
        if (k < NKEY) { const float* s_ = (k < PAST ? ckr + ((size_t)b * PAST + k) * 64 : F.out + O_KRS + (size_t)(b * 16 + k - PAST) * 64) + l * 4; const f32x4 a_ = *(const f32x4*)s_;
            ss = (a_[0] * a_[0] + a_[1] * a_[1]) + (a_[2] * a_[2] + a_[3] * a_[3]); }
        ss += __shfl_xor(ss, 1); ss += __shfl_xor(ss, 2); ss += __shfl_xor(ss, 4); ss += __shfl_xor(ss, 8);
        if (l == 0) fsm[F_KRSS_C + row] = ss; }
}
__device__ __forceinline__ void p3_kcat_ct(Frame& F, bool cache_rows_done) {
    LAS float* scr = (LAS float*)(F.lds + F.wave * 16384);
    const int gw = F.vcu * 8 + F.wave, NGW = F.G * 8, lane = lane_fresh_();
    const int gt = gw * 64 + lane, NGT = NGW * 64;
    unsigned char* ws = F.ws;
    bf16_t* CT = (bf16_t*)(ws + WS_R4);
    const float* cckv = F.in[2];
    if (!cache_rows_done) {
        if (F.G == 256) { kcat_rows(F, 0, PAST, F.vcu, 356); if (F.vcu >= 156) kcat_rows(F, 0, PAST, 100 + F.vcu, 356); }
        else kcat_rows(F, 0, PAST, F.vcu, F.G); }
    kcat_rows(F, NKEY, NKP, F.vcu, F.G);
    { auto dec = [=](int it) -> TrDesc { const int b = it >> 9, r = it & 511, kb = r >> 4, nb = r & 15;
          return tr_desc(cckv + (size_t)b * PAST * 512, 512, CT + (size_t)b * 512 * NKP, NKP, kb * 64, nb * 32, nb * 32 + (lane_id_() & 7) * 4, nullptr, lane); };
      tr_loop(gw, 16 * 32 * 16, NGW, dec, scr, lane); }
    for (int i = gt; i < 16 * 512 * 32; i += NGT) { const int ch = i & 31, c = (i >> 5) & 511, b = i >> 14;
        if (ch >= 2) *(u32x4*)(CT + ((size_t)b * 512 + c) * NKP + PAST + ch * 8) = (u32x4){0u, 0u, 0u, 0u}; }
    { float* invk_t = (float*)(ws + WS_FSM) + F_KNSS_C;
      for (int i = gt; i < 256 * 60; i += NGT) { const int bh = i / 60, j = i - bh * 60; *(f32x4*)(invk_t + (size_t)bh * NKP + NKEY + j * 4) = (f32x4){0.f, 0.f, 0.f, 0.f}; } }
}
__device__ __forceinline__ float logsig16(float x) { return (fminf(x, 0.f) - __logf(1.f + __expf(-fabsf(x)))) * (1.f / 16.f); }
__device__ __forceinline__ void p3_gla_prep(Frame& F) {
    unsigned char* ws = F.ws; float* fsm = (float*)(ws + WS_FSM);
    const bf16_t* ZQK = (const bf16_t*)(ws + WS_ZQK); const bf16_t* ZV = (const bf16_t*)(ws + WS_ZV); const bf16_t* ZM = (const bf16_t*)(ws + WS_ZM);
    bf16_t* qt = (bf16_t*)(ws + WS_ZOG); bf16_t* kt = (bf16_t*)(ws + WS_R5); bf16_t* kendT = (bf16_t*)(ws + WS_R5) + 8 * MiB; bf16_t* vT = (bf16_t*)(F.out + O_STS);
    const float* wa2 = F.in[15]; const float* ba_ = F.in[16];
    LAS float* alr_s = (LAS float*)F.lds;
    LAS float* tot_s = (LAS float*)(F.lds + 16384);
    LAS unsigned char* tile = F.lds + 16384 + 2048;
    const int tid = F.tid;
    __syncthreads();
    for (int un = F.vcu; un < 256; un += F.G) {
        const int hc = un >> 1, dh = un & 1, h = hc >> 5, c = hc & 31;
        const int dl = tid & 127, qtr = tid >> 7, d = dh * 128 + dl;
        { const int tt = tid >> 1, half = tid & 1; const u32x4 w = *(const u32x4*)(ZM + (size_t)(c * 256 + tt) * 256 + 64 + half * 8);
          LAS float* a = alr_s + tt * 16 + half * 8;
          a[0] = bflo(w.x); a[1] = bfhi(w.x); a[2] = bflo(w.y); a[3] = bfhi(w.y); a[4] = bflo(w.z); a[5] = bfhi(w.z); a[6] = bflo(w.w); a[7] = bfhi(w.w); }
        float wa[16];
#pragma unroll
        for (int r = 0; r < 16; ++r) wa[r] = wa2[r * 1024 + h * 256 + d];
        const float ba = ba_[h * 256 + d];
        __syncthreads();
        float tot = 0.f;
#pragma unroll 4
        for (int i = 0; i < 64; ++i) { const LAS float* a = alr_s + (qtr * 64 + i) * 16; float x = ba;
#pragma unroll
            for (int r = 0; r < 16; ++r) x += a[r] * wa[r];
            const _Float16 lh = (_Float16)logsig16(x);
            *(LAS unsigned short*)(tile + dl * 520 + (qtr * 64 + i) * 2) = __builtin_bit_cast(unsigned short, lh);
            tot += (float)lh; }
        tot_s[qtr * 128 + dl] = tot;
        __syncthreads();
        float off = 0.f, bend = 0.f;
#pragma unroll
        for (int q = 0; q < 4; ++q) { const float v = tot_s[q * 128 + dl]; bend += v; if (q < qtr) off += v; }
        const float ebend = __expf(bend);
        if (qtr == 0) fsm[F_GAMMA + hc * 256 + d] = ebend;
        float bcum = off;
#define GP_LOAD(bq, bk, i0_) do { _Pragma("unroll") for (int i_ = 0; i_ < 8; ++i_) { const size_t trow_ = (size_t)(c * 256 + qtr * 64 + (i0_) + i_) * 2048; bq[i_] = ZQK[trow_ + h * 256 + d]; bk[i_] = ZQK[trow_ + 1024 + h * 256 + d]; } } while (0)
#define GP_COMP(bq, bk, i0_) do { _Pragma("unroll") for (int i_ = 0; i_ < 8; ++i_) { const int tl = qtr * 64 + (i0_) + i_; \
            bcum += (float)__builtin_bit_cast(_Float16, *(const LAS unsigned short*)(tile + dl * 520 + tl * 2)); \
            const float gq = bf2f(bq[i_]), gk = bf2f(bk[i_]); \
            const float eb = __expf(bcum), ieb = __builtin_amdgcn_rcpf(eb); \
            qt[(size_t)hc * 65536 + tl * 256 + d] = f2bf(gq * 0.0625f * eb); \
            kt[(size_t)hc * 65536 + tl * 256 + d] = f2bf(gk * ieb); \
            *(LAS bf16_t*)(tile + dl * 520 + tl * 2) = f2bf(gk * (ebend * ieb)); } } while (0)
        { bf16_t qa[8], ka[8], qb[8], kb[8];
          GP_LOAD(qa, ka, 0);
#pragma unroll 1
          for (int i0 = 0; i0 < 64; i0 += 16) {
              GP_LOAD(qb, kb, i0 + 8); asm volatile("" ::: "memory");
              GP_COMP(qa, ka, i0); asm volatile("" ::: "memory");
              if (i0 + 16 < 64) GP_LOAD(qa, ka, i0 + 16);
              asm volatile("" ::: "memory");
              GP_COMP(qb, kb, i0 + 8); asm volatile("" ::: "memory");
          } }
#undef GP_LOAD
#undef GP_COMP
        __syncthreads();
#pragma unroll 4
        for (int j = 0; j < 16; ++j) { const int g = tid + 512 * j, row = g >> 6, ch = g & 63;
            const u32x2 v = *(const LAS u32x2*)(tile + row * 520 + ch * 8);
            *(u32x2*)(kendT + (size_t)hc * 65536 + (size_t)(dh * 128 + row) * 256 + ch * 4) = v; }
        __syncthreads();
    }
    LAS unsigned char* tl2 = F.lds;
    for (int it = F.vcu; it < 1024; it += F.G) {
        const int hc = it >> 3, eb = it & 7, h = hc >> 5, c = hc & 31, e0 = eb * 64;
#pragma unroll
        for (int j = 0; j < 4; ++j) { const int g = tid + 512 * j, t = g >> 3, ch = g & 7;
            const u32x4 w = *(const u32x4*)(ZV + (size_t)(c * 256 + t) * 2048 + h * 512 + e0 + ch * 8);
            LAS unsigned char* p = tl2 + (ch * 8) * 520 + t * 2;
            *(LAS bf16_t*)(p) = (bf16_t)(w.x & 0xffff); *(LAS bf16_t*)(p + 520) = (bf16_t)(w.x >> 16);
            *(LAS bf16_t*)(p + 2 * 520) = (bf16_t)(w.y & 0xffff); *(LAS bf16_t*)(p + 3 * 520) = (bf16_t)(w.y >> 16);
            *(LAS bf16_t*)(p + 4 * 520) = (bf16_t)(w.z & 0xffff); *(LAS bf16_t*)(p + 5 * 520) = (bf16_t)(w.z >> 16);
            *(LAS bf16_t*)(p + 6 * 520) = (bf16_t)(w.w & 0xffff); *(LAS bf16_t*)(p + 7 * 520) = (bf16_t)(w.w >> 16); }
        __syncthreads();
#pragma unroll
        for (int j = 0; j < 8; ++j) { const int g = tid + 512 * j, row = g >> 6, ch = g & 63;
            const u32x2 v = *(const LAS u32x2*)(tl2 + row * 520 + ch * 8);
            *(u32x2*)(vT + ((size_t)hc * 512 + e0 + row) * 256 + ch * 4) = v; }
        __syncthreads();
    }
}

__device__ __forceinline__ void p6_softmax_scan(Frame& F) {
    const int lane = F.lane;
    unsigned char* ws = F.ws; float* fsm = (float*)(ws + WS_FSM);
    const bf16_t* dS = (const bf16_t*)(ws + WS_R1); bf16_t* Sst = (bf16_t*)(ws + WS_R2); const float* gam = fsm + F_GAMMA;
    for (int gid = (F.vcu * 8 + F.wave) * 64 + lane; gid < 4 * 512 * 64; gid += F.G * 512) {
        const int dq = gid & 63, e = (gid >> 6) & 511, h = gid >> 15;
        f32x4 st = {0.f, 0.f, 0.f, 0.f};
#pragma unroll 8
        for (int c = 0; c < 32; ++c) { const int hc = h * 32 + c; const size_t idx = ((size_t)hc * 512 + e) * 256 + dq * 4;
            const u32x2 w = *(const u32x2*)(dS + idx); const f32x4 g = *(const f32x4*)(gam + hc * 256 + dq * 4);
            u32x2 o = {pk2(st[0], st[1]), pk2(st[2], st[3])}; *(u32x2*)(Sst + idx) = o;
            st[0] = g[0] * st[0] + bflo(w.x); st[1] = g[1] * st[1] + bfhi(w.x); st[2] = g[2] * st[2] + bflo(w.y); st[3] = g[3] * st[3] + bfhi(w.y); }
        float* op = F.out + O_STP + ((size_t)h * 256 + dq * 4) * 512 + e;
        op[0] = st[0]; op[512] = st[1]; op[1024] = st[2]; op[1536] = st[3];
    }
}

__device__ __forceinline__ void p8_pc_convert(Frame& F) {
    const int gt = (F.vcu * 8 + F.wave) * 64 + F.lane, NGT = F.G * 512;
    const float* PCp = (const float*)(F.ws + WS_R5); bf16_t* PCb = (bf16_t*)(F.ws + WS_ZQK) + 8 * MiB; const float* fsm = (const float*)(F.ws + WS_FSM);
    for (int i = gt; i < 16 * 256 * 64; i += NGT) { const size_t e = (size_t)i * 8; f32x4 a = {0.f, 0.f, 0.f, 0.f}, b = a;
        const int rr = i >> 6, h = rr >> 8, bq = rr & 255, bb = bq >> 4, q = bq & 15;
        const float* rs = fsm + F_SSQ_K + ((size_t)bb * 256 + h * 16 + q) * 9; float tot = 0.f;
#pragma unroll
        for (int t = 0; t < 9; ++t) tot += rs[t];
        const float inv = 1.f / tot;
#pragma unroll
        for (int ks = 0; ks < 3; ++ks) { const float* s = PCp + (size_t)ks * 16 * 256 * 512 + e; a += *(const f32x4*)s; b += *(const f32x4*)(s + 4); }
        u32x4 o = {pk2(a[0] * inv, a[1] * inv), pk2(a[2] * inv, a[3] * inv), pk2(b[0] * inv, b[1] * inv), pk2(b[2] * inv, b[3] * inv)}; *(u32x4*)(PCb + e) = o; }
}

__device__ __forceinline__ void p9_ffn_weights(Frame& F, int jlo, int jhi, int wi, int nw) {
    LAS float* scr = (LAS float*)(F.lds + F.wave * 16384);
    const int gw = wi * 8 + F.wave, NGW = nw * 8, lane = lane_fresh_();
    const float* const* in = F.in; unsigned char* ws = F.ws; bf16_t* wup = (bf16_t*)((char*)(F.out + O_Y) + 20 * MiB);
    auto dec = [=](int it) -> TrDesc {
        const int n = (lane_id_() & 7) * 4;
        if (it < 8192) { const int kb = it / 256, nb = it % 256; return tr_desc(in[20], DFF, wup, 2048, kb * 64, nb * 32, nb * 32 + n, in[19], lane); }
        const int r = it - 8192, kb = r / 64, nb = r % 64; return tr_desc(in[21], 2048, (bf16_t*)(ws + WS_R3), DFF, kb * 64, nb * 32, nb * 32 + n, nullptr, lane);
    };
    tr_loop(jlo + gw, jhi, NGW, dec, scr, lane);
}
__device__ __forceinline__ void p9_gla_sample(Frame& F) {
    unsigned char* ws = F.ws; float* fsm = (float*)(ws + WS_FSM);
    const bf16_t* ZQK = (const bf16_t*)(ws + WS_ZQK); bf16_t* ZV = (bf16_t*)(ws + WS_ZV); const bf16_t* ZM = (const bf16_t*)(ws + WS_ZM);
    const float* wa2 = F.in[15]; const float* ba_ = F.in[16]; const float* S0 = F.in[4];
    LAS float* alr_s = (LAS float*)F.lds;
    LAS float* qt_s = alr_s + 256;
    LAS float* kt_s = qt_s + 4096;
    LAS float* ke_s = kt_s + 4096;
    LAS float* gam_s = ke_s + 4096;
    LAS float* A_s = gam_s + 256;
    LAS float* osum = A_s + 256;
    LAS float* red_s = osum + 8192;
    const int tid = F.tid;
    __syncthreads();
    for (int un = F.vcu; un < 256; un += F.G) {
        const int bh = un >> 2, eq = un & 3, b = bh >> 2, h = bh & 3; const int row0 = SEQ + b * 16;
        if (tid < 256) alr_s[tid] = bf2f(ZM[(size_t)(row0 + (tid >> 4)) * 256 + 64 + (tid & 15)]);
        __syncthreads();
        if (tid < 256) { const int d = tid; float bb[16]; float bc = 0.f; const float ba = ba_[h * 256 + d]; float wa[16];
#pragma unroll
            for (int r = 0; r < 16; ++r) wa[r] = wa2[r * 1024 + h * 256 + d];
#pragma unroll
            for (int t = 0; t < 16; ++t) { float x = ba;
#pragma unroll
                for (int r = 0; r < 16; ++r) x += alr_s[t * 16 + r] * wa[r];
                bc += logsig16(x); bb[t] = bc; }
#pragma unroll
            for (int t = 0; t < 16; ++t) { const size_t tr = (size_t)(row0 + t) * 2048;
                const float gq = bf2f(ZQK[tr + h * 256 + d]), gk = bf2f(ZQK[tr + 1024 + h * 256 + d]);
                qt_s[d * 16 + t] = gq * 0.0625f * __expf(bb[t]); kt_s[d * 16 + t] = gk * __expf(-bb[t]); ke_s[d * 16 + t] = gk * __expf(bc - bb[t]); }
            gam_s[d] = __expf(bc); }
        __syncthreads();
        if (tid < 256) { const int t = tid >> 4, s_ = tid & 15; float a = 0.f;
            for (int d = 0; d < 256; ++d) a += qt_s[d * 16 + t] * kt_s[d * 16 + s_];
            A_s[tid] = (s_ <= t) ? a : 0.f; }
        __syncthreads();
        const int el = tid & 127, dq = tid >> 7, e = eq * 128 + el; float v[16], o[16];
#pragma unroll
        for (int t = 0; t < 16; ++t) v[t] = bf2f(ZV[(size_t)(row0 + t) * 2048 + h * 512 + e]);
#pragma unroll
        for (int t = 0; t < 16; ++t) { float a = 0.f;
            if (dq == 0) {
#pragma unroll
                for (int s_ = 0; s_ < 16; ++s_) a += A_s[t * 16 + s_] * v[s_]; }
            o[t] = a; }
        const float* sp = S0 + ((size_t)(b * 4 + h) * 256 + dq * 64) * 512 + e; float* op = F.out + O_STS + ((size_t)(b * 4 + h) * 256 + dq * 64) * 512 + e;
#define GS_LOAD(buf, dd0_) do { _Pragma("unroll") for (int i_ = 0; i_ < 8; ++i_) buf[i_] = sp[(size_t)((dd0_) + i_) * 512]; } while (0)
#define GS_COMP(buf, dd0_) do { _Pragma("unroll") for (int i_ = 0; i_ < 8; ++i_) { const int dd = (dd0_) + i_; const int d = dq * 64 + dd; const float s0 = buf[i_]; float sn = gam_s[d] * s0; \
            const LAS f32x4* q4 = (const LAS f32x4*)(qt_s + d * 16); const LAS f32x4* k4 = (const LAS f32x4*)(ke_s + d * 16); \
            _Pragma("unroll") for (int j = 0; j < 4; ++j) { const f32x4 qv = q4[j], kv = k4[j]; \
                _Pragma("unroll") for (int i = 0; i < 4; ++i) { o[j * 4 + i] += qv[i] * s0; sn += kv[i] * v[j * 4 + i]; } } \
            op[(size_t)dd * 512] = sn; } } while (0)
        { float sa[8], sb[8];
          GS_LOAD(sa, 0);
#pragma unroll 1
          for (int dd0 = 0; dd0 < 64; dd0 += 16) {
              GS_LOAD(sb, dd0 + 8); asm volatile("" ::: "memory");
              GS_COMP(sa, dd0); asm volatile("" ::: "memory");
              if (dd0 + 16 < 64) GS_LOAD(sa, dd0 + 16);
              asm volatile("" ::: "memory");
              GS_COMP(sb, dd0 + 8); asm volatile("" ::: "memory");
          } }
#undef GS_LOAD
#undef GS_COMP
#pragma unroll
        for (int t = 0; t < 16; ++t) osum[(dq * 16 + t) * 128 + el] = o[t];
        __syncthreads();
#pragma unroll
        for (int j = 0; j < 4; ++j) { const int t = dq * 4 + j;
            const float tot = (osum[(0 * 16 + t) * 128 + el] + osum[(1 * 16 + t) * 128 + el]) + (osum[(2 * 16 + t) * 128 + el] + osum[(3 * 16 + t) * 128 + el]);
            ZV[(size_t)(row0 + t) * 2048 + h * 512 + e] = f2bf(tot);
            const float ss = wave_sum(tot * tot); if (F.lane == 0) red_s[t * 8 + F.wave] = ss; }
        __syncthreads();
        if (tid < 16) { const int t = tid, w0 = (t >> 2) * 2; fsm[F_SSQ_OG + ((size_t)(row0 + t) * 4 + h) * 4 + eq] = red_s[t * 8 + w0] + red_s[t * 8 + w0 + 1]; }
        __syncthreads();
    }
}

__device__ __forceinline__ void p10_mix(Frame& F, int t_lo, int t_hi, int wi, int nw) {
    const int gt = (wi * 8 + F.wave) * 64 + F.lane, NGT = nw * 512;
    unsigned char* ws = F.ws; const float* fsm = (const float*)(ws + WS_FSM); const float* gn = F.in[17];
    bf16_t* ZOG = (bf16_t*)(ws + WS_ZOG); const bf16_t* ZGM = (const bf16_t*)(ws + WS_ZGM); const bf16_t* ZGG = (const bf16_t*)(ws + WS_ZGG); const bf16_t* ZV = (const bf16_t*)(ws + WS_ZV);
#pragma unroll 2
    for (int i = t_lo * 256 + gt; i < t_hi * 256; i += NGT) { const int t = i >> 8, c8 = (i & 255) * 8, hg = c8 >> 9; const size_t e = (size_t)t * 2048 + c8;
        const f32x4 sq = *(const f32x4*)(fsm + F_SSQ_OG + ((size_t)t * 4 + hg) * 4);
        const float inv = rsqrtf(((sq[0] + sq[1]) + (sq[2] + sq[3])) * (1.f / 512.f) + EPS);
        const u32x4 wm = *(const u32x4*)(ZGM + e), wg = *(const u32x4*)(ZGG + e), wv = *(const u32x4*)(ZV + e);
        const f32x4 g0 = *(const f32x4*)(gn + (c8 & 511)), g1 = *(const f32x4*)(gn + (c8 & 511) + 4);
        const float m[8] = {bflo(wm.x), bfhi(wm.x), bflo(wm.y), bfhi(wm.y), bflo(wm.z), bfhi(wm.z), bflo(wm.w), bfhi(wm.w)};
        const float gg[8] = {bflo(wg.x), bfhi(wg.x), bflo(wg.y), bfhi(wg.y), bflo(wg.z), bfhi(wg.z), bflo(wg.w), bfhi(wg.w)};
        const float ov[8] = {bflo(wv.x), bfhi(wv.x), bflo(wv.y), bfhi(wv.y), bflo(wv.z), bfhi(wv.z), bflo(wv.w), bfhi(wv.w)};
        const float gnv[8] = {g0[0], g0[1], g0[2], g0[3], g1[0], g1[1], g1[2], g1[3]};
        float r[8];
#pragma unroll
        for (int k = 0; k < 8; ++k) r[k] = m[k] + gg[k] * (ov[k] * inv * gnv[k]);
        u32x4 o = {pk2(r[0], r[1]), pk2(r[2], r[3]), pk2(r[4], r[5]), pk2(r[6], r[7])}; *(u32x4*)(ZOG + e) = o; }
}

__device__ __forceinline__ void t_reduce_wo(Frame& F) {
    const int gw = F.vcu * 8 + F.wave, NGW = F.G * 8, lane = F.lane;
    float* fsm = (float*)(F.ws + WS_FSM); const float* Yp = (const float*)(F.ws + WS_R4); bf16_t* x1b = (bf16_t*)(F.ws + WS_R2);
    for (int r = gw; r < NSAMP; r += NGW) { float ss = 0.f;
#pragma unroll
        for (int j = 0; j < 4; ++j) { const int c = (lane + 64 * j) * 8; const float* xr = F.in[1] + (size_t)r * DM + c;
            f32x4 a = *(const f32x4*)xr, b = *(const f32x4*)(xr + 4);
#pragma unroll
            for (int ks = 0; ks < 8; ++ks) { const float* s = Yp + ((size_t)ks * 256 + r) * DM + c; a += *(const f32x4*)s; b += *(const f32x4*)(s + 4); }
            u32x4 o = {pk2(a[0], a[1]), pk2(a[2], a[3]), pk2(b[0], b[1]), pk2(b[2], b[3])}; *(u32x4*)(x1b + (size_t)(SEQ + r) * DM + c) = o;
            ss += (a[0] * a[0] + a[1] * a[1]) + (a[2] * a[2] + a[3] * a[3]) + (b[0] * b[0] + b[1] * b[1]) + (b[2] * b[2] + b[3] * b[3]); }
        ss = wave_sum(ss);
        if (lane < 8) fsm[F_SSQ_X1 + (size_t)(SEQ + r) * 8 + lane] = lane == 0 ? ss : 0.f; }
}
__device__ __forceinline__ void t_reduce_up(Frame& F) {
    const int gt = (F.vcu * 8 + F.wave) * 64 + F.lane, NGT = F.G * 512;
    const float* fsm = (const float*)(F.ws + WS_FSM); const float* U = (const float*)(F.ws + WS_R5); bf16_t* Hb = (bf16_t*)(F.ws + WS_ZL);
    for (int i = gt; i < NSAMP * 1024; i += NGT) { const int r = i >> 10, c = (i & 1023) * 8;
        const f32x4 q0_ = *(const f32x4*)(fsm + F_SSQ_X1 + (size_t)(SEQ + r) * 8), q1_ = *(const f32x4*)(fsm + F_SSQ_X1 + (size_t)(SEQ + r) * 8 + 4);
        const float inv2 = 1.f / ((((q0_[0] + q0_[1]) + (q0_[2] + q0_[3])) + ((q1_[0] + q1_[1]) + (q1_[2] + q1_[3]))) * (1.f / 2048.f) + EPS);
        f32x4 a = {0.f, 0.f, 0.f, 0.f}, b = a;
#pragma unroll
        for (int ks = 0; ks < 4; ++ks) { const float* s = U + ((size_t)ks * 256 + r) * DFF + c; a += *(const f32x4*)s; b += *(const f32x4*)(s + 4); }
#pragma unroll
        for (int k = 0; k < 4; ++k) { const float x = fmaxf(a[k], 0.f), y = fmaxf(b[k], 0.f); a[k] = x * x * inv2; b[k] = y * y * inv2; }
        u32x4 o = {pk2(a[0], a[1]), pk2(a[2], a[3]), pk2(b[0], b[1]), pk2(b[2], b[3])}; *(u32x4*)(Hb + (size_t)(SEQ + r) * DFF + c) = o; }
}
__device__ __forceinline__ void t_reduce_down(Frame& F) {
    const int gt = (F.vcu * 8 + F.wave) * 64 + F.lane, NGT = F.G * 512;
    const float* Dp = (const float*)(F.ws + WS_R4);
    for (int i = gt; i < NSAMP * 256; i += NGT) { const int r = i >> 8, c = (i & 255) * 8;
        float* yp = F.out + O_Y + (size_t)(SEQ + r) * DM + c; const u32x4 w = *(const u32x4*)((const bf16_t*)(F.ws + WS_R2) + (size_t)(SEQ + r) * DM + c);
        f32x4 a = {bflo(w.x), bfhi(w.x), bflo(w.y), bfhi(w.y)}, b = {bflo(w.z), bfhi(w.z), bflo(w.w), bfhi(w.w)};
#pragma unroll
        for (int ks = 0; ks < 16; ++ks) { const float* s = Dp + ((size_t)ks * 256 + r) * DM + c; a += *(const f32x4*)s; b += *(const f32x4*)(s + 4); }
        *(f32x4*)yp = a; *(f32x4*)(yp + 4) = b; }
}


__device__ __forceinline__ void t_local_wo(Frame& F, int pn, int part) {
    const int tid = F.wave * 64 + F.lane;
    float* fsm = (float*)(F.ws + WS_FSM); const float* Yp = (const float*)(F.ws + WS_R4); bf16_t* x1b = (bf16_t*)(F.ws + WS_R2);
#pragma unroll
    for (int j = 0; j < 2; ++j) { const int i = tid + 512 * j, r = part * 32 + (i >> 5), c = pn * 256 + (i & 31) * 8;
        const float* xr = F.in[1] + (size_t)r * DM + c;
        f32x4 a = *(const f32x4*)xr, b = *(const f32x4*)(xr + 4);
#pragma unroll
        for (int ks = 0; ks < 8; ++ks) { const float* s = Yp + ((size_t)ks * 256 + r) * DM + c; a += *(const f32x4*)s; b += *(const f32x4*)(s + 4); }
        u32x4 o = {pk2(a[0], a[1]), pk2(a[2], a[3]), pk2(b[0], b[1]), pk2(b[2], b[3])}; *(u32x4*)(x1b + (size_t)(SEQ + r) * DM + c) = o;
        float ss = (a[0] * a[0] + a[1] * a[1]) + (a[2] * a[2] + a[3] * a[3]) + (b[0] * b[0] + b[1] * b[1]) + (b[2] * b[2] + b[3] * b[3]);
        ss += __shfl_xor(ss, 1); ss += __shfl_xor(ss, 2); ss += __shfl_xor(ss, 4); ss += __shfl_xor(ss, 8); ss += __shfl_xor(ss, 16);
        if ((i & 31) == 0) fsm[F_SSQ_X1 + (size_t)(SEQ + r) * 8 + pn] = ss; }
}
__device__ __forceinline__ void t_local_up(Frame& F, int pn, int part) {
    const int tid = F.wave * 64 + F.lane;
    const float* fsm = (const float*)(F.ws + WS_FSM); const float* U = (const float*)(F.ws + WS_R5); bf16_t* Hb = (bf16_t*)(F.ws + WS_ZL);
#pragma unroll
    for (int j = 0; j < 4; ++j) { const int i = tid + 512 * j, r = part * 64 + (i >> 5), c = pn * 256 + (i & 31) * 8;
        const f32x4 q0_ = *(const f32x4*)(fsm + F_SSQ_X1 + (size_t)(SEQ + r) * 8), q1_ = *(const f32x4*)(fsm + F_SSQ_X1 + (size_t)(SEQ + r) * 8 + 4);
        const float inv2 = 1.f / ((((q0_[0] + q0_[1]) + (q0_[2] + q0_[3])) + ((q1_[0] + q1_[1]) + (q1_[2] + q1_[3]))) * (1.f / 2048.f) + EPS);
        f32x4 a = {0.f, 0.f, 0.f, 0.f}, b = a;
#pragma unroll
        for (int ks = 0; ks < 4; ++ks) { const float* s = U + ((size_t)ks * 256 + r) * DFF + c; a += *(const f32x4*)s; b += *(const f32x4*)(s + 4); }
#pragma unroll
        for (int k = 0; k < 4; ++k) { const float x = fmaxf(a[k], 0.f), y = fmaxf(b[k], 0.f); a[k] = x * x * inv2; b[k] = y * y * inv2; }
        u32x4 o = {pk2(a[0], a[1]), pk2(a[2], a[3]), pk2(b[0], b[1]), pk2(b[2], b[3])}; *(u32x4*)(Hb + (size_t)(SEQ + r) * DFF + c) = o; }
}
__device__ __forceinline__ void t_local_down(Frame& F, int pn, int part) {
    const int tid = F.wave * 64 + F.lane;
    const float* Dp = (const float*)(F.ws + WS_R4);
    { const int r = part * 16 + (tid >> 5), c = pn * 256 + (tid & 31) * 8;
        float* yp = F.out + O_Y + (size_t)(SEQ + r) * DM + c; const u32x4 w = *(const u32x4*)((const bf16_t*)(F.ws + WS_R2) + (size_t)(SEQ + r) * DM + c);
        f32x4 a = {bflo(w.x), bfhi(w.x), bflo(w.y), bfhi(w.y)}, b = {bflo(w.z), bfhi(w.z), bflo(w.w), bfhi(w.w)};
#pragma unroll
        for (int ks = 0; ks < 16; ++ks) { const float* s = Dp + ((size_t)ks * 256 + r) * DM + c; a += *(const f32x4*)s; b += *(const f32x4*)(s + 4); }
        *(f32x4*)yp = a; *(f32x4*)(yp + 4) = b; }
}

#ifndef N_LAUNCHES
#define N_LAUNCHES 1
#endif
constexpr int N_PHASES = 16;

__device__ __forceinline__ att::BlockRef att_ref(Frame& F, int h, int qb, int dry) {
    att::BlockRef r;
    r.Q = (const bf16_t*)(F.ws + WS_R1) + ((size_t)h * NTOK + (size_t)qb * 256) * 192;
    r.K = (const bf16_t*)(F.out + O_Y) + (size_t)h * SEQ * 192;
    r.V = (const bf16_t*)(F.ws + WS_R2) + (size_t)h * SEQ * 128;
    r.G = (bf16_t*)(F.ws + WS_ZGM) + (size_t)qb * 256 * 2048 + h * 128;
    r.fsm = (const float*)(F.ws + WS_FSM); r.ssq_qg = (const float*)((const char*)(F.out + O_Y) + 56 * MiB);
    r.qb = qb; r.h = h; r.dry = dry; return r;
}
__device__ __forceinline__ void p4_attention(Frame& F, int dry) {
    const int nblk = 512;
    int n = F.vcu * 2; if (n >= nblk) return;
    att::Seam S;
    att::BlockRef cur = att_ref(F, n >> 5, (n & 1) ? 31 - ((n >> 1) & 15) : ((n >> 1) & 15), dry);
    att::prime(cur, (char*)F.lds, S, F.wave);
    for (;;) {
        int nn = (n & 1) ? (n - 1 + 2 * F.G) : n + 1;
        const bool last = nn >= nblk;
        const att::BlockRef nxt = last ? cur : att_ref(F, nn >> 5, (nn & 1) ? 31 - ((nn >> 1) & 15) : ((nn >> 1) & 15), dry);
        att::block(cur, nxt, (char*)F.lds, S, F.wave);
        if (last) break;
        cur = nxt; n = nn;
    }
}

struct Args { const float* in[22]; float* out; unsigned char* ws; float freq[32]; int ph_lo, ph_hi, li, probe; };

__global__ void __launch_bounds__(512, 2) mega_fwd(Args args) {
    extern __shared__ __attribute__((aligned(16))) unsigned char lds_raw[];
    Frame F;
    F.lds = (LAS unsigned char*)lds_raw; F.ws = args.ws; F.out = args.out; F.in = args.in;
    F.tid = threadIdx.x; F.lane = F.tid & 63; F.wave = __builtin_amdgcn_readfirstlane(F.tid >> 6);
    F.G = gridDim.x; { const int bx = blockIdx.x; F.vcu = (F.G % 8 == 0) ? (bx % 8) * (F.G / 8) + bx / 8 : bx; }
    volatile LAS unsigned* MISC = (volatile LAS unsigned*)(F.lds + MISC_OFF);
    for (int u = F.tid; u < (LDS_BYTES - LDSCTL_OFF) / 4; u += 512) ((LAS unsigned*)(F.lds + LDSCTL_OFF))[u] = 0u;
    __syncthreads();
    XcdBarrier bar; bar.bar = (unsigned*)(F.ws + WS_CTL) + 4096; bar.x = 0; bar.st = nullptr;
    if (N_LAUNCHES == 1) bar = xcd_barrier_post((unsigned*)(F.ws + WS_CTL) + 4096, MISC + 8, F.tid == 0);
    EP ep; ep.ws = F.ws; ep.out = F.out; ep.xp = args.in[0]; ep.xs = args.in[1]; ep.gqn = args.in[11]; ep.gqr = args.in[12]; ep.gkn = args.in[13]; ep.gkr = args.in[14]; ep.lds = F.lds; ep.dry = 0;
    const int lo = args.ph_lo, hi = args.ph_hi;
#ifndef PH_MASK
#define PH_MASK 0xffffffff
#endif
#define IN(k) ((((unsigned)PH_MASK >> (k)) & 1u) && lo <= (k) && (k) < hi)
#define RF() do { int l_ = lane_id_(); asm volatile("" : "+v"(l_)); F.lane = l_; F.tid = F.wave * 64 + l_; } while (0)
#define SEAM(k) do { if (IN(k) && IN((k) + 1)) xcd_barrier(bar, F.wave == 0 && lane_id_() == 0); RF(); } while (0)
    int rot = 0;
    const bool late_w = (F.G == 256);
    if (IN(0)) {
        p0_prologue(F, late_w ? 1 : 3, F.vcu, F.G);
        { float* cs = (float*)(F.ws + WS_FSM) + F_ROPE; const int gt = (F.vcu * 8 + F.wave) * 64 + F.lane;
          for (int i = gt; i < SEQ * 32; i += F.G * 512) { const int p = i >> 5, k = i & 31;
              const float ang = (float)p * args.freq[k];
              const double xd = (double)ang; const double kq = __builtin_rint(xd * 0.63661977236758134308); const float r = (float)(xd - kq * 1.57079632679489661923);
              const float sr = __sinf(r), cr = __cosf(r); const int q = ((int)kq) & 3;
              const float c = (q == 0) ? cr : (q == 1) ? -sr : (q == 2) ? -cr : sr;
              const float s = (q == 0) ? sr : (q == 1) ? cr : (q == 2) ? -sr : -cr;
              cs[p * 64 + k] = c; cs[p * 64 + 32 + k] = s; } }
    }
#if defined(PROBE) && (PROBE & 4)
    if (IN(0) && args.probe) { p0_prologue(F, 3, F.vcu, F.G); }
#endif
#if defined(PROBE) && (PROBE & 64)
    if (args.probe) { for (int i = 0; i < 10; ++i) xcd_barrier(bar, F.wave == 0 && lane_id_() == 0); }
#endif
    SEAM(0);
    const bool kcat_early = false;
    if (IN(1)) { rot = 0; run_gemm<M_INPROJ>(F, ep, 33 * 45, 4096, 4096, 32, 32, rot, 1);
        RF(); if (late_w && F.vcu >= 205) p0_prologue(F, 2, F.vcu - 205, 51);
#if defined(PROBE) && (PROBE & 1)
        if (args.probe) { EP ed = ep; ed.dry = args.probe; rot = 0; run_gemm<M_INPROJ>(F, ed, 33 * 45, 4096, 4096, 32, 32, rot); }
#endif
#if defined(PROBE) && (PROBE & 512)
        if (args.probe) { rot = 0; run_gemm<M_INPROJ>(F, ep, 33 * 45, 4096, 4096, 32, 32, rot); }
#endif
    }
    SEAM(1);
    if (IN(2)) { rot = 0; run_gemm<M_QUP>(F, ep, 33 * 12, 2048, 1024, 8, 8, rot); run_gemm<M_KVUP>(F, ep, 33 * 16, 2048, 1024, 8, 8, rot); RF();
        if ((F.vcu & 1) == 0 || F.G != 256) { p2_ckv_krope(F); RF(); p3_kcat_ct(F, kcat_early); RF(); p3_gla_prep(F); }
        else { p3_gla_prep(F); RF(); p2_ckv_krope(F); RF(); p3_kcat_ct(F, kcat_early); } }
#if defined(PROBE) && (PROBE & 128)
    if (IN(2) && args.probe) { EP ed = ep; ed.dry = args.probe; rot = 0; run_gemm<M_QUP>(F, ed, 33 * 12, 2048, 1024, 8, 8, rot); run_gemm<M_KVUP>(F, ed, 33 * 16, 2048, 1024, 8, 8, rot);
        run_gemm<M_CNORM>(F, ed, 144 * 8, 1280, 1024, 8, 8, rot); }
#endif
    SEAM(2);
#if defined(PROBE) && (PROBE & 2)
    if (IN(4) && args.probe) { p4_attention(F, args.probe); }
#endif
    if (IN(4)) { rot = 0; p4_attention(F, 0); RF(); for (int L = F.vcu; L < 32; L += F.G) p4_finalize_q_head(F, L >> 1); asm volatile("s_waitcnt vmcnt(0)" ::: "memory"); __syncthreads(); run_gemm<M_QABS>(F, ep, 32, 512, 512, 4, 4, rot); run_gemm<M_CNORM>(F, ep, 128 * 8, 1280, 1024, 8, 8, rot); }
    SEAM(4);
    if (IN(5)) { rot = 0; run_gemm<M_S>(F, ep, 144, 1280, 1280, 10, 10, rot); if (F.G == 256) { const bool sc = F.vcu < 144;
            run_gemm_cg<M_GLA_A>(F, ep, F.vcu, sc ? 384 : 112, 384, 512, 512, 4); }
        else run_gemm<M_GLA_A>(F, ep, 384, 512, 512, 4, 4, rot); }
    SEAM(5);
    const bool wwin = (F.G == 256);
    constexpr int J6 = 4000, J8 = 13000, J10 = 14200;
    if (IN(6)) { rot = 0; run_gemm<M_PC>(F, ep, 96, 4608, 4608, 12, 12, rot); RF(); p6_softmax_scan(F); if (wwin && F.vcu >= 96) p9_ffn_weights(F, 0, J6, F.vcu - 96, 160); }
    SEAM(6);
    if (IN(7)) { { int r2 = 0; run_gemm<M_GLA_O>(F, ep, 512, 512, 512, 4, 4, r2); } RF(); p8_pc_convert(F); }
    SEAM(7);
    const int x_nx = __builtin_amdgcn_readfirstlane((int)MISC[8 + 1]), x_minc = __builtin_amdgcn_readfirstlane((int)MISC[8 + 2]);
    const int x_xi = __builtin_amdgcn_readfirstlane((int)MISC[8 + 3]), x_rank = __builtin_amdgcn_readfirstlane((int)MISC[8 + 4]);
    const bool xl = (N_LAUNCHES == 1) && XCD_LOCAL_TAIL && F.G == 256 && x_nx == 8 && x_minc == 32;
    unsigned* lctr = (unsigned*)(F.ws + WS_CTL) + 7680;
#define T0() (F.wave == 0 && lane_id_() == 0)
    if (IN(8)) { rot = 0; run_gemm<M_O>(F, ep, 16, 1024, 1024, 8, 8, rot); RF();
        if ((F.vcu & 1) == 0 || !wwin) { p9_gla_sample(F); RF(); p10_mix(F, 0, SEQ, F.vcu, F.G); RF(); if (wwin) { if (F.vcu >= 16) p9_ffn_weights(F, J6, J8, F.vcu - 16, 240); } else p9_ffn_weights(F, 0, 16384, F.vcu, F.G); }
        else { p10_mix(F, 0, SEQ, F.vcu, F.G); RF(); if (F.vcu >= 16) p9_ffn_weights(F, J6, J8, F.vcu - 16, 240); RF(); p9_gla_sample(F); } }
#if defined(PROBE) && (PROBE & 32)
    if (IN(8) && args.probe) { p9_ffn_weights(F, 0, 16384, F.vcu, F.G); }
#endif
    SEAM(8);
    if (!xl) { if (IN(9)) { p10_mix(F, SEQ, NTOK, F.vcu, F.G); }
    SEAM(9); }
#if defined(PROBE) && (PROBE & 512)
    if (IN(10) && args.probe) { rot = 0; run_gemm<M_WO>(F, ep, 32 * 8, 4096, 4096, 32, 32, rot); }
#endif
    if (IN(10)) {
        if (xl) { p10_mix(F, SEQ, NTOK, x_rank, 32); xcd_local_join(lctr + 384 + x_xi * 8, 32u, bar.bar, T0()); RF(); }
        { const int c = xl ? (x_rank < 8 ? x_rank * 8 + x_xi : 64) : F.vcu, st = xl ? 64 : F.G; run_gemm_cg<M_WO_S>(F, ep, c, st, 64, 4096, 4096, 4); }
        if (xl && x_rank < 8) { xcd_local_join(lctr + x_xi * 8, 8u, bar.bar, T0()); RF(); t_local_wo(F, x_xi, x_rank); }
        rot = 64 % F.G; run_gemm<M_WO>(F, ep, 32 * 8, 4096, 4096, 32, 32, rot); RF();
        if (xl) { if (x_rank >= 8) p9_ffn_weights(F, J8, J10, x_xi * 24 + x_rank - 8, 192); }
        else if (wwin && F.vcu >= 64) p9_ffn_weights(F, J8, J10, F.vcu - 64, 192); }
    SEAM(10);
    if (!xl) { if (IN(11)) { t_reduce_wo(F); }
        SEAM(11); }
#if defined(PROBE) && (PROBE & 512)
    if (IN(12) && args.probe) { rot = 0; run_gemm<M_UP>(F, ep, 32 * 32, 4096, 4096, 32, 32, rot); }
#endif
#if defined(PROBE) && (PROBE & 1024)
    if (IN(12) && args.probe) { rot = 0; run_gemm<M_UP>(F, ep, 32 * 32, 4096, 4096, 32, 32, rot); }
#endif
#if defined(PROBE) && (PROBE & 2048)
    if (IN(12) && args.probe) { EP ed = ep; ed.dry = args.probe + 1; rot = 0; run_gemm<M_UP>(F, ed, 32 * 32, 4096, 4096, 32, 32, rot); }
#endif
#if defined(PROBE) && (PROBE & 4096)
    if (IN(12) && args.probe) { EP ed = ep; ed.dry = args.probe; rot = 0; run_gemm<M_UP>(F, ed, 32 * 32, 4096, 4096, 32, 32, rot); }
#endif
    if (IN(12)) {
        const int upn = x_xi * 4 + (x_rank >> 2), uks = x_rank & 3;
        { const int c = xl ? (x_rank < 16 ? uks * 32 + upn : 128) : F.vcu, st = xl ? 128 : F.G; run_gemm_cg<M_UP_S>(F, ep, c, st, 128, 4096, 4096, 8); }
        if (xl && x_rank < 16) { xcd_local_join(lctr + 64 + upn * 8, 4u, bar.bar, T0()); RF(); t_local_up(F, upn, uks); }
        rot = 128 % F.G; run_gemm<M_UP>(F, ep, 32 * 32, 4096, 4096, 32, 32, rot, 1); RF();
        if (xl) { if (x_rank >= 16) p9_ffn_weights(F, J10, 16384, x_xi * 16 + x_rank - 16, 128); }
        else if (wwin && F.vcu >= 128) p9_ffn_weights(F, J10, 16384, F.vcu - 128, 128); }
    SEAM(12);
    if (!xl) { if (IN(13)) { t_reduce_up(F); }
        SEAM(13); }
    if (IN(14)) {
        { const int c = xl ? (x_rank < 16 ? x_rank * 8 + x_xi : 128) : F.vcu, st = xl ? 128 : F.G; run_gemm_cg<M_DOWN_S>(F, ep, c, st, 128, 16384, 16384, 8); }
        if (xl && x_rank < 16) { xcd_local_join(lctr + 320 + x_xi * 8, 16u, bar.bar, T0()); RF(); t_local_down(F, x_xi, x_rank); }
        rot = 128 % F.G; run_gemm<M_DOWN>(F, ep, 32 * 8, 16384, 16384, 128, 128, rot); }
    if (!xl) { SEAM(14);
        if (IN(15)) { t_reduce_down(F); } }
#undef T0
#undef IN
#undef SEAM
}

extern "C" void kernel_launch(void* const* d_in, const int* in_sizes, int n_in, void* d_out, int out_size, void* d_ws, size_t ws_size, hipStream_t stream) {
    static int grid = 0;
    if (grid == 0) {
        if (n_in != 22 || out_size != (int)O_END || ws_size < WS_END) { fprintf(stderr, "kernel_launch: unexpected shapes (n_in %d out %d ws %zu)\n", n_in, out_size, ws_size); grid = -1; return; }
        int dev = 0, cus = 0, per_cu = 0;
        if (hipGetDevice(&dev) != hipSuccess || hipDeviceGetAttribute(&cus, hipDeviceAttributeMultiprocessorCount, dev) != hipSuccess) { grid = -1; return; }
        if (hipFuncSetAttribute((const void*)mega_fwd, hipFuncAttributeMaxDynamicSharedMemorySize, LDS_BYTES) != hipSuccess) { fprintf(stderr, "kernel_launch: hipFuncSetAttribute failed\n"); grid = -1; return; }
        if (hipOccupancyMaxActiveBlocksPerMultiprocessor(&per_cu, (const void*)mega_fwd, 512, LDS_BYTES) != hipSuccess || per_cu < 1) { fprintf(stderr, "kernel_launch: occupancy query says %d blocks per CU\n", per_cu); (void)hipGetLastError(); grid = -1; return; }
        grid = cus;
    }
    if (grid < 0) return;
    (void)hipMemsetAsync((char*)d_ws + WS_CTL, 0, 32768, stream);
    Args a{};
    for (int i = 0; i < 22; ++i) a.in[i] = (const float*)d_in[i];
    a.out = (float*)d_out; a.ws = (unsigned char*)d_ws;
#ifdef PROBE
    a.probe = 1;
#endif
    for (int k = 0; k < 32; ++k) a.freq[k] = powf(10000.f, -(float)k / 32.f);
    if (N_LAUNCHES == 1) { a.ph_lo = 0; a.ph_hi = N_PHASES; a.li = 0; hipLaunchKernelGGL(mega_fwd, dim3(grid), dim3(512), LDS_BYTES, stream, a); }
    else { for (int p = 0; p < N_PHASES; ++p) { a.ph_lo = p; a.ph_hi = p + 1; a.li = p; hipLaunchKernelGGL(mega_fwd, dim3(grid), dim3(512), LDS_BYTES, stream, a); } }
}
```

```cpp
#include <hip/hip_runtime.h>
#include <hip/hip_bf16.h>
#include <cstdio>
#include <cstdint>

#define LAS __attribute__((address_space(3)))
#define GAS __attribute__((address_space(1)))
typedef unsigned short bf16_t;
typedef short bf16x8 __attribute__((ext_vector_type(8)));
typedef short s16x4 __attribute__((ext_vector_type(4)));
typedef float f32x4 __attribute__((ext_vector_type(4)));
typedef float f32x2 __attribute__((ext_vector_type(2)));
typedef float f32x16 __attribute__((ext_vector_type(16)));
typedef unsigned u32x4 __attribute__((ext_vector_type(4)));
typedef unsigned u32x2 __attribute__((ext_vector_type(2)));

constexpr int DM = 2048, SEQ = 8192, NSAMP = 256, NTOK = 8448, NZ = 11520, DFF = 8192, DIN = 11344;
constexpr int NH = 16, QKD = 192, NOPE = 128, ROPE = 64, VD = 128, QR = 512, KVR = 512;
constexpr int GH = 4, GDK = 256, GDV = 512, GC = 256, NCH = 32;
constexpr int PAST = 2048, NKEY = 2064, NKP = 2304, DQC = 640, DECB = 16, DECS = 16;
constexpr float EPS = 1e-6f;
constexpr float LOG2E = 1.4426950408889634f;
constexpr float MLA_SCALE = 0.07216878364870322f;

constexpr size_t MiB = 1u << 20;
constexpr size_t WS_CTL = 0, CTL_BYTES = 1 * MiB;
constexpr size_t WS_FSM = 1 * MiB;
constexpr size_t WS_WSM = 7 * MiB;
constexpr size_t WS_ZL = 30 * MiB, WS_ZM = 47 * MiB, WS_ZQK = 52 * MiB, WS_ZV = 85 * MiB, WS_ZOG = 118 * MiB, WS_ZGM = 151 * MiB, WS_ZGG = 184 * MiB;
constexpr size_t WS_R1 = 217 * MiB, WS_R2 = 267 * MiB, WS_R3 = 300 * MiB, WS_R4 = 345 * MiB, WS_R5 = 381 * MiB, WS_END = 413 * MiB;
constexpr size_t F_SSQ_QL = 0  , F_SSQ_KV = F_SSQ_QL + 16896  , F_SSQ_X1 = F_SSQ_KV + 16896  , F_KRSS = F_SSQ_X1 + 67584, F_SSQ_K = F_KRSS + 8448  ,
                 F_SSQ_OG = F_SSQ_K + 135168  , F_KNSS_C = F_SSQ_OG + 135168, F_KRSS_C = F_KNSS_C + 589824, F_GAMMA = F_KRSS_C + 36864, F_ROPE = F_GAMMA + 32768, F_END = F_ROPE + 524288;
static_assert(F_END * 4 <= 6 * MiB, "FSM");
constexpr size_t W_UQ = 0, W_UKVG = W_UQ + 3072 * 512, W_KNP = W_UKVG + 4096 * 512, W_VP = W_KNP + 2048 * 512, W_KNABS = W_VP + 2048 * 512, W_O = W_KNABS + 16 * 512 * 256, W_END = W_O + 2048 * 2048;
static_assert(W_END * 2 <= 23 * MiB, "WSM");
constexpr size_t O_Y = 0, O_CKVP = 17301504, O_KRP = 21495808, O_STP = 22020096, O_CKVS = 22544384, O_KRS = 22675456, O_STS = 22691840, O_END = 31080448;

#define RLX_AGENT __ATOMIC_RELAXED, __HIP_MEMORY_SCOPE_AGENT
__device__ __forceinline__ unsigned cvt_pk_bf16(float lo, float hi) { unsigned r; asm volatile("v_cvt_pk_bf16_f32 %0, %1, %2" : "=v"(r) : "v"(lo), "v"(hi)); return r; }
__device__ __forceinline__ float bf2f(unsigned short b) { return __uint_as_float(((unsigned)b) << 16); }
__device__ __forceinline__ float bflo(unsigned w) { return __uint_as_float(w << 16); }
__device__ __forceinline__ float bfhi(unsigned w) { return __uint_as_float(w & 0xffff0000u); }
__device__ __forceinline__ unsigned short f2bf(float f) { return (unsigned short)(cvt_pk_bf16(f, 0.f) & 0xffffu); }
__device__ __forceinline__ float sigmoidf_(float x) { return 1.f / (1.f + __expf(-x)); }
__device__ __forceinline__ int lane_id_() { int l_; asm volatile("v_mbcnt_lo_u32_b32 %0, -1, 0\n\tv_mbcnt_hi_u32_b32 %0, -1, %0" : "=v"(l_)); return l_; }
__device__ __forceinline__ float wave_sum(float v) {
#pragma unroll
    for (int o = 1; o < 64; o <<= 1) v += __shfl_xor(v, o);
    return v;
}
__device__ __forceinline__ float wave_max(float v) {
#pragma unroll
    for (int o = 1; o < 64; o <<= 1) v = fmaxf(v, __shfl_xor(v, o));
    return v;
}

#ifndef XCD_LOCAL_TAIL
#define XCD_LOCAL_TAIL 1
#endif
#define XB_TMO      128
#define XB_XCNT(j)  (256  + 64 * (j))
#define XB_XSUB(j)  (1280 + 64 * (j))
#define XB_XGEN(j)  (2304 + 64 * (j))
#define XB_TOP      3328
#define XB_TOPGEN   3392
#define XCD_BAR_WORDS 3456
#define XB_SPIN_CAP (1u << 22)
__device__ __forceinline__ unsigned xb_ld(unsigned* p)              { return __hip_atomic_load(p, __ATOMIC_RELAXED, __HIP_MEMORY_SCOPE_AGENT); }
__device__ __forceinline__ unsigned xb_add(unsigned* p, unsigned v) { return __hip_atomic_fetch_add(p, v, __ATOMIC_RELAXED, __HIP_MEMORY_SCOPE_AGENT); }
__device__ __forceinline__ unsigned xb_xcc_id() { return (unsigned)__builtin_amdgcn_s_getreg((3 << 11) | 20) & 0xFu; }
#define XB_SPIN(cond, bar) do { unsigned _sp = 0; while (cond) { __builtin_amdgcn_s_sleep(1); \
    if ((++_sp & 255u) == 0u) { if (xb_ld(&(bar)[XB_TMO])) break; if (_sp > XB_SPIN_CAP) { atomicAdd(&(bar)[XB_TMO], 1u); break; } } } } while (0)
struct XcdBarrier { unsigned* bar; unsigned x; volatile LAS unsigned* st; };
__device__ __forceinline__ XcdBarrier xcd_barrier_post(unsigned* bar, volatile LAS unsigned* st, bool t0) {
    XcdBarrier b; b.bar = bar; b.x = xb_xcc_id(); b.st = st;
    if (t0) st[4] = xb_add(&bar[XB_XCNT(b.x)], 1u);
    return b;
}
__device__ __forceinline__ void xcd_barrier_complete(unsigned* bar, unsigned x, unsigned& nloc, unsigned& nx, unsigned& minc, unsigned& xi) {
    const unsigned G = gridDim.x * gridDim.y * gridDim.z;
    unsigned sum, cnt, mine, mn, below, sp = 0u;
    for (;;) {
        sum = 0u; cnt = 0u; mine = 0u; mn = ~0u; below = 0u;
#pragma unroll
        for (unsigned j = 0; j < 16; ++j) { const unsigned c = xb_ld(&bar[XB_XCNT(j)]); sum += c; cnt += (c > 0u) ? 1u : 0u; mine = (j == x) ? c : mine; mn = (c > 0u && c < mn) ? c : mn; below += (c > 0u && j < x) ? 1u : 0u; }
        if (sum == G) break;
        __builtin_amdgcn_s_sleep(1);
        if ((++sp & 255u) == 0u) { if (xb_ld(&bar[XB_TMO])) break; if (sp > XB_SPIN_CAP) { atomicAdd(&bar[XB_TMO], 1u); break; } }
    }
    nloc = mine > 0u ? mine : 1u; nx = cnt > 0u ? cnt : 1u; minc = mn; xi = below;
}
__device__ __forceinline__ void xcd_local_join(unsigned* ctr, unsigned target, unsigned* bar, bool t0) {
    asm volatile("s_waitcnt vmcnt(0)" ::: "memory");
    __syncthreads();
    if (t0) {
        __builtin_amdgcn_s_waitcnt(0);
        (void)xb_add(ctr, 1u);
        XB_SPIN(xb_ld(ctr) < target, bar);
        __builtin_amdgcn_fence(__ATOMIC_ACQUIRE, "agent");
        asm volatile("s_waitcnt vmcnt(0)" ::: "memory");
    }
    __syncthreads();
}
__device__ __forceinline__ void xcd_barrier(const XcdBarrier& b, bool t0) {
    asm volatile("s_waitcnt vmcnt(0)" ::: "memory");
    __syncthreads();
    if (t0) {
        unsigned* bar = b.bar;
        __builtin_amdgcn_s_waitcnt(0);
        unsigned nloc = b.st[0], nx = b.st[1];
        if (nloc == 0u) { unsigned minc, xi; xcd_barrier_complete(bar, b.x, nloc, nx, minc, xi); b.st[0] = nloc; b.st[1] = nx; b.st[2] = minc; b.st[3] = xi; }
        const unsigned old = xb_add(&bar[XB_XSUB(b.x)], 1u);
        const unsigned gen = old / nloc;
        if (old + 1u == (gen + 1u) * nloc) {
            __builtin_amdgcn_fence(__ATOMIC_RELEASE, "agent");
            asm volatile("s_waitcnt vmcnt(0)" ::: "memory");
            const unsigned og = xb_add(&bar[XB_TOP], 1u);
            const unsigned tg = og / nx;
            if (og + 1u == (tg + 1u) * nx) xb_add(&bar[XB_TOPGEN], 1u);
            else XB_SPIN(xb_ld(&bar[XB_TOPGEN]) == tg, bar);
            __builtin_amdgcn_fence(__ATOMIC_ACQUIRE, "agent");
            xb_add(&bar[XB_XGEN(b.x)], 1u);
            asm volatile("s_waitcnt vmcnt(0)" ::: "memory");
        } else {
            XB_SPIN(xb_ld(&bar[XB_XGEN(b.x)]) == gen, bar);
            __builtin_amdgcn_fence(__ATOMIC_ACQUIRE, "agent");
            asm volatile("s_waitcnt vmcnt(0)" ::: "memory");
        }
    }
    __syncthreads();
}

constexpr int RING_BYTES = 131072, LDSCTL_OFF = RING_BYTES, MISC_OFF = LDSCTL_OFF + 320, LDS_BYTES = 147456;

struct Frame {
    LAS unsigned char* lds; unsigned char* ws; float* out; const float* const* in;
    int tid, lane, wave, vcu, G;
};

namespace pg8 {
constexpr int BM = 256, BK = 64, HALF = 128, HTB = HALF * BK * 2, STAGE_BYTES = 8 * HTB;
__device__ __forceinline__ int lds_byte(int r, int c) { const int st = (r >> 4) * 2 + (c >> 5), rr = r & 15, cc = c & 31, ob = rr * 64 + cc * 2; return st * 1024 + (ob ^ (((ob >> 9) & 1) << 5)); }
__device__ __forceinline__ void stage_rc(int b, int& R, int& C) { const int st = b / 1024, sb = b % 1024, swz = sb ^ (((sb >> 9) & 1) << 5); R = (st >> 1) * 16 + swz / 64; C = (st & 1) * 32 + (swz % 64) / 2; }
__device__ __forceinline__ int perm32(int rho) { const int n = rho >> 4, i = rho & 15; return 8 * (i >> 2) + 4 * n + (i & 3); }

struct GUnit { const char* A; const char* B; int pm, pn, aux; };
struct GCfg { unsigned lda, ldb; int nt, t1; };

typedef f32x4 Acc[2][2][4][2];

template <class Epi, class Sched>
__device__ __forceinline__ void gemm_phase(LAS unsigned char* lds, const GCfg g, const Sched& S, const Epi& E, int wave) {
    int lane_ = lane_id_(); asm volatile("" : "+v"(lane_));
    const int wid = wave, lane = lane_, tid = wid * 64 + lane, wr = wid >> 2, wc = wid & 3, fr = lane & 15, fq = lane >> 4;
    const int nt = g.nt;
    unsigned voffA[2], voffB[2];
#pragma unroll
    for (int i = 0; i < 2; ++i) { int R, C; stage_rc(tid * 16 + i * 8192, R, C); const int Rb = (R & ~31) + perm32(R & 31);
        voffA[i] = (unsigned)R * g.lda + (unsigned)C * 2u; voffB[i] = (unsigned)Rb * g.ldb + (unsigned)C * 2u; }
    const size_t kstep = (size_t)(BK * 2);
    const size_t hstepA = (size_t)HALF * g.lda, hstepB = (size_t)HALF * g.ldb;
    const unsigned ldsw = (unsigned)wid * 1024u;
    const int aoff = lds_byte(wr * 64 + fr, fq * 8), boff = lds_byte(wc * 32 + fr, fq * 8);
#define PG8_SA(b, h) (((b) * 2 + (h)) * HTB)
#define PG8_SB(b, h) ((4 + (b) * 2 + (h)) * HTB)
#define PG8_STAGE(bufoff, gbase, voff) do { _Pragma("unroll") for (int _i = 0; _i < 2; ++_i) \
        __builtin_amdgcn_global_load_lds((const unsigned*)((const char*)(gbase) + (voff)[_i]), (LAS unsigned*)(lds + (bufoff) + ldsw + _i * 8192), 16, 0, 0); } while (0)
#define PG8_LDA(dst, b, h) do { _Pragma("unroll") for (int m = 0; m < 4; ++m) _Pragma("unroll") for (int k = 0; k < 2; ++k) dst[m][k] = *(const LAS bf16x8*)(lds + PG8_SA(b, h) + aoff + m * 2048 + k * 1024); } while (0)
#define PG8_LDB(dst, b, h) do { _Pragma("unroll") for (int n = 0; n < 2; ++n) _Pragma("unroll") for (int k = 0; k < 2; ++k) dst[n][k] = *(const LAS bf16x8*)(lds + PG8_SB(b, h) + boff + n * 2048 + k * 1024); } while (0)
#define PG8_MMA(ai, bj, At, Bt) do { __builtin_amdgcn_s_setprio(1); _Pragma("unroll") for (int m = 0; m < 4; ++m) _Pragma("unroll") for (int n = 0; n < 2; ++n) _Pragma("unroll") for (int k = 0; k < 2; ++k) \
        acc[ai][bj][m][n] = __builtin_amdgcn_mfma_f32_16x16x32_bf16(Bt[n][k], At[m][k], acc[ai][bj][m][n], 0, 0, 0); __builtin_amdgcn_s_setprio(0); } while (0)
#define PG8_WAIT_V(n) asm volatile("s_waitcnt vmcnt(" #n ")" ::: "memory")
#define PG8_WAIT_L(n) asm volatile("s_waitcnt lgkmcnt(" #n ")" ::: "memory")
#define PG8_BAR __builtin_amdgcn_s_barrier()
#define PG8_SCHED __builtin_amdgcn_sched_barrier(0)
#define PG8_APTR(u, t) ((u).A + (size_t)(t) * kstep)
#define PG8_BPTR(u, t) ((u).B + (size_t)(t) * kstep)
    GUnit cur, nxt; int ui = 0;
    if (!S.next(0, cur)) return;
    Acc acc;
#pragma unroll
    for (int a = 0; a < 2; ++a)
#pragma unroll
        for (int b = 0; b < 2; ++b)
#pragma unroll
            for (int m = 0; m < 4; ++m)
#pragma unroll
                for (int n = 0; n < 2; ++n) acc[a][b][m][n] = (f32x4){0.f, 0.f, 0.f, 0.f};
    bf16x8 At[4][2], B0[2][2], B1[2][2];
    {
        const char* cA = cur.A; const char* cB = cur.B;
        PG8_STAGE(PG8_SB(0, 0), cB, voffB); PG8_STAGE(PG8_SB(0, 1), cB + hstepB, voffB); PG8_STAGE(PG8_SA(0, 0), cA, voffA); PG8_STAGE(PG8_SA(0, 1), cA + hstepA, voffA);
        if (wr == 1) PG8_BAR;
        PG8_WAIT_V(2); PG8_BAR;
        PG8_STAGE(PG8_SB(1, 0), cB + kstep, voffB); PG8_STAGE(PG8_SA(1, 0), cA + kstep, voffA); PG8_STAGE(PG8_SB(1, 1), cB + hstepB + kstep, voffB);
        PG8_WAIT_V(6); PG8_BAR;
    }
    for (;;) {
        const bool has_next = S.next(ui + 1, nxt);
        if (!has_next) nxt = cur;
        for (int t = 0; t < nt; t += 2) {
            const bool last = (t == nt - 2);
            const char* a1 = PG8_APTR(cur, t + 1);
            const char* a2 = last ? nxt.A : PG8_APTR(cur, t + 2); const char* b2 = last ? nxt.B : PG8_BPTR(cur, t + 2);
            const char* a3 = last ? nxt.A + kstep : PG8_APTR(cur, t + 3); const char* b3 = last ? nxt.B + kstep : PG8_BPTR(cur, t + 3);
            PG8_LDB(B0, 0, 0); PG8_LDB(B1, 0, 1); PG8_SCHED; PG8_LDA(At, 0, 0); PG8_STAGE(PG8_SA(1, 1), a1 + hstepA, voffA);
            PG8_WAIT_V(8); PG8_WAIT_L(0); PG8_BAR; PG8_MMA(0, 0, At, B0); PG8_MMA(0, 1, At, B1); PG8_BAR; PG8_SCHED;
            PG8_LDA(At, 0, 1); PG8_STAGE(PG8_SB(0, 0), b2, voffB); PG8_STAGE(PG8_SB(0, 1), b2 + hstepB, voffB); PG8_STAGE(PG8_SA(0, 0), a2, voffA);
            PG8_WAIT_V(8); PG8_WAIT_L(0); PG8_BAR; PG8_MMA(1, 0, At, B0); PG8_MMA(1, 1, At, B1); PG8_BAR; PG8_SCHED;
            PG8_LDB(B0, 1, 0); PG8_LDB(B1, 1, 1); PG8_SCHED; PG8_LDA(At, 1, 0); PG8_STAGE(PG8_SA(0, 1), a2 + hstepA, voffA);
            PG8_WAIT_V(8); PG8_WAIT_L(0); PG8_BAR; PG8_MMA(0, 0, At, B0); PG8_MMA(0, 1, At, B1); PG8_BAR; PG8_SCHED;
            PG8_LDA(At, 1, 1); PG8_STAGE(PG8_SB(1, 0), b3, voffB); PG8_STAGE(PG8_SB(1, 1), b3 + hstepB, voffB); PG8_STAGE(PG8_SA(1, 0), a3, voffA);
            PG8_WAIT_V(8); PG8_WAIT_L(0); PG8_BAR; PG8_MMA(1, 0, At, B0); PG8_MMA(1, 1, At, B1); PG8_BAR; PG8_SCHED;
        }
        if (wr == 0) PG8_BAR;
        { int fr_ = fr, fq_ = fq; asm volatile("" : "+v"(fr_), "+v"(fq_));
          E(acc, cur, wr, wc, fr_, fq_); }
        if (!has_next) break;
#pragma unroll
        for (int a = 0; a < 2; ++a)
#pragma unroll
            for (int b = 0; b < 2; ++b)
#pragma unroll
                for (int m = 0; m < 4; ++m)
#pragma unroll
                    for (int n = 0; n < 2; ++n) acc[a][b][m][n] = (f32x4){0.f, 0.f, 0.f, 0.f};
        cur = nxt; ++ui;
        if (wr == 1) PG8_BAR;
    }
    PG8_WAIT_V(0);
    PG8_BAR;
#undef PG8_SA
#undef PG8_SB
#undef PG8_STAGE
#undef PG8_LDA
#undef PG8_LDB
#undef PG8_MMA
#undef PG8_WAIT_V
#undef PG8_WAIT_L
#undef PG8_BAR
#undef PG8_SCHED
#undef PG8_APTR
#undef PG8_BPTR
}

__device__ __forceinline__ void tile_of(int L, int nM, int nN, int& pm, int& pn) {
    const int nig = 8 * nN, gid = L / nig, fm = gid * 8, gsz = (nM - fm) < 8 ? (nM - fm) : 8, r = L % nig;
    pm = fm + r % gsz; pn = r / gsz;
}
}

enum { M_INPROJ = 0, M_QUP, M_KVUP, M_CNORM, M_QABS, M_S, M_PC, M_O, M_GLA_A, M_GLA_DS, M_GLA_O, M_GLA_O2, M_WO, M_UP, M_DOWN, M_WO_S, M_UP_S, M_DOWN_S };

struct EP { unsigned char* ws; float* out; const float* xp; const float* xs; const float* gqn; const float* gqr; const float* gkn; const float* gkr; LAS unsigned char* lds; int dry; };
constexpr int EPI_RED_OFF = 131072 + 1024;

__device__ __forceinline__ u32x4 pack8(const f32x4 v0, const f32x4 v1) {
    u32x4 w; w.x = cvt_pk_bf16(v0[0], v0[1]); w.y = cvt_pk_bf16(v0[2], v0[3]); w.z = cvt_pk_bf16(v1[0], v1[1]); w.w = cvt_pk_bf16(v1[2], v1[3]); return w;
}
#ifndef WT_STORES
#define WT_STORES 0
#endif
__device__ __forceinline__ void st16(void* ptr, const u32x4 v) {
#if WT_STORES
    asm volatile("global_store_dwordx4 %0, %1, off sc1\n\ts_nop 1" :: "v"(ptr), "v"(v) : "memory");
#else
    *(u32x4*)ptr = v;
#endif
}
__device__ __forceinline__ float sumsq8(const f32x4 a, const f32x4 b) {
    return (a[0] * a[0] + a[1] * a[1]) + (a[2] * a[2] + a[3] * a[3]) + (b[0] * b[0] + b[1] * b[1]) + (b[2] * b[2] + b[3] * b[3]);
}
__device__ __forceinline__ float red_fq(float s) { s += __shfl_xor(s, 16); s += __shfl_xor(s, 32); return s; }


__device__ __forceinline__ void epi_red_put(LAS unsigned char* lds, int slot, const float (&part)[2][4], int rt0, int wc, int fq) {
    LAS float* red = (LAS float*)(lds + EPI_RED_OFF) + slot * 1024;
    if (fq == 0) {
#pragma unroll
        for (int ai = 0; ai < 2; ++ai)
#pragma unroll
            for (int m = 0; m < 4; ++m) red[(rt0 + ai * 128 + m * 16) * 4 + wc] = part[ai][m];
    }
}
__device__ __forceinline__ void epi_red_sync() { asm volatile("s_waitcnt lgkmcnt(0)" ::: "memory"); __builtin_amdgcn_s_barrier(); asm volatile("" ::: "memory"); }
__device__ __forceinline__ float epi_red_get(LAS unsigned char* lds, int slot, int row) {
    const LAS f32x4* red = (const LAS f32x4*)(lds + EPI_RED_OFF) + slot * 256; const f32x4 v = red[row]; return (v[0] + v[1]) + (v[2] + v[3]);
}

template <int MODE> struct Epi {
    EP p;
    __device__ __forceinline__ void operator()(const pg8::Acc& acc, const pg8::GUnit& u, int wr, int wc, int fr, int fq) const {
        unsigned char* ws = p.ws;
        float* fsm = (float*)(ws + WS_FSM);
#ifdef PROBE
        if (p.dry == 1) {
#pragma unroll
            for (int a = 0; a < 2; ++a)
#pragma unroll
                for (int b = 0; b < 2; ++b)
#pragma unroll
                    for (int m = 0; m < 4; ++m) asm volatile("" :: "v"(acc[a][b][m][0]), "v"(acc[a][b][m][1]));
            return; }
#endif
        const int rt0 = wr * 64 + fr;
        const int ct0 = wc * 32 + 8 * fq;
        if constexpr (MODE == M_INPROJ) {
            const int pn = u.pn;
            if (pn >= 20 && pn < 36) {
                bf16_t* base = (bf16_t*)(ws + WS_ZGG) + (pn - 20) * 128 + ct0;
#pragma unroll
                for (int ai = 0; ai < 2; ++ai)
#pragma unroll
                    for (int m = 0; m < 4; ++m) {
                        const int row = u.pm * 256 + rt0 + ai * 128 + m * 16;
                        f32x4 o0, o1;
#pragma unroll
                        for (int i = 0; i < 4; ++i) { const float g0 = acc[ai][0][m][0][i], g1 = acc[ai][0][m][1][i], x0 = acc[ai][1][m][0][i], x1 = acc[ai][1][m][1][i];
                            o0[i] = sigmoidf_(g0) * x0 * sigmoidf_(x0); o1[i] = sigmoidf_(g1) * x1 * sigmoidf_(x1); }
                        *(u32x4*)(base + (size_t)row * 2048) = pack8(o0, o1);
                    }
            } else {
            bf16_t* base; int ld;
            if (pn < 4) { base = (bf16_t*)(ws + WS_ZL) + pn * 256; ld = 1024; }
            else if (pn < 12) { base = (bf16_t*)(ws + WS_ZQK) + (pn - 4) * 256; ld = 2048; }
            else if (pn < 20) { base = (bf16_t*)(ws + WS_ZV) + (pn - 12) * 256; ld = 2048; }
            else if (pn < 44) { base = (bf16_t*)(ws + WS_ZGM) + (pn - 36) * 256; ld = 2048; }
            else { base = (bf16_t*)(ws + WS_ZM); ld = 256; }
            float part[2][4];
#pragma unroll
            for (int ai = 0; ai < 2; ++ai)
#pragma unroll
                for (int m = 0; m < 4; ++m) {
                    const int row = u.pm * 256 + rt0 + ai * 128 + m * 16;
                    bf16_t* rowp = base + (size_t)row * ld + ct0;
                    *(u32x4*)(rowp) = pack8(acc[ai][0][m][0], acc[ai][0][m][1]);
                    *(u32x4*)(rowp + 128) = pack8(acc[ai][1][m][0], acc[ai][1][m][1]);
                    part[ai][m] = red_fq(sumsq8(acc[ai][0][m][0], acc[ai][0][m][1]) + sumsq8(acc[ai][1][m][0], acc[ai][1][m][1]));
                }
            if (pn < 4) {
                epi_red_put(p.lds, 0, part, rt0, wc, fq); epi_red_sync();
                const int tid = (wr * 4 + wc) * 64 + fq * 16 + fr;
                if (tid < 256) fsm[(pn < 2 ? F_SSQ_QL : F_SSQ_KV) + (size_t)(u.pm * 256 + tid) * 2 + (pn & 1)] = epi_red_get(p.lds, 0, tid);
            }
            }
        } else if constexpr (MODE == M_QUP) {
            bf16_t* Qp = (bf16_t*)(ws + WS_R1);
            float* ssq = (float*)((char*)(p.out + O_Y) + 56 * MiB);
#pragma unroll
            for (int bj = 0; bj < 2; ++bj) {
                const int c = u.pn * 256 + bj * 128 + ct0, h = c / 192, j = c - h * 192;
                const int grp = u.pn * 8 + bj * 4 + wc;
#pragma unroll
                for (int ai = 0; ai < 2; ++ai)
#pragma unroll
                    for (int m = 0; m < 4; ++m) {
                        const int row = u.pm * 256 + rt0 + ai * 128 + m * 16;
                        st16(Qp + ((size_t)h * NTOK + row) * 192 + j, pack8(acc[ai][bj][m][0], acc[ai][bj][m][1]));
                        float s = red_fq(sumsq8(acc[ai][bj][m][0], acc[ai][bj][m][1]));
                        if (fq == 0) ssq[(size_t)row * 96 + grp] = s;
                    }
            }
        } else if constexpr (MODE == M_KVUP) {
            bf16_t* Kp = (bf16_t*)(p.out + O_Y); bf16_t* Vp = (bf16_t*)(ws + WS_R2);
            const float* ssq_kv = fsm + F_SSQ_KV; const bf16_t* ZM = (const bf16_t*)(ws + WS_ZM);
            const int h = u.pn, tid = (wr * 4 + wc) * 64 + fq * 16 + fr; float part[2][4], invr[2][4];
            { f32x2 sq[2][4];
#pragma unroll
              for (int ai = 0; ai < 2; ++ai)
#pragma unroll
                  for (int m = 0; m < 4; ++m) sq[ai][m] = *(const f32x2*)(ssq_kv + (size_t)(u.pm * 256 + rt0 + ai * 128 + m * 16) * 2);
              asm volatile("" ::: "memory");
#pragma unroll
              for (int ai = 0; ai < 2; ++ai)
#pragma unroll
                  for (int m = 0; m < 4; ++m) invr[ai][m] = rsqrtf((sq[ai][m][0] + sq[ai][m][1]) * (1.f / 512.f) + EPS); }
#pragma unroll
            for (int ai = 0; ai < 2; ++ai)
#pragma unroll
                for (int m = 0; m < 4; ++m) {
                    const int row = u.pm * 256 + rt0 + ai * 128 + m * 16;
                    const float inv = invr[ai][m];
                    if (row < SEQ) *(u32x4*)(Vp + ((size_t)h * SEQ + row) * 128 + ct0) = pack8(acc[ai][1][m][0] * inv, acc[ai][1][m][1] * inv);
                    part[ai][m] = red_fq(sumsq8(acc[ai][0][m][0], acc[ai][0][m][1])) * inv * inv;
                }
            epi_red_put(p.lds, 0, part, rt0, wc, fq);
            LAS float* invk_s = (LAS float*)(p.lds + EPI_RED_OFF + 8192);
            u32x4 kr[8]; const int krow = u.pm * 256 + (tid & 255);
            if (tid < 256) {
#pragma unroll
                for (int i = 0; i < 8; ++i) kr[i] = *(const u32x4*)(ZM + (size_t)krow * 256 + i * 8);
            }
            epi_red_sync();
            if (tid < 256) {
                float x[64];
#pragma unroll
                for (int i = 0; i < 8; ++i) { x[8 * i] = bflo(kr[i].x); x[8 * i + 1] = bfhi(kr[i].x); x[8 * i + 2] = bflo(kr[i].y); x[8 * i + 3] = bfhi(kr[i].y);
                    x[8 * i + 4] = bflo(kr[i].z); x[8 * i + 5] = bfhi(kr[i].z); x[8 * i + 6] = bflo(kr[i].w); x[8 * i + 7] = bfhi(kr[i].w); }
                float krss = 0.f;
#pragma unroll
                for (int i = 0; i < 64; ++i) krss += x[i] * x[i];
                const float invk = rsqrtf((epi_red_get(p.lds, 0, tid) + krss) * (1.f / 192.f) + EPS);
                invk_s[tid] = invk;
                if (krow >= SEQ) { const int r_ = krow - SEQ; fsm[F_KNSS_C + ((size_t)(r_ >> 4) * 16 + h) * NKP + PAST + (r_ & 15)] = invk; }
                if (krow < SEQ) {
                    const float* cs = fsm + F_ROPE + (size_t)krow * 64; const float* gqr = p.gqr; const float* gkr = p.gkr;
                    bf16_t* kd = Kp + ((size_t)h * SEQ + krow) * 192 + 128;
#pragma unroll
                    for (int i8 = 0; i8 < 4; ++i8) { float y1[8], y2[8];
#pragma unroll
                        for (int j = 0; j < 8; ++j) { const int i = i8 * 8 + j; const float c = cs[i], sn = cs[32 + i], g = gqr[i] * gkr[i] * invk;
                            y1[j] = (x[i] * c - x[32 + i] * sn) * g; y2[j] = (x[32 + i] * c + x[i] * sn) * g; }
                        *(u32x4*)(kd + i8 * 8) = (u32x4){cvt_pk_bf16(y1[0], y1[1]), cvt_pk_bf16(y1[2], y1[3]), cvt_pk_bf16(y1[4], y1[5]), cvt_pk_bf16(y1[6], y1[7])};
                        *(u32x4*)(kd + 32 + i8 * 8) = (u32x4){cvt_pk_bf16(y2[0], y2[1]), cvt_pk_bf16(y2[2], y2[3]), cvt_pk_bf16(y2[4], y2[5]), cvt_pk_bf16(y2[6], y2[7])}; }
                }
            }
            epi_red_sync();
            if (u.pm < 32) {
                const f32x4 g0 = *(const f32x4*)(p.gqn + ct0) * *(const f32x4*)(p.gkn + ct0), g1 = *(const f32x4*)(p.gqn + ct0 + 4) * *(const f32x4*)(p.gkn + ct0 + 4);
#pragma unroll
                for (int ai = 0; ai < 2; ++ai)
#pragma unroll
                    for (int m = 0; m < 4; ++m) {
                        const int rt = rt0 + ai * 128 + m * 16; const float ik = invk_s[rt] * invr[ai][m];
                        *(u32x4*)(Kp + ((size_t)h * SEQ + u.pm * 256 + rt) * 192 + ct0) = pack8(acc[ai][0][m][0] * ik * g0, acc[ai][0][m][1] * ik * g1);
                    }
            }
        } else if constexpr (MODE == M_CNORM) {
            float* knss = fsm + F_KNSS_C; float part[2][2][4];
#pragma unroll
            for (int bj = 0; bj < 2; ++bj)
#pragma unroll
                for (int ai = 0; ai < 2; ++ai)
#pragma unroll
                    for (int m = 0; m < 4; ++m) part[bj][ai][m] = red_fq(sumsq8(acc[ai][bj][m][0], acc[ai][bj][m][1]));
            epi_red_put(p.lds, 0, part[0], rt0, wc, fq); epi_red_put(p.lds, 1, part[1], rt0, wc, fq); epi_red_sync();
            { const int tid = (wr * 4 + wc) * 64 + fq * 16 + fr, row = tid & 255, bj = tid >> 8; const int R = u.pm * 256 + row, b = R / NKP, k = R - b * NKP, h = u.pn * 2 + bj;
              knss[((size_t)b * 16 + h) * NKP + k] = rsqrtf((epi_red_get(p.lds, bj, row) + fsm[F_KRSS_C + R]) * (1.f / 192.f) + EPS); }
        } else if constexpr (MODE == M_QABS) {
            bf16_t* Qcat = (bf16_t*)(p.out + O_Y) + 48 * MiB / 2;
            const int h = u.aux;
#pragma unroll
            for (int ai = 0; ai < 2; ++ai)
#pragma unroll
                for (int m = 0; m < 4; ++m) {
                    const int r = rt0 + ai * 128 + m * 16, b = r >> 4, q = r & 15;
                    bf16_t* rowp = Qcat + ((size_t)b * 256 + h * 16 + q) * DQC + u.pn * 256 + ct0;
                    *(u32x4*)(rowp) = pack8(acc[ai][0][m][0], acc[ai][0][m][1]);
                    *(u32x4*)(rowp + 128) = pack8(acc[ai][1][m][0], acc[ai][1][m][1]);
                }
        } else if constexpr (MODE == M_S) {
            bf16_t* Pb = (bf16_t*)(p.out + O_Y); const float* invk_t = fsm + F_KNSS_C; const int b = u.aux; float part[2][4];
#pragma unroll
            for (int ai = 0; ai < 2; ++ai) {
                f32x4 ia[4][2], ib[4][2];
#pragma unroll
                for (int m = 0; m < 4; ++m) { const int h = (rt0 + ai * 128 + m * 16) >> 4;
#pragma unroll
                    for (int bj = 0; bj < 2; ++bj) { const float* ik = invk_t + ((size_t)b * 16 + h) * NKP + u.pn * 256 + bj * 128 + ct0; ia[m][bj] = *(const f32x4*)ik; ib[m][bj] = *(const f32x4*)(ik + 4); } }
                asm volatile("" ::: "memory");
#pragma unroll
                for (int m = 0; m < 4; ++m) {
                    const int r = rt0 + ai * 128 + m * 16; float s_ = 0.f;
#pragma unroll
                    for (int bj = 0; bj < 2; ++bj) {
                        const int k = u.pn * 256 + bj * 128 + ct0; const f32x4 i0 = ia[m][bj], i1 = ib[m][bj];
                        f32x4 o0, o1;
#pragma unroll
                        for (int i = 0; i < 4; ++i) { o0[i] = (k + i < NKEY) ? __builtin_amdgcn_exp2f(acc[ai][bj][m][0][i] * i0[i]) : 0.f; o1[i] = (k + 4 + i < NKEY) ? __builtin_amdgcn_exp2f(acc[ai][bj][m][1][i] * i1[i]) : 0.f; }
                        *(u32x4*)(Pb + ((size_t)b * 256 + r) * NKP + k) = pack8(o0, o1);
                        s_ += ((o0[0] + o0[1]) + (o0[2] + o0[3])) + ((o1[0] + o1[1]) + (o1[2] + o1[3]));
                    }
                    part[ai][m] = red_fq(s_);
                }
            }
            epi_red_put(p.lds, 0, part, rt0, wc, fq); epi_red_sync();
            { const int tid = (wr * 4 + wc) * 64 + fq * 16 + fr; if (tid < 256) fsm[F_SSQ_K + ((size_t)b * 256 + tid) * 9 + u.pn] = epi_red_get(p.lds, 0, tid); }
        } else if constexpr (MODE == M_PC) {
            float* PCp = (float*)(ws + WS_R5);
            const int b = u.aux >> 2, ks = u.aux & 3;
#pragma unroll
            for (int ai = 0; ai < 2; ++ai)
#pragma unroll
                for (int m = 0; m < 4; ++m) {
                    const int r = rt0 + ai * 128 + m * 16, h = r >> 4, q = r & 15;
                    float* rowp = PCp + (((size_t)ks * 16 + h) * 256 + b * 16 + q) * 512 + u.pn * 256 + ct0;
#pragma unroll
                    for (int bj = 0; bj < 2; ++bj) { *(f32x4*)(rowp + bj * 128) = acc[ai][bj][m][0]; *(f32x4*)(rowp + bj * 128 + 4) = acc[ai][bj][m][1]; }
                }
        } else if constexpr (MODE == M_O) {
            bf16_t* Zgm = (bf16_t*)(ws + WS_ZGM);
            const int h = u.aux, bj = h & 1;
            u32x4 g8[2][4];
#pragma unroll
            for (int ai = 0; ai < 2; ++ai)
#pragma unroll
                for (int m = 0; m < 4; ++m) g8[ai][m] = *(const u32x4*)(Zgm + (size_t)(SEQ + rt0 + ai * 128 + m * 16) * 2048 + h * 128 + ct0);
            asm volatile("" ::: "memory");
#pragma unroll
            for (int ai = 0; ai < 2; ++ai)
#pragma unroll
                for (int m = 0; m < 4; ++m) {
                    const int r = rt0 + ai * 128 + m * 16;
                    bf16_t* gp = Zgm + (size_t)(SEQ + r) * 2048 + h * 128 + ct0;
                    const u32x4 g = g8[ai][m];
                    const f32x4 a0 = bj ? acc[ai][1][m][0] : acc[ai][0][m][0], a1 = bj ? acc[ai][1][m][1] : acc[ai][0][m][1];
                    f32x4 o0, o1;
                    o0[0] = a0[0] * sigmoidf_(bflo(g.x)); o0[1] = a0[1] * sigmoidf_(bfhi(g.x)); o0[2] = a0[2] * sigmoidf_(bflo(g.y)); o0[3] = a0[3] * sigmoidf_(bfhi(g.y));
                    o1[0] = a1[0] * sigmoidf_(bflo(g.z)); o1[1] = a1[1] * sigmoidf_(bfhi(g.z)); o1[2] = a1[2] * sigmoidf_(bflo(g.w)); o1[3] = a1[3] * sigmoidf_(bfhi(g.w));
                    *(u32x4*)gp = pack8(o0, o1);
                }
        } else if constexpr (MODE == M_GLA_A) {
          if (u.aux < 128) {
            bf16_t* Am = (bf16_t*)(ws + WS_ZQK) + (size_t)u.aux * 65536;
#pragma unroll
            for (int ai = 0; ai < 2; ++ai)
#pragma unroll
                for (int m = 0; m < 4; ++m) {
                    const int t = rt0 + ai * 128 + m * 16;
#pragma unroll
                    for (int bj = 0; bj < 2; ++bj) {
                        const int s0 = bj * 128 + ct0;
                        f32x4 a0 = acc[ai][bj][m][0], a1 = acc[ai][bj][m][1];
#pragma unroll
                        for (int i = 0; i < 4; ++i) { if (s0 + i > t) a0[i] = 0.f; if (s0 + 4 + i > t) a1[i] = 0.f; }
                        *(u32x4*)(Am + (size_t)t * 256 + s0) = pack8(a0, a1);
                        asm volatile("" ::: "memory");
                    }
                }
          } else {
            bf16_t* dS = (bf16_t*)(ws + WS_R1) + (size_t)(u.aux - 128) * 131072;
#pragma unroll
            for (int ai = 0; ai < 2; ++ai)
#pragma unroll
                for (int m = 0; m < 4; ++m) {
                    const int e = u.pm * 256 + rt0 + ai * 128 + m * 16;
                    bf16_t* rowp = dS + (size_t)e * 256 + ct0;
                    *(u32x4*)(rowp) = pack8(acc[ai][0][m][0], acc[ai][0][m][1]);
                    *(u32x4*)(rowp + 128) = pack8(acc[ai][1][m][0], acc[ai][1][m][1]);
                }
          }
        } else if constexpr (MODE == M_GLA_O) {
            bf16_t* Zv = (bf16_t*)(ws + WS_ZV); float* ssq = fsm + F_SSQ_OG;
            const bool second = (u.aux & 128) != 0; const int hc = u.aux & 127, h = hc >> 5, c = hc & 31; float part[2][4];
#pragma unroll
            for (int ai = 0; ai < 2; ++ai) {
                u32x4 wa[4], wb[4];
                if (second) {
#pragma unroll
                    for (int m = 0; m < 4; ++m) { const bf16_t* rowp = Zv + (size_t)(c * 256 + rt0 + ai * 128 + m * 16) * 2048 + h * 512 + u.pn * 256 + ct0; wa[m] = *(const u32x4*)(rowp); wb[m] = *(const u32x4*)(rowp + 128); }
                } else {
#pragma unroll
                    for (int m = 0; m < 4; ++m) { wa[m] = (u32x4){0u, 0u, 0u, 0u}; wb[m] = wa[m]; }
                }
                asm volatile("" ::: "memory");
#pragma unroll
                for (int m = 0; m < 4; ++m) {
                    const int t = c * 256 + rt0 + ai * 128 + m * 16;
                    bf16_t* rowp = Zv + (size_t)t * 2048 + h * 512 + u.pn * 256 + ct0;
                    f32x4 a0 = acc[ai][0][m][0], a1 = acc[ai][0][m][1], b0 = acc[ai][1][m][0], b1 = acc[ai][1][m][1];
                    a0[0] += bflo(wa[m].x); a0[1] += bfhi(wa[m].x); a0[2] += bflo(wa[m].y); a0[3] += bfhi(wa[m].y); a1[0] += bflo(wa[m].z); a1[1] += bfhi(wa[m].z); a1[2] += bflo(wa[m].w); a1[3] += bfhi(wa[m].w);
                    b0[0] += bflo(wb[m].x); b0[1] += bfhi(wb[m].x); b0[2] += bflo(wb[m].y); b0[3] += bfhi(wb[m].y); b1[0] += bflo(wb[m].z); b1[1] += bfhi(wb[m].z); b1[2] += bflo(wb[m].w); b1[3] += bfhi(wb[m].w);
                    *(u32x4*)(rowp) = pack8(a0, a1);
                    *(u32x4*)(rowp + 128) = pack8(b0, b1);
                    part[ai][m] = red_fq(sumsq8(a0, a1) + sumsq8(b0, b1));
                }
            }
            if (second) {
                epi_red_put(p.lds, 0, part, rt0, wc, fq); epi_red_sync();
                const int tid = (wr * 4 + wc) * 64 + fq * 16 + fr; if (tid < 256) { float* q = ssq + ((size_t)(c * 256 + tid) * 4 + h) * 4 + u.pn; q[0] = epi_red_get(p.lds, 0, tid); q[2] = 0.f; }
            }
        } else if constexpr (MODE == M_WO) {
            bf16_t* x1b = (bf16_t*)(ws + WS_R2); float* ssq = fsm + F_SSQ_X1; float part[2][4];
#pragma unroll
            for (int ai = 0; ai < 2; ++ai) {
                f32x4 xa[4][2], xb[4][2];
#pragma unroll
                for (int m = 0; m < 4; ++m) { const int row = u.pm * 256 + rt0 + ai * 128 + m * 16;
                    const float* xr = (row < SEQ ? p.xp + (size_t)row * DM : p.xs + (size_t)(row - SEQ) * DM) + u.pn * 256 + ct0;
#pragma unroll
                    for (int bj = 0; bj < 2; ++bj) { xa[m][bj] = *(const f32x4*)(xr + bj * 128); xb[m][bj] = *(const f32x4*)(xr + bj * 128 + 4); } }
                asm volatile("" ::: "memory");
#pragma unroll
                for (int m = 0; m < 4; ++m) { const int row = u.pm * 256 + rt0 + ai * 128 + m * 16; float s_ = 0.f;
#pragma unroll
                    for (int bj = 0; bj < 2; ++bj) {
                        const f32x4 x0 = xa[m][bj] + acc[ai][bj][m][0], x1 = xb[m][bj] + acc[ai][bj][m][1];
                        st16(x1b + (size_t)row * DM + u.pn * 256 + bj * 128 + ct0, pack8(x0, x1));
                        s_ += sumsq8(x0, x1);
                    }
                    part[ai][m] = red_fq(s_); }
            }
            epi_red_put(p.lds, 0, part, rt0, wc, fq); epi_red_sync();
            { const int tid = (wr * 4 + wc) * 64 + fq * 16 + fr; if (tid < 256) ssq[(size_t)(u.pm * 256 + tid) * 8 + u.pn] = epi_red_get(p.lds, 0, tid); }
        } else if constexpr (MODE == M_UP) {
            bf16_t* Hb = (bf16_t*)(ws + WS_ZL); const float* ssq = fsm + F_SSQ_X1;
            f32x4 q0[2][4], q1[2][4];
#pragma unroll
            for (int ai = 0; ai < 2; ++ai)
#pragma unroll
                for (int m = 0; m < 4; ++m) { const int row = u.pm * 256 + rt0 + ai * 128 + m * 16; q0[ai][m] = *(const f32x4*)(ssq + (size_t)row * 8); q1[ai][m] = *(const f32x4*)(ssq + (size_t)row * 8 + 4); }
            asm volatile("" ::: "memory");
#pragma unroll
            for (int ai = 0; ai < 2; ++ai)
#pragma unroll
                for (int m = 0; m < 4; ++m) {
                    const int row = u.pm * 256 + rt0 + ai * 128 + m * 16;
                    const f32x4 a_ = q0[ai][m], b_ = q1[ai][m];
                    const float inv2 = 1.f / (((a_[0] + a_[1]) + (a_[2] + a_[3]) + (b_[0] + b_[1]) + (b_[2] + b_[3])) * (1.f / 2048.f) + EPS);
#pragma unroll
                    for (int bj = 0; bj < 2; ++bj) {
                        f32x4 a0 = acc[ai][bj][m][0], a1 = acc[ai][bj][m][1];
#pragma unroll
                        for (int i = 0; i < 4; ++i) { const float r0 = fmaxf(a0[i], 0.f), r1 = fmaxf(a1[i], 0.f); a0[i] = r0 * r0 * inv2; a1[i] = r1 * r1 * inv2; }
                        st16(Hb + (size_t)row * DFF + u.pn * 256 + bj * 128 + ct0, pack8(a0, a1));
                    }
                }
        } else if constexpr (MODE == M_DOWN) {
            float* Y = p.out + O_Y; const bf16_t* x1b = (const bf16_t*)(ws + WS_R2);
#pragma unroll
            for (int ai = 0; ai < 2; ++ai) {
                u32x4 w[4][2];
#pragma unroll
                for (int m = 0; m < 4; ++m)
#pragma unroll
                    for (int bj = 0; bj < 2; ++bj) w[m][bj] = *(const u32x4*)(x1b + (size_t)(u.pm * 256 + rt0 + ai * 128 + m * 16) * DM + u.pn * 256 + bj * 128 + ct0);
                asm volatile("" ::: "memory");
#pragma unroll
                for (int m = 0; m < 4; ++m)
#pragma unroll
                    for (int bj = 0; bj < 2; ++bj) {
                        const size_t e = (size_t)(u.pm * 256 + rt0 + ai * 128 + m * 16) * DM + u.pn * 256 + bj * 128 + ct0; const u32x4 w_ = w[m][bj];
                        f32x4 y0 = acc[ai][bj][m][0], y1 = acc[ai][bj][m][1];
                        y0[0] += bflo(w_.x); y0[1] += bfhi(w_.x); y0[2] += bflo(w_.y); y0[3] += bfhi(w_.y); y1[0] += bflo(w_.z); y1[1] += bfhi(w_.z); y1[2] += bflo(w_.w); y1[3] += bfhi(w_.w);
                        *(f32x4*)(Y + e) = y0; *(f32x4*)(Y + e + 4) = y1;
                    }
            }
        } else if constexpr (MODE == M_WO_S || MODE == M_UP_S || MODE == M_DOWN_S) {
            constexpr int ld = (MODE == M_UP_S) ? DFF : DM;
            float* slab = (float*)(ws + (MODE == M_UP_S ? WS_R5 : WS_R4)) + (size_t)u.aux * 256 * ld;
#pragma unroll
            for (int ai = 0; ai < 2; ++ai)
#pragma unroll
                for (int m = 0; m < 4; ++m) {
                    float* rowp = slab + (size_t)(rt0 + ai * 128 + m * 16) * ld + u.pn * 256 + ct0;
#pragma unroll
                    for (int bj = 0; bj < 2; ++bj) { *(f32x4*)(rowp + bj * 128) = acc[ai][bj][m][0]; *(f32x4*)(rowp + bj * 128 + 4) = acc[ai][bj][m][1]; }
                }
        }
    }
};

template <int MODE> struct Sched {
    unsigned char* ws; float* out; int G, c, n;
    __device__ __forceinline__ bool next(int i, pg8::GUnit& u) const {
        int L = i * G + c;
        if constexpr (MODE == M_GLA_O) { const int j = (i >> 1) * G + c; if (j >= 256) return false; L = j + 256 * (i & 1); }
        else { if (L >= n) return false; }
        u.aux = 0;
        if constexpr (MODE == M_INPROJ) {
            pg8::tile_of(L, 33, 45, u.pm, u.pn);
            u.A = (const char*)(ws + WS_R2) + (size_t)u.pm * 256 * 4096; u.B = (const char*)(ws + WS_R1) + (size_t)u.pn * 256 * 4096;
        } else if constexpr (MODE == M_QUP) {
            pg8::tile_of(L, 33, 12, u.pm, u.pn);
            u.A = (const char*)(ws + WS_ZL) + (size_t)u.pm * 256 * 2048; u.B = (const char*)(ws + WS_WSM) + (W_UQ + (size_t)u.pn * 256 * 512) * 2;
        } else if constexpr (MODE == M_KVUP) {
            pg8::tile_of(L, 33, 16, u.pm, u.pn);
            u.A = (const char*)(ws + WS_ZL) + (size_t)u.pm * 256 * 2048 + 1024; u.B = (const char*)(ws + WS_WSM) + (W_UKVG + (size_t)u.pn * 256 * 512) * 2;
        } else if constexpr (MODE == M_CNORM) {
            pg8::tile_of(L, 128, 8, u.pm, u.pn); u.pm = (u.pm >> 3) * 9 + (u.pm & 7);
            u.A = (const char*)(ws + WS_R3) + (size_t)u.pm * 256 * (DQC * 2); u.B = (const char*)(ws + WS_WSM) + (W_KNP + (size_t)u.pn * 256 * 512) * 2;
        } else if constexpr (MODE == M_QABS) {
            const int h = L >> 1; u.pm = 0; u.pn = L & 1; u.aux = h;
            u.A = (const char*)(out + O_Y) + 53 * MiB + (size_t)h * 256 * 512; u.B = (const char*)(ws + WS_WSM) + (W_KNABS + ((size_t)h * 512 + u.pn * 256) * 256) * 2;
        } else if constexpr (MODE == M_S) {
            const int b = L / 9; u.pm = 0; u.pn = L - b * 9; u.aux = b;
            u.A = (const char*)(out + O_Y) + 48 * MiB + (size_t)b * 256 * (DQC * 2); u.B = (const char*)(ws + WS_R3) + ((size_t)b * NKP + u.pn * 256) * (DQC * 2);
        } else if constexpr (MODE == M_PC) {
            const int b = L / 6, r = L - b * 6, ks = r >> 1; u.pm = 0; u.pn = r & 1; u.aux = b * 4 + ks;
            u.A = (const char*)(out + O_Y) + ((size_t)b * 256 * NKP + ks * 768) * 2; u.B = (const char*)(ws + WS_R4) + (((size_t)b * 512 + u.pn * 256) * NKP + ks * 768) * 2;
        } else if constexpr (MODE == M_O) {
            const int h = L; u.pm = 0; u.pn = 0; u.aux = h;
            u.A = (const char*)(ws + WS_ZQK) + 16 * MiB + (size_t)h * 256 * 1024; u.B = (const char*)(ws + WS_WSM) + (W_VP + (size_t)(h & ~1) * 128 * 512) * 2;
        } else if constexpr (MODE == M_GLA_A) {
            if (L < 128) { u.pm = 0; u.pn = 0; u.aux = L;
                u.A = (const char*)(ws + WS_ZOG) + (size_t)L * 131072; u.B = (const char*)(ws + WS_R5) + (size_t)L * 131072;
            } else { const int l2 = L - 128, hc = l2 >> 1; u.pm = l2 & 1; u.pn = 0; u.aux = 128 + hc;
                u.A = (const char*)(out + O_STS) + ((size_t)hc * 512 + u.pm * 256) * 512; u.B = (const char*)(ws + WS_R5) + 16 * MiB + (size_t)hc * 131072; }
        } else if constexpr (MODE == M_GLA_O) {
            const int second = L >= 256, l2 = L & 255, hc = l2 >> 1; u.pm = 0; u.pn = l2 & 1; u.aux = hc | (second ? 128 : 0);
            if (!second) { u.A = (const char*)(ws + WS_ZQK) + (size_t)hc * 131072; u.B = (const char*)(out + O_STS) + ((size_t)hc * 512 + u.pn * 256) * 512; }
            else { u.A = (const char*)(ws + WS_ZOG) + (size_t)hc * 131072; u.B = (const char*)(ws + WS_R2) + ((size_t)hc * 512 + u.pn * 256) * 512; }
        } else if constexpr (MODE == M_WO) {
            pg8::tile_of(L, 32, 8, u.pm, u.pn);
            u.A = (const char*)(ws + WS_ZOG) + (size_t)u.pm * 256 * 4096; u.B = (const char*)(ws + WS_WSM) + (W_O + (size_t)u.pn * 256 * 2048) * 2;
        } else if constexpr (MODE == M_UP) {
            pg8::tile_of(L, 32, 32, u.pm, u.pn);
            u.A = (const char*)(ws + WS_R2) + (size_t)u.pm * 256 * 4096; u.B = (const char*)(out + O_Y) + 20 * MiB + (size_t)u.pn * 256 * 4096;
        } else if constexpr (MODE == M_DOWN) {
            pg8::tile_of(L, 32, 8, u.pm, u.pn);
            u.A = (const char*)(ws + WS_ZL) + (size_t)u.pm * 256 * 16384; u.B = (const char*)(ws + WS_R3) + (size_t)u.pn * 256 * 16384;
        } else if constexpr (MODE == M_WO_S) {
            u.pm = 0; u.pn = L & 7; u.aux = L >> 3;
            u.A = (const char*)(ws + WS_ZOG) + (size_t)SEQ * 4096 + u.aux * 512; u.B = (const char*)(ws + WS_WSM) + (W_O + (size_t)u.pn * 256 * 2048) * 2 + u.aux * 512;
        } else if constexpr (MODE == M_UP_S) {
            u.pm = 0; u.pn = L & 31; u.aux = L >> 5;
            u.A = (const char*)(ws + WS_R2) + (size_t)SEQ * 4096 + u.aux * 1024; u.B = (const char*)(out + O_Y) + 20 * MiB + (size_t)u.pn * 256 * 4096 + u.aux * 1024;
        } else if constexpr (MODE == M_DOWN_S) {
            u.pm = 0; u.pn = L & 7; u.aux = L >> 3;
            u.A = (const char*)(ws + WS_ZL) + (size_t)SEQ * 16384 + u.aux * 1024; u.B = (const char*)(ws + WS_R3) + (size_t)u.pn * 256 * 16384 + u.aux * 1024;
        }
        return true;
    }
};

#ifndef STAG_TICKS
#define STAG_TICKS 0
#endif
template <int MODE>
__device__ __forceinline__ void run_gemm_cg(Frame& F, const EP& ep, int c, int stride, int n_units, unsigned lda, unsigned ldb, int nt) {
    Sched<MODE> S; S.ws = F.ws; S.out = F.out; S.G = stride; S.c = c; S.n = n_units;
    Epi<MODE> E; E.p = ep;
    pg8::GCfg g; g.lda = lda; g.ldb = ldb; g.nt = nt; g.t1 = nt;
    pg8::gemm_phase<Epi<MODE>, Sched<MODE>>(F.lds, g, S, E, F.wave);
}
template <int MODE>
__device__ __forceinline__ void run_gemm(Frame& F, const EP& ep, int n_units, unsigned lda, unsigned ldb, int nt, int t1, int& rot, int stag = 0) {
    if (stag && STAG_TICKS) {
        const unsigned long long t0 = __builtin_amdgcn_s_memrealtime(); const unsigned long long wait = (unsigned long long)((F.vcu & 3) * STAG_TICKS);
        while (__builtin_amdgcn_s_memrealtime() - t0 < wait) __builtin_amdgcn_s_sleep(8);
    }
    Sched<MODE> S; S.ws = F.ws; S.out = F.out; S.G = F.G; S.c = (F.vcu + F.G - rot) % F.G; S.n = n_units;
    Epi<MODE> E; E.p = ep;
    pg8::GCfg g; g.lda = lda; g.ldb = ldb; g.nt = nt; g.t1 = t1;
    pg8::gemm_phase<Epi<MODE>, Sched<MODE>>(F.lds, g, S, E, F.wave);
    rot = (rot + n_units) % F.G;
}

namespace att {
constexpr int NW = 8, QBLK = 32, KVBLK = 64, QB = 256;
constexpr int SHM_V = KVBLK * 128 * 2, SHM_K = KVBLK * 192 * 2;
constexpr int NBUF = 3;
constexpr int LDS_ATT = NBUF * SHM_V + NBUF * SHM_K + NW * 64 * 4;
constexpr float THR = 8.f;
#define KSWZ(row, colB) ((row) * 384 + ((colB) ^ ((((row) >> 1) & 7) << 4)))
#define SBAR() __builtin_amdgcn_sched_barrier(0)
__device__ __forceinline__ int v_st(int k, int c) { const int kk = (k & ~0xC) | ((k & 4) << 1) | ((k & 8) >> 1); return ((kk >> 3) * 4 + (c >> 5)) * 512 + ((kk & 7) * 32 + (c & 31)) * 2; }
__device__ __forceinline__ int v_rd_base(int lane) { return ((lane & 3) << 3) | (((lane >> 2) & 3) << 6) | (((lane >> 4) & 1) << 5) | (((lane >> 5) & 1) << 8); }
constexpr int v_rd_off(int d0, int ks, int half) { return d0 * 512 + ks * 4096 + half * 2048; }
__device__ __forceinline__ int crow(int r, int hi) { return (r & 3) + 8 * (r >> 2) + 4 * hi; }
__device__ __forceinline__ unsigned cvtpk(float lo, float hi) { unsigned r; asm volatile("v_cvt_pk_bf16_f32 %0, %1, %2" : "=v"(r) : "v"(lo), "v"(hi)); return r; }

__device__ __forceinline__ void partialSM(f32x16& p0, f32x16& p1, float& m_reg, float& mn, float& alpha) {
    mn = 0.f; alpha = 1.f;
#pragma unroll
    for (int r = 0; r < 16; ++r) p0[r] = __builtin_amdgcn_exp2f(p0[r]);
}
__device__ __forceinline__ void finishSM(f32x16& p0, f32x16& p1, float alpha, float& l_reg, bf16x8& pa0, bf16x8& pa1, bf16x8& pa2, bf16x8& pa3) {
#pragma unroll
    for (int r = 0; r < 16; ++r) p1[r] = __builtin_amdgcn_exp2f(p1[r]);
    float ps = 0;
#pragma unroll
    for (int r = 0; r < 16; ++r) ps += p0[r];
#pragma unroll
    for (int r = 0; r < 16; ++r) ps += p1[r];
    { auto rr = __builtin_amdgcn_permlane32_swap(__float_as_uint(ps), __float_as_uint(ps), false, false);
      ps = __uint_as_float(rr[0]) + __uint_as_float(rr[1]); }
    l_reg = l_reg * alpha + ps;
#define PK4(P, B_, OUT) do { unsigned a0 = cvtpk(P[B_+0], P[B_+1]), a1 = cvtpk(P[B_+2], P[B_+3]);                          \
        unsigned b0 = cvtpk(P[B_+4], P[B_+5]), b1 = cvtpk(P[B_+6], P[B_+7]);                                             \
        auto r0 = __builtin_amdgcn_permlane32_swap(a0, b0, false, false); auto r1 = __builtin_amdgcn_permlane32_swap(a1, b1, false, false); \
        u32x4 w = {r0[0], r1[0], r0[1], r1[1]}; OUT = *reinterpret_cast<bf16x8*>(&w); } while (0)
    PK4(p0, 0, pa0); PK4(p0, 8, pa1); PK4(p1, 0, pa2); PK4(p1, 8, pa3);
#undef PK4
}
__device__ __forceinline__ void qkt(int kboff, f32x16& p0, f32x16& p1, const char* K_lds, int r32, int hi, const bf16x8* qr) {
    p0 = f32x16{}; p1 = f32x16{};
    const char* kb[4];
#pragma unroll
    for (int dd = 0; dd < 4; ++dd) kb[dd] = K_lds + kboff + KSWZ(r32, (dd * 16 + hi * 8) * 2);
#pragma unroll
    for (int d0 = 0; d0 < 12; ++d0) { const char* a = kb[d0 & 3] + (d0 >> 2) * 128;
        bf16x8 b0 = *reinterpret_cast<const bf16x8*>(a);
        bf16x8 b1 = *reinterpret_cast<const bf16x8*>(a + 32 * 384);
        p0 = __builtin_amdgcn_mfma_f32_32x32x16_bf16(b0, qr[d0], p0, 0, 0, 0);
        p1 = __builtin_amdgcn_mfma_f32_32x32x16_bf16(b1, qr[d0], p1, 0, 0, 0); }
}
__device__ __forceinline__ void pv_tile(f32x16* o, int vb0, bf16x8 pa0, bf16x8 pa1, bf16x8 pa2, bf16x8 pa3) {
#define TRRD(dst, off) asm volatile("ds_read_b64_tr_b16 %0, %1 offset:%2" : "=&v"(dst) : "v"(vb0), "i"(off) : "memory")
#define PV_RD(L, H, d0) do { constexpr int b_ = v_rd_off(d0, 0, 0); TRRD(L[0], b_); TRRD(H[0], b_ + 2048); TRRD(L[1], b_ + 4096); TRRD(H[1], b_ + 6144); TRRD(L[2], b_ + 8192); TRRD(H[2], b_ + 10240); TRRD(L[3], b_ + 12288); TRRD(H[3], b_ + 14336); } while (0)
#define PV_FR(L, H, k) (bf16x8){L[k][0], L[k][1], L[k][2], L[k][3], H[k][0], H[k][1], H[k][2], H[k][3]}
#define PV_MM(L, H, d0) do { o[d0] = __builtin_amdgcn_mfma_f32_32x32x16_bf16(pa0, PV_FR(L, H, 0), o[d0], 0, 0, 0); o[d0] = __builtin_amdgcn_mfma_f32_32x32x16_bf16(pa1, PV_FR(L, H, 1), o[d0], 0, 0, 0); \
        o[d0] = __builtin_amdgcn_mfma_f32_32x32x16_bf16(pa2, PV_FR(L, H, 2), o[d0], 0, 0, 0); o[d0] = __builtin_amdgcn_mfma_f32_32x32x16_bf16(pa3, PV_FR(L, H, 3), o[d0], 0, 0, 0); } while (0)
    s16x4 la[4], ha[4], lb[4], hb[4];
    PV_RD(la, ha, 0);
    PV_RD(lb, hb, 1); asm volatile("s_waitcnt lgkmcnt(8)" ::: "memory"); SBAR(); PV_MM(la, ha, 0); SBAR();
    PV_RD(la, ha, 2); asm volatile("s_waitcnt lgkmcnt(8)" ::: "memory"); SBAR(); PV_MM(lb, hb, 1); SBAR();
    PV_RD(lb, hb, 3); asm volatile("s_waitcnt lgkmcnt(8)" ::: "memory"); SBAR(); PV_MM(la, ha, 2); SBAR();
    asm volatile("s_waitcnt lgkmcnt(0)" ::: "memory"); SBAR(); PV_MM(lb, hb, 3);
#undef PV_MM
#undef PV_FR
#undef PV_RD
#undef TRRD
}

struct BlockRef { const bf16_t* Q; const bf16_t* K; const bf16_t* V; bf16_t* G; const float* fsm; const float* ssq_qg; int qb; int h; int dry; };
struct Seam { bf16x8 qr[12]; bf16x8 st_v0, st_v1, st_k0, st_k1, st_k2; };

#define VMW() asm volatile("s_waitcnt vmcnt(0)" ::: "memory")
#define VMWN(n) asm volatile("s_waitcnt vmcnt(%0)" :: "i"(n) : "memory")
#define LD8(p) (*reinterpret_cast<const bf16x8*>(p))
#define SLOAD_H(Kp, Vp, k0) do { S.st_v0 = LD8((Vp) + (size_t)((k0) + sr) * 128 + sc); S.st_v1 = LD8((Vp) + (size_t)((k0) + 32 + sr) * 128 + sc); \
        const bf16_t* kt_ = (Kp) + (size_t)(k0) * 192 + tid * 8; S.st_k0 = LD8(kt_); S.st_k1 = LD8(kt_ + 4096); S.st_k2 = LD8(kt_ + 8192); } while (0)
#define SWRITE_HK(bf) do { *(bf16x8*)(K_lds + (bf) * SHM_K + kw0) = S.st_k0; *(bf16x8*)(K_lds + (bf) * SHM_K + kw1) = S.st_k1; *(bf16x8*)(K_lds + (bf) * SHM_K + kw2) = S.st_k2; } while (0)
#define SWRITE_HV(bf) do { *(bf16x8*)(V_lds + (bf) * SHM_V + vst0) = S.st_v0; *(bf16x8*)(V_lds + (bf) * SHM_V + vst1) = S.st_v1; } while (0)
#define SWRITE_H(bf) do { SWRITE_HV(bf); SWRITE_HK(bf); } while (0)
#define KW_OFFS() const int g0_ = tid, g1_ = tid + 512, g2_ = tid + 1024; \
    const int kw0 = KSWZ(g0_ / 24, (g0_ % 24) * 16), kw1 = KSWZ(g1_ / 24, (g1_ % 24) * 16), kw2 = KSWZ(g2_ / 24, (g2_ % 24) * 16)

__device__ __forceinline__ void prime(const BlockRef& cur, char* lds, Seam& S, int wave) {
    int lane_ = lane_id_(); asm volatile("" : "+v"(lane_));
    const int tid = wave * 64 + lane_;
    const int sr = tid >> 4, sc = (tid & 15) * 8; char* K_lds = lds + NBUF * SHM_V;
    KW_OFFS();
    SLOAD_H(cur.K, cur.V, 0); VMW(); SWRITE_HK(0);
    __syncthreads();
}
__device__ __forceinline__ void block(const BlockRef& cur, const BlockRef& nxt, char* lds, Seam& S, int wave) {
    int lane_ = lane_id_(); asm volatile("" : "+v"(lane_));
    const int wid = wave, lane = lane_, tid = wid * 64 + lane, r32 = lane & 31, hi = lane >> 5;
    const int NT = 4 * cur.qb + 4;
    const int tmax = 4 * cur.qb + (wid >> 1);
    char* V_lds = lds; char* K_lds = lds + NBUF * SHM_V;
    float* wsf = (float*)(lds + NBUF * SHM_V + NBUF * SHM_K) + wid * 64; float* li_l = wsf, * al_l = wsf + 32;
    float m_reg = -1e30f, l_reg = 0; f32x16 o[4] = {};
    const int sr = tid >> 4, sc = (tid & 15) * 8, vst0 = v_st(sr, sc), vst1 = v_st(32 + sr, sc);
    KW_OFFS();
    const int vb0 = (int)(uintptr_t)V_lds + v_rd_base(lane);
    const bf16_t* Kh = cur.K; const bf16_t* Vh = cur.V;
#define RESC(a) do { if (__any((a) < 1.f)) { if (hi == 0) al_l[r32] = (a); asm volatile("s_waitcnt lgkmcnt(0)" ::: "memory");              \
                     _Pragma("unroll") for (int d_ = 0; d_ < 4; ++d_) _Pragma("unroll") for (int r = 0; r < 16; ++r) o[d_][r] *= al_l[crow(r, hi)]; } } while (0)
#define KBASE(t) ((t) * KVBLK)
#define MASKT(P0_, P1_, t) do { if ((t) > tmax) { const float NEG_ = -__builtin_inff(); _Pragma("unroll") for (int r = 0; r < 16; ++r) { P0_[r] = NEG_; P1_[r] = NEG_; } } } while (0)
    constexpr int NQL = 0;
#define SEAM_K0() do { VMWN(NQL); SWRITE_HK(0); SBAR(); } while (0)
    f32x16 pA0, pA1, pB0, pB1; float mnA, mnB, alA, alB; bf16x8 pa0, pa1, pa2, pa3;
    {
        const int t = cur.qb * QB + wid * QBLK + r32;
        const float* fsm = cur.fsm;
        const float al = rsqrtf((fsm[F_SSQ_QL + 2 * t] + fsm[F_SSQ_QL + 2 * t + 1]) * (1.f / 512.f) + EPS);
        const float* qg = cur.ssq_qg + (size_t)t * 96 + cur.h * 6;
        const float ssh = ((qg[0] + qg[1]) + (qg[2] + qg[3])) + (qg[4] + qg[5]);
        const float sc = al * rsqrtf(al * al * ssh * (1.f / 192.f) + EPS) * (MLA_SCALE * LOG2E);
        const bf16_t* qrow = cur.Q + (size_t)(wid * QBLK + r32) * 192 + hi * 8;
#define UNPK(src_, f) do { const u32x4 w_ = __builtin_bit_cast(u32x4, (src_)); f[0] = bflo(w_.x); f[1] = bfhi(w_.x); f[2] = bflo(w_.y); f[3] = bfhi(w_.y); f[4] = bflo(w_.z); f[5] = bfhi(w_.z); f[6] = bflo(w_.w); f[7] = bfhi(w_.w); } while (0)
#define REPK(f) __builtin_bit_cast(bf16x8, (u32x4){cvtpk(f[0], f[1]), cvtpk(f[2], f[3]), cvtpk(f[4], f[5]), cvtpk(f[6], f[7])})
#pragma unroll
        for (int d0 = 0; d0 < 8; ++d0) { float f[8]; UNPK(LD8(qrow + d0 * 16), f);
#pragma unroll
            for (int j = 0; j < 8; ++j) f[j] *= sc;
            S.qr[d0] = REPK(f); }
        const float* cs = fsm + F_ROPE + (size_t)t * 64;
#pragma unroll
        for (int dd = 0; dd < 2; ++dd) { float x1[8], x2[8], y1[8], y2[8]; UNPK(LD8(qrow + (8 + dd) * 16), x1); UNPK(LD8(qrow + (10 + dd) * 16), x2);
            const int i0 = dd * 16 + hi * 8;
#pragma unroll
            for (int j = 0; j < 8; ++j) { const float c = cs[i0 + j], sn = cs[32 + i0 + j]; y1[j] = (x1[j] * c - x2[j] * sn) * sc; y2[j] = (x2[j] * c + x1[j] * sn) * sc; }
            S.qr[8 + dd] = REPK(y1); S.qr[10 + dd] = REPK(y2); }
#undef UNPK
#undef REPK
    }
    SWRITE_HV(0); SBAR();
    SLOAD_H(Kh, Vh, KBASE(1));
    SBAR(); qkt(0, pA0, pA1, K_lds, r32, hi, S.qr);
    MASKT(pA0, pA1, 0); partialSM(pA0, pA1, m_reg, mnA, alA);
    VMW(); SWRITE_H(1);
    __syncthreads();
    int b_prev = 0, b_cur = 1, b_next = 2;
#define ROT3() do { const int t_ = b_prev; b_prev = b_cur; b_cur = b_next; b_next = t_; } while (0)
#define HALF_STEP(PX0, PX1, mnX, alX, PY0, PY1, alY, t) do {                                                      \
        SBAR(); qkt(b_cur * SHM_K, PX0, PX1, K_lds, r32, hi, S.qr);                                                          \
        finishSM(PY0, PY1, alY, l_reg, pa0, pa1, pa2, pa3); SBAR();                                                           \
        if ((t) + 1 < NT) { SLOAD_H(Kh, Vh, KBASE((t) + 1)); SBAR(); }                                               \
        pv_tile(o, vb0 + b_prev * SHM_V, pa0, pa1, pa2, pa3); MASKT(PX0, PX1, (t)); partialSM(PX0, PX1, m_reg, mnX, alX);                                        \
        if ((t) + 1 < NT) { VMW(); SWRITE_H(b_next); }                                                                          \
        RESC(alX); __syncthreads(); ROT3(); } while (0)
    for (int t = 1; t + 1 < NT; t += 2) {
        HALF_STEP(pB0, pB1, mnB, alB, pA0, pA1, alA, t);
        HALF_STEP(pA0, pA1, mnA, alA, pB0, pB1, alB, t + 1);
    }
    SBAR(); qkt(b_cur * SHM_K, pB0, pB1, K_lds, r32, hi, S.qr); SBAR();
    SLOAD_H(nxt.K, nxt.V, 0); SBAR();
    finishSM(pA0, pA1, alA, l_reg, pa0, pa1, pa2, pa3); SBAR();
    pv_tile(o, vb0 + b_prev * SHM_V, pa0, pa1, pa2, pa3);
    MASKT(pB0, pB1, NT - 1); partialSM(pB0, pB1, m_reg, mnB, alB); __syncthreads(); RESC(alB);
    finishSM(pB0, pB1, alB, l_reg, pa0, pa1, pa2, pa3); SBAR(); pv_tile(o, vb0 + b_cur * SHM_V, pa0, pa1, pa2, pa3);
    SBAR(); SEAM_K0();
    if (hi == 0) li_l[r32] = l_reg; asm volatile("s_waitcnt lgkmcnt(0)" ::: "memory");
    float rli[16];
#pragma unroll
    for (int r = 0; r < 16; ++r) rli[r] = __builtin_amdgcn_rcpf(li_l[crow(r, hi)]);
    bf16_t* Gw = cur.G + (size_t)(wid * QBLK) * 2048;
#pragma unroll
    for (int dp = 0; dp < 4; dp += 2) {
        bf16_t gt_[2][16];
#pragma unroll
        for (int dd = 0; dd < 2; ++dd)
#pragma unroll
            for (int r = 0; r < 16; ++r) gt_[dd][r] = Gw[(size_t)crow(r, hi) * 2048 + (dp + dd) * 32 + r32];
        asm volatile("" ::: "memory");
#pragma unroll
        for (int dd = 0; dd < 2; ++dd)
#pragma unroll
            for (int r = 0; r < 16; ++r) { const int d0 = dp + dd;
                bf16_t* gp = Gw + (size_t)crow(r, hi) * 2048 + d0 * 32 + r32;
                const float v = o[d0][r] * rli[r] * sigmoidf_(bf2f(gt_[dd][r]));
                const float vn = __shfl_xor(v, 1);
                if ((r32 & 1) == 0 && !cur.dry) *(unsigned*)gp = cvtpk(v, vn); }
        asm volatile("" ::: "memory");
    }
    __syncthreads();
#undef RESC
#undef KBASE
#undef MASKT
#undef SEAM_K0
#undef HALF_STEP
#undef ROT3
}
#undef VMW
#undef VMWN
#undef LD8
#undef SLOAD_H
#undef SWRITE_HK
#undef SWRITE_HV
#undef SWRITE_H
#undef KW_OFFS
#undef KSWZ
#undef SBAR
}

#define LDS_WAIT() asm volatile("s_waitcnt lgkmcnt(0)" ::: "memory")
__device__ __forceinline__ unsigned pk2(float lo, float hi) { return cvt_pk_bf16(lo, hi); }

__device__ __forceinline__ int lane_fresh_() { int l_ = lane_id_(); asm volatile("" : "+v"(l_)); return l_; }
struct TrDesc { const float* sp; size_t ldn; bf16_t* dp; size_t ldk; const float* ks; int valid; };
__device__ __forceinline__ TrDesc tr_desc(const float* src, size_t ldn, bf16_t* dst, size_t ldk, int k0, int ndst0, int srcn, const float* kscale, int lane) {
    lane = lane_id_();
    TrDesc d; d.sp = src + (size_t)(k0 + (lane >> 3)) * ldn + (srcn >= 0 ? srcn : 0); d.ldn = ldn; d.dp = dst + (size_t)(ndst0 + (lane >> 3)) * ldk + k0 + 8 * (lane & 7); d.ldk = ldk;
    d.ks = kscale ? kscale + k0 + (lane >> 3) : nullptr; d.valid = srcn >= 0; return d;
}
__device__ __forceinline__ void tr_load(const TrDesc& d, float (&v)[32]) {
#pragma unroll
    for (int j = 0; j < 8; ++j) { const f32x4 w = *(const f32x4*)(d.sp + (size_t)(8 * j) * d.ldn); v[4 * j] = w[0]; v[4 * j + 1] = w[1]; v[4 * j + 2] = w[2]; v[4 * j + 3] = w[3]; }
}
__device__ __forceinline__ void tr_finish(const TrDesc& d, float (&v)[32], LAS float* scr, int lane) {
    lane = lane_id_();
    if (d.ks) {
#pragma unroll
        for (int j = 0; j < 8; ++j) { const float g = d.ks[8 * j]; v[4 * j] *= g; v[4 * j + 1] *= g; v[4 * j + 2] *= g; v[4 * j + 3] *= g; }
    }
#pragma unroll
    for (int j = 0; j < 8; ++j)
#pragma unroll
        for (int e = 0; e < 4; ++e) scr[(8 * j + (lane >> 3)) * 33 + 4 * (lane & 7) + e] = d.valid ? v[4 * j + e] : 0.f;
    LDS_WAIT(); asm volatile("" ::: "memory");
    const int c = lane & 7;
#pragma unroll
    for (int j = 0; j < 4; ++j) { const int n = (lane >> 3) + 8 * j; const LAS float* s_ = scr + (8 * c) * 33 + n;
        u32x4 o; o.x = pk2(s_[0 * 33], s_[1 * 33]); o.y = pk2(s_[2 * 33], s_[3 * 33]); o.z = pk2(s_[4 * 33], s_[5 * 33]); o.w = pk2(s_[6 * 33], s_[7 * 33]);
        *(u32x4*)(d.dp + (size_t)(8 * j) * d.ldk) = o; }
    LDS_WAIT(); asm volatile("" ::: "memory");
}
template <class Dec>
__device__ __forceinline__ void tr_loop(int first, int n, int stride, const Dec& dec, LAS float* scr, int lane) {
    if (first >= n) return;
    float va[32], vb[32];
    TrDesc da = dec(first), db = da;
    tr_load(da, va);
    for (int it = first;; it += 2 * stride) {
        const bool hb = it + stride < n;
        if (hb) { db = dec(it + stride); tr_load(db, vb); }
        tr_finish(da, va, scr, lane);
        if (!hb) break;
        const bool ha = it + 2 * stride < n;
        if (ha) { da = dec(it + 2 * stride); tr_load(da, va); }
        tr_finish(db, vb, scr, lane);
        if (!ha) break;
    }
}
__device__ __forceinline__ int win_src(int n) {
    if (n < 1024) return n;
    if (n < 5120) return n + 64;
    if (n < 9216) { const int w = n - 5120, c = (w >> 8) * 128 + (w & 127); return (w & 128) ? 5200 + c : 9296 + c; }
    if (n < 11264) return 7248 + (n - 9216);
    const int lc = n - 11264;
    if (lc < 64) return 1024 + lc;
    if (lc < 80) return 5184 + (lc - 64);
    return -1;
}

__device__ __forceinline__ void p0_prologue(Frame& F, int parts, int wi, int nw) {
    LAS float* scr = (LAS float*)(F.lds + F.wave * 16384);
    const int gw = wi * 8 + F.wave, NGW = nw * 8, lane = lane_fresh_();
    const int gt = gw * 64 + lane, NGT = NGW * 64;
    unsigned char* ws = F.ws; bf16_t* wsm = (bf16_t*)(ws + WS_WSM);
    if (parts & 1) {
        const float* g = F.in[5]; bf16_t* hb = (bf16_t*)(ws + WS_R2);
        f32x4 gg8[8];
#pragma unroll
        for (int j = 0; j < 8; ++j) gg8[j] = *(const f32x4*)(g + (lane + 64 * j) * 4);
#define H_ROWPTR(row_) ((row_) < SEQ ? F.in[0] + (size_t)(row_) * DM : F.in[1] + (size_t)((row_) - SEQ) * DM)
        f32x4 v[8], vn[8];
        if (gw < NTOK) { const float* xr = H_ROWPTR(gw);
#pragma unroll
            for (int j = 0; j < 8; ++j) v[j] = *(const f32x4*)(xr + (lane + 64 * j) * 4); }
        for (int row = gw; row < NTOK; row += NGW) {
            const bool more = row + NGW < NTOK;
            if (more) { const float* xn = H_ROWPTR(row + NGW);
#pragma unroll
                for (int j = 0; j < 8; ++j) vn[j] = *(const f32x4*)(xn + (lane + 64 * j) * 4); }
            asm volatile("" ::: "memory");
            float s = 0.f;
#pragma unroll
            for (int j = 0; j < 8; ++j) s += (v[j][0] * v[j][0] + v[j][1] * v[j][1]) + (v[j][2] * v[j][2] + v[j][3] * v[j][3]);
            const float inv = rsqrtf(wave_sum(s) * (1.f / DM) + EPS);
#pragma unroll
            for (int j = 0; j < 8; ++j) { const f32x4 gg = gg8[j];
                u32x2 o; o.x = pk2(v[j][0] * inv * gg[0], v[j][1] * inv * gg[1]); o.y = pk2(v[j][2] * inv * gg[2], v[j][3] * inv * gg[3]);
                *(u32x2*)(hb + (size_t)row * DM + (lane + 64 * j) * 4) = o; }
            if (more) {
#pragma unroll
                for (int j = 0; j < 8; ++j) v[j] = vn[j]; }
        }
#undef H_ROWPTR
    }
    if (parts & 2) {
        const float* wukv = F.in[10]; bf16_t* wk = wsm + W_KNABS;
        for (int i = gt; i < 16 * 512 * 32; i += NGT) { const int j8 = (i & 31) * 8, c = (i >> 5) & 511, h = i >> 14;
            u32x4 o = {0u, 0u, 0u, 0u};
            if (j8 < 128) { const float* s = wukv + (size_t)c * 4096 + h * 256 + j8; const f32x4 a = *(const f32x4*)s, b = *(const f32x4*)(s + 4);
                o.x = pk2(a[0], a[1]); o.y = pk2(a[2], a[3]); o.z = pk2(b[0], b[1]); o.w = pk2(b[2], b[3]); }
            *(u32x4*)(wk + ((size_t)h * 512 + c) * 256 + j8) = o; }
    }
    constexpr int I_IN = 32 * 360, I_UQ = 8 * 96, I_UKV = 8 * 128, I_KN = 8 * 64, I_V = 8 * 64, I_O = 32 * 64;
    constexpr int NIT = I_IN + I_UQ + I_UKV + I_KN + I_V + I_O;
    const float* const* in = F.in;
    auto dec = [=](int it) -> TrDesc {
        int r = it; const int n = (lane_id_() & 7) * 4;
        if (r < I_IN) { const int kb = r / 360, nb = r % 360; return tr_desc(in[6], DIN, (bf16_t*)(ws + WS_R1), 2048, kb * 64, nb * 32, win_src(nb * 32 + n), nullptr, lane); } r -= I_IN;
        if (r < I_UQ) { const int kb = r / 96, nb = r % 96; return tr_desc(in[8], 3072, wsm + W_UQ, 512, kb * 64, nb * 32, nb * 32 + n, in[7], lane); } r -= I_UQ;
        if (r < I_UKV) { const int kb = r / 128, nb = r % 128; return tr_desc(in[10], 4096, wsm + W_UKVG, 512, kb * 64, nb * 32, nb * 32 + n, in[9], lane); } r -= I_UKV;
        if (r < I_KN) { const int kb = r / 64, nb = r % 64; const int nd = nb * 32 + n; return tr_desc(in[10], 4096, wsm + W_KNP, 512, kb * 64, nb * 32, (nd >> 7) * 256 + (nd & 127), nullptr, lane); } r -= I_KN;
        if (r < I_V) { const int kb = r / 64, nb = r % 64; const int nd = nb * 32 + n; return tr_desc(in[10], 4096, wsm + W_VP, 512, kb * 64, nb * 32, (nd >> 7) * 256 + 128 + (nd & 127), nullptr, lane); } r -= I_V;
        { const int kb = r / 64, nb = r % 64; return tr_desc(in[18], 2048, wsm + W_O, 2048, kb * 64, nb * 32, nb * 32 + n, nullptr, lane); }
    };
    const int lo = (parts & 1) ? 0 : I_IN, hi = (parts & 2) ? NIT : I_IN;
    tr_loop(lo + gw, hi, NGW, dec, scr, lane);
}

__device__ __forceinline__ void p2_ckv_krope(Frame& F) {
    const int gw = F.vcu * 8 + F.wave, NGW = F.G * 8, lane = F.lane;
    unsigned char* ws = F.ws; float* fsm = (float*)(ws + WS_FSM);
    const bf16_t* ZL = (const bf16_t*)(ws + WS_ZL); const bf16_t* ZM = (const bf16_t*)(ws + WS_ZM);
    const float* gkv = F.in[9]; const float* cs = fsm + F_ROPE;
    for (int t = gw; t < NTOK; t += NGW) {
        const float inv = rsqrtf((fsm[F_SSQ_KV + 2 * t] + fsm[F_SSQ_KV + 2 * t + 1]) * (1.f / 512.f) + EPS);
        const u32x4 w = *(const u32x4*)(ZL + (size_t)t * 1024 + 512 + lane * 8);
        const f32x4 g0 = *(const f32x4*)(gkv + lane * 8), g1 = *(const f32x4*)(gkv + lane * 8 + 4);
        f32x4 o0, o1;
        o0[0] = bflo(w.x) * inv * g0[0]; o0[1] = bfhi(w.x) * inv * g0[1]; o0[2] = bflo(w.y) * inv * g0[2]; o0[3] = bfhi(w.y) * inv * g0[3];
        o1[0] = bflo(w.z) * inv * g1[0]; o1[1] = bfhi(w.z) * inv * g1[1]; o1[2] = bflo(w.w) * inv * g1[2]; o1[3] = bfhi(w.w) * inv * g1[3];
        float* oc = t < SEQ ? F.out + O_CKVP + (size_t)t * 512 : F.out + O_CKVS + (size_t)(t - SEQ) * 512;
        *(f32x4*)(oc + lane * 8) = o0; *(f32x4*)(oc + lane * 8 + 4) = o1;
        const int r_ = t - SEQ, kb_ = r_ >> 4, kq_ = r_ & 15; const int krow = kb_ * NKP + PAST + kq_;
        bf16_t* kc = (bf16_t*)(ws + WS_R3) + (size_t)(t >= SEQ ? krow : 0) * DQC;
        if (t >= SEQ) {
            u32x4 o; o.x = pk2(o0[0], o0[1]); o.y = pk2(o0[2], o0[3]); o.z = pk2(o1[0], o1[1]); o.w = pk2(o1[2], o1[3]);
            *(u32x4*)(kc + lane * 8) = o;
            if (lane < 8) *(u32x4*)(kc + 576 + lane * 8) = (u32x4){0u, 0u, 0u, 0u};
            bf16_t* ct = (bf16_t*)(ws + WS_R4) + ((size_t)kb_ * 512 + lane * 8) * NKP + PAST + kq_;
            ((unsigned short*)ct)[0] = (unsigned short)(o.x & 0xffffu); ((unsigned short*)(ct + NKP))[0] = (unsigned short)(o.x >> 16);
            ((unsigned short*)(ct + 2 * NKP))[0] = (unsigned short)(o.y & 0xffffu); ((unsigned short*)(ct + 3 * NKP))[0] = (unsigned short)(o.y >> 16);
            ((unsigned short*)(ct + 4 * NKP))[0] = (unsigned short)(o.z & 0xffffu); ((unsigned short*)(ct + 5 * NKP))[0] = (unsigned short)(o.z >> 16);
            ((unsigned short*)(ct + 6 * NKP))[0] = (unsigned short)(o.w & 0xffffu); ((unsigned short*)(ct + 7 * NKP))[0] = (unsigned short)(o.w >> 16);
        }
        float ss = 0.f;
        if (lane < 32) {
            const float x1 = bf2f(ZM[(size_t)t * 256 + lane]), x2 = bf2f(ZM[(size_t)t * 256 + 32 + lane]);
            const int pos = t < SEQ ? t : PAST + ((t - SEQ) & 15);
            const float c = cs[pos * 64 + lane], s = cs[pos * 64 + 32 + lane];
            const float y1 = x1 * c - x2 * s, y2 = x2 * c + x1 * s;
            float* ok = t < SEQ ? F.out + O_KRP + (size_t)t * 64 : F.out + O_KRS + (size_t)(t - SEQ) * 64;
            ok[lane] = y1; ok[32 + lane] = y2; ss = y1 * y1 + y2 * y2;
            if (t >= SEQ) { const unsigned p_ = pk2(y1, y2); ((unsigned short*)(kc + 512 + lane))[0] = (unsigned short)(p_ & 0xffffu); ((unsigned short*)(kc + 544 + lane))[0] = (unsigned short)(p_ >> 16); }
        }
        ss = wave_sum(ss);
        if (lane == 0) { fsm[F_KRSS + t] = ss; if (t >= SEQ) fsm[F_KRSS_C + krow] = ss; }
    }
}

__device__ __forceinline__ void p4_finalize_q_head(Frame& F, int h) {
    const int tid = F.wave * 64 + F.lane;
    unsigned char* ws = F.ws; float* fsm = (float*)(ws + WS_FSM); const float* cs = fsm + F_ROPE;
    const bf16_t* Qp = (const bf16_t*)(ws + WS_R1);
    bf16_t* Qcat = (bf16_t*)(F.out + O_Y) + 48 * MiB / 2; bf16_t* QnA = (bf16_t*)(F.out + O_Y) + 53 * MiB / 2;
    const float* gqn = F.in[11]; const float* gqr = F.in[12]; const float* gkn = F.in[13]; const float* gkr = F.in[14];
    const float* ssq_qg = (const float*)((const char*)(F.out + O_Y) + 56 * MiB);
#define QSCALE(t, h) ({ const float al_ = rsqrtf((fsm[F_SSQ_QL + 2 * (t)] + fsm[F_SSQ_QL + 2 * (t) + 1]) * (1.f / 512.f) + EPS); const float* qg_ = ssq_qg + (size_t)(t) * 96 + (h) * 6; \
        const float ssh_ = ((qg_[0] + qg_[1]) + (qg_[2] + qg_[3])) + (qg_[4] + qg_[5]); al_ * rsqrtf(al_ * al_ * ssh_ * (1.f / 192.f) + EPS) * (MLA_SCALE * LOG2E); })
#pragma unroll 4
    for (int i = tid; i < NSAMP * 16; i += 512) { const int l = i & 15, r = i >> 4, t = SEQ + r;
        const float sc = QSCALE(t, h);
        const bf16_t* q = Qp + ((size_t)h * NTOK + t) * 192 + l * 8;
        const u32x4 w = *(const u32x4*)q;
        const f32x4 a0 = *(const f32x4*)(gqn + l * 8), a1 = *(const f32x4*)(gqn + l * 8 + 4), b0 = *(const f32x4*)(gkn + l * 8), b1 = *(const f32x4*)(gkn + l * 8 + 4);
        u32x4 o;
        o.x = pk2(bflo(w.x) * sc * a0[0] * b0[0], bfhi(w.x) * sc * a0[1] * b0[1]); o.y = pk2(bflo(w.y) * sc * a0[2] * b0[2], bfhi(w.y) * sc * a0[3] * b0[3]);
        o.z = pk2(bflo(w.z) * sc * a1[0] * b1[0], bfhi(w.z) * sc * a1[1] * b1[1]); o.w = pk2(bflo(w.w) * sc * a1[2] * b1[2], bfhi(w.w) * sc * a1[3] * b1[3]);
        bf16_t* qa = QnA + ((size_t)h * 256 + r) * 256; *(u32x4*)(qa + l * 8) = o; *(u32x4*)(qa + 128 + l * 8) = (u32x4){0u, 0u, 0u, 0u};
    }
#pragma unroll 2
    for (int i = tid; i < NSAMP * 4; i += 512) { const int k = i & 3, r = i >> 2, t = SEQ + r;
        const float sc = QSCALE(t, h);
        const bf16_t* q = Qp + ((size_t)h * NTOK + t) * 192;
        const int b = r >> 4, qi = r & 15; const int pos = PAST + qi;
        const u32x4 w1 = *(const u32x4*)(q + 128 + 8 * k), w2 = *(const u32x4*)(q + 160 + 8 * k);
        const float x1[8] = {bflo(w1.x), bfhi(w1.x), bflo(w1.y), bfhi(w1.y), bflo(w1.z), bfhi(w1.z), bflo(w1.w), bfhi(w1.w)};
        const float x2[8] = {bflo(w2.x), bfhi(w2.x), bflo(w2.y), bfhi(w2.y), bflo(w2.z), bfhi(w2.z), bflo(w2.w), bfhi(w2.w)};
        float y1[8], y2[8];
#pragma unroll
        for (int j = 0; j < 8; ++j) { const int ii = 8 * k + j; const float c = cs[pos * 64 + ii], sn = cs[pos * 64 + 32 + ii], g = gqr[ii] * gkr[ii] * sc;
            y1[j] = (x1[j] * c - x2[j] * sn) * g; y2[j] = (x2[j] * c + x1[j] * sn) * g; }
        const u32x4 o1 = {pk2(y1[0], y1[1]), pk2(y1[2], y1[3]), pk2(y1[4], y1[5]), pk2(y1[6], y1[7])};
        const u32x4 o2 = {pk2(y2[0], y2[1]), pk2(y2[2], y2[3]), pk2(y2[4], y2[5]), pk2(y2[6], y2[7])};
        bf16_t* qc = Qcat + ((size_t)b * 256 + h * 16 + qi) * DQC; *(u32x4*)(qc + 512 + 8 * k) = o1; *(u32x4*)(qc + 544 + 8 * k) = o2;
        *(u32x4*)(qc + 576 + 8 * k) = (u32x4){0u, 0u, 0u, 0u}; *(u32x4*)(qc + 608 + 8 * k) = (u32x4){0u, 0u, 0u, 0u};
    }
#undef QSCALE
}
__device__ __forceinline__ void kcat_rows(Frame& F, int klo, int khi, int wi, int nw) {
    const int gt = (wi * 8 + F.wave) * 64 + F.lane, NGT = nw * 512, nk = khi - klo;
    unsigned char* ws = F.ws; float* fsm = (float*)(ws + WS_FSM);
    bf16_t* Kcat = (bf16_t*)(ws + WS_R3);
    const float* cckv = F.in[2]; const float* ckr = F.in[3];
#pragma unroll 4
    for (int i = gt; i < DECB * nk * 80; i += NGT) { const int rr = i / 80, ch = i - rr * 80, b = rr / nk, k = klo + (rr - b * nk); const int row = b * NKP + k;
        u32x4 o = {0u, 0u, 0u, 0u};
        if (k < NKEY && ch < 72) {
            const float* s_;
            if (ch < 64) s_ = (k < PAST ? cckv + ((size_t)b * PAST + k) * 512 : F.out + O_CKVS + (size_t)(b * 16 + k - PAST) * 512) + ch * 8;
            else s_ = (k < PAST ? ckr + ((size_t)b * PAST + k) * 64 : F.out + O_KRS + (size_t)(b * 16 + k - PAST) * 64) + (ch - 64) * 8;
            const f32x4 a_ = *(const f32x4*)s_, c_ = *(const f32x4*)(s_ + 4);
            o.x = pk2(a_[0], a_[1]); o.y = pk2(a_[2], a_[3]); o.z = pk2(c_[0], c_[1]); o.w = pk2(c_[2], c_[3]);
        }
        *(u32x4*)(Kcat + (size_t)row * DQC + ch * 8) = o; }
#pragma unroll 4
    for (int i = gt; i < DECB * nk * 16; i += NGT) { const int rr = i >> 4, l = i & 15, b = rr / nk, k = klo + (rr - b * nk); const int row = b * NKP + k;
        float ss = 0.f;
        if (k < NKEY) { const float* s_ = (k < PAST ? ckr + ((size_t)b * PAST + k) * 64 : F.out + O_KRS + (size_t)(b * 16 + k - PAST) * 64) + l * 4; const f32x4 a_ = *(const f32x4*)s_;
            ss = (a_[0] * a_[0] + a_[1] * a_[1]) + (a_[2] * a_[2] + a_[3] * a_[3]); }
        ss += __shfl_xor(ss, 1); ss += __shfl_xor(ss, 2); ss += __shfl_xor(ss, 4); ss += __shfl_xor(ss, 8);
        if (l == 0) fsm[F_KRSS_C + row] = ss; }
}
__device__ __forceinline__ void p3_kcat_ct(Frame& F, bool cache_rows_done) {
    LAS float* scr = (LAS float*)(F.lds + F.wave * 16384);
    const int gw = F.vcu * 8 + F.wave, NGW = F.G * 8, lane = lane_fresh_();
    const int gt = gw * 64 + lane, NGT = NGW * 64;
    unsigned char* ws = F.ws;
    bf16_t* CT = (bf16_t*)(ws + WS_R4);
    const float* cckv = F.in[2];
    if (!cache_rows_done) {
        if (F.G == 256) { kcat_rows(F, 0, PAST, F.vcu, 356); if (F.vcu >= 156) kcat_rows(F, 0, PAST, 100 + F.vcu, 356); }
        else kcat_rows(F, 0, PAST, F.vcu, F.G); }
    kcat_rows(F, NKEY, NKP, F.vcu, F.G);
    { auto dec = [=](int it) -> TrDesc { const int b = it >> 9, r = it & 511, kb = r >> 4, nb = r & 15;
          return tr_desc(cckv + (size_t)b * PAST * 512, 512, CT + (size_t)b * 512 * NKP, NKP, kb * 64, nb * 32, nb * 32 + (lane_id_() & 7) * 4, nullptr, lane); };
      tr_loop(gw, 16 * 32 * 16, NGW, dec, scr, lane); }
    for (int i = gt; i < 16 * 512 * 32; i += NGT) { const int ch = i & 31, c = (i >> 5) & 511, b = i >> 14;
        if (ch >= 2) *(u32x4*)(CT + ((size_t)b * 512 + c) * NKP + PAST + ch * 8) = (u32x4){0u, 0u, 0u, 0u}; }
    { float* invk_t = (float*)(ws + WS_FSM) + F_KNSS_C;
      for (int i = gt; i < 256 * 60; i += NGT) { const int bh = i / 60, j = i - bh * 60; *(f32x4*)(invk_t + (size_t)bh * NKP + NKEY + j * 4) = (f32x4){0.f, 0.f, 0.f, 0.f}; } }
}
__device__ __forceinline__ float logsig16(float x) { return (fminf(x, 0.f) - __logf(1.f + __expf(-fabsf(x)))) * (1.f / 16.f); }
__device__ __forceinline__ void p3_gla_prep(Frame& F) {
    unsigned char* ws = F.ws; float* fsm = (float*)(ws + WS_FSM);
    const bf16_t* ZQK = (const bf16_t*)(ws + WS_ZQK); const bf16_t* ZV = (const bf16_t*)(ws + WS_ZV); const bf16_t* ZM = (const bf16_t*)(ws + WS_ZM);
    bf16_t* qt = (bf16_t*)(ws + WS_ZOG); bf16_t* kt = (bf16_t*)(ws + WS_R5); bf16_t* kendT = (bf16_t*)(ws + WS_R5) + 8 * MiB; bf16_t* vT = (bf16_t*)(F.out + O_STS);
    const float* wa2 = F.in[15]; const float* ba_ = F.in[16];
    LAS float* alr_s = (LAS float*)F.lds;
    LAS float* tot_s = (LAS float*)(F.lds + 16384);
    LAS unsigned char* tile = F.lds + 16384 + 2048;
    const int tid = F.tid;
    __syncthreads();
    for (int un = F.vcu; un < 256; un += F.G) {
        const int hc = un >> 1, dh = un & 1, h = hc >> 5, c = hc & 31;
        const int dl = tid & 127, qtr = tid >> 7, d = dh * 128 + dl;
        { const int tt = tid >> 1, half = tid & 1; const u32x4 w = *(const u32x4*)(ZM + (size_t)(c * 256 + tt) * 256 + 64 + half * 8);
          LAS float* a = alr_s + tt * 16 + half * 8;
          a[0] = bflo(w.x); a[1] = bfhi(w.x); a[2] = bflo(w.y); a[3] = bfhi(w.y); a[4] = bflo(w.z); a[5] = bfhi(w.z); a[6] = bflo(w.w); a[7] = bfhi(w.w); }
        float wa[16];
#pragma unroll
        for (int r = 0; r < 16; ++r) wa[r] = wa2[r * 1024 + h * 256 + d];
        const float ba = ba_[h * 256 + d];
        __syncthreads();
        float tot = 0.f;
#pragma unroll 4
        for (int i = 0; i < 64; ++i) { const LAS float* a = alr_s + (qtr * 64 + i) * 16; float x = ba;
#pragma unroll
            for (int r = 0; r < 16; ++r) x += a[r] * wa[r];
            const _Float16 lh = (_Float16)logsig16(x);
            *(LAS unsigned short*)(tile + dl * 520 + (qtr * 64 + i) * 2) = __builtin_bit_cast(unsigned short, lh);
            tot += (float)lh; }
        tot_s[qtr * 128 + dl] = tot;
        __syncthreads();
        float off = 0.f, bend = 0.f;
#pragma unroll
        for (int q = 0; q < 4; ++q) { const float v = tot_s[q * 128 + dl]; bend += v; if (q < qtr) off += v; }
        const float ebend = __expf(bend);
        if (qtr == 0) fsm[F_GAMMA + hc * 256 + d] = ebend;
        float bcum = off;
#define GP_LOAD(bq, bk, i0_) do { _Pragma("unroll") for (int i_ = 0; i_ < 8; ++i_) { const size_t trow_ = (size_t)(c * 256 + qtr * 64 + (i0_) + i_) * 2048; bq[i_] = ZQK[trow_ + h * 256 + d]; bk[i_] = ZQK[trow_ + 1024 + h * 256 + d]; } } while (0)
#define GP_COMP(bq, bk, i0_) do { _Pragma("unroll") for (int i_ = 0; i_ < 8; ++i_) { const int tl = qtr * 64 + (i0_) + i_; \
            bcum += (float)__builtin_bit_cast(_Float16, *(const LAS unsigned short*)(tile + dl * 520 + tl * 2)); \
            const float gq = bf2f(bq[i_]), gk = bf2f(bk[i_]); \
            const float eb = __expf(bcum), ieb = __builtin_amdgcn_rcpf(eb); \
            qt[(size_t)hc * 65536 + tl * 256 + d] = f2bf(gq * 0.0625f * eb); \
            kt[(size_t)hc * 65536 + tl * 256 + d] = f2bf(gk * ieb); \
            *(LAS bf16_t*)(tile + dl * 520 + tl * 2) = f2bf(gk * (ebend * ieb)); } } while (0)
        { bf16_t qa[8], ka[8], qb[8], kb[8];
          GP_LOAD(qa, ka, 0);
#pragma unroll 1
          for (int i0 = 0; i0 < 64; i0 += 16) {
              GP_LOAD(qb, kb, i0 + 8); asm volatile("" ::: "memory");
              GP_COMP(qa, ka, i0); asm volatile("" ::: "memory");
              if (i0 + 16 < 64) GP_LOAD(qa, ka, i0 + 16);
              asm volatile("" ::: "memory");
              GP_COMP(qb, kb, i0 + 8); asm volatile("" ::: "memory");
          } }
#undef GP_LOAD
#undef GP_COMP
        __syncthreads();
#pragma unroll 4
        for (int j = 0; j < 16; ++j) { const int g = tid + 512 * j, row = g >> 6, ch = g & 63;
            const u32x2 v = *(const LAS u32x2*)(tile + row * 520 + ch * 8);
            *(u32x2*)(kendT + (size_t)hc * 65536 + (size_t)(dh * 128 + row) * 256 + ch * 4) = v; }
        __syncthreads();
    }
    LAS unsigned char* tl2 = F.lds;
    for (int it = F.vcu; it < 1024; it += F.G) {
        const int hc = it >> 3, eb = it & 7, h = hc >> 5, c = hc & 31, e0 = eb * 64;
#pragma unroll
        for (int j = 0; j < 4; ++j) { const int g = tid + 512 * j, t = g >> 3, ch = g & 7;
            const u32x4 w = *(const u32x4*)(ZV + (size_t)(c * 256 + t) * 2048 + h * 512 + e0 + ch * 8);
            LAS unsigned char* p = tl2 + (ch * 8) * 520 + t * 2;
            *(LAS bf16_t*)(p) = (bf16_t)(w.x & 0xffff); *(LAS bf16_t*)(p + 520) = (bf16_t)(w.x >> 16);
            *(LAS bf16_t*)(p + 2 * 520) = (bf16_t)(w.y & 0xffff); *(LAS bf16_t*)(p + 3 * 520) = (bf16_t)(w.y >> 16);
            *(LAS bf16_t*)(p + 4 * 520) = (bf16_t)(w.z & 0xffff); *(LAS bf16_t*)(p + 5 * 520) = (bf16_t)(w.z >> 16);
            *(LAS bf16_t*)(p + 6 * 520) = (bf16_t)(w.w & 0xffff); *(LAS bf16_t*)(p + 7 * 520) = (bf16_t)(w.w >> 16); }
        __syncthreads();
#pragma unroll
        for (int j = 0; j < 8; ++j) { const int g = tid + 512 * j, row = g >> 6, ch = g & 63;
            const u32x2 v = *(const LAS u32x2*)(tl2 + row * 520 + ch * 8);
            *(u32x2*)(vT + ((size_t)hc * 512 + e0 + row) * 256 + ch * 4) = v; }
        __syncthreads();
    }
}

__device__ __forceinline__ void p6_softmax_scan(Frame& F) {
    const int lane = F.lane;
    unsigned char* ws = F.ws; float* fsm = (float*)(ws + WS_FSM);
    const bf16_t* dS = (const bf16_t*)(ws + WS_R1); bf16_t* Sst = (bf16_t*)(ws + WS_R2); const float* gam = fsm + F_GAMMA;
    for (int gid = (F.vcu * 8 + F.wave) * 64 + lane; gid < 4 * 512 * 64; gid += F.G * 512) {
        const int dq = gid & 63, e = (gid >> 6) & 511, h = gid >> 15;
        f32x4 st = {0.f, 0.f, 0.f, 0.f};
#pragma unroll 8
        for (int c = 0; c < 32; ++c) { const int hc = h * 32 + c; const size_t idx = ((size_t)hc * 512 + e) * 256 + dq * 4;
            const u32x2 w = *(const u32x2*)(dS + idx); const f32x4 g = *(const f32x4*)(gam + hc * 256 + dq * 4);
            u32x2 o = {pk2(st[0], st[1]), pk2(st[2], st[3])}; *(u32x2*)(Sst + idx) = o;
            st[0] = g[0] * st[0] + bflo(w.x); st[1] = g[1] * st[1] + bfhi(w.x); st[2] = g[2] * st[2] + bflo(w.y); st[3] = g[3] * st[3] + bfhi(w.y); }
        float* op = F.out + O_STP + ((size_t)h * 256 + dq * 4) * 512 + e;
        op[0] = st[0]; op[512] = st[1]; op[1024] = st[2]; op[1536] = st[3];
    }
}

__device__ __forceinline__ void p8_pc_convert(Frame& F) {
    const int gt = (F.vcu * 8 + F.wave) * 64 + F.lane, NGT = F.G * 512;
    const float* PCp = (const float*)(F.ws + WS_R5); bf16_t* PCb = (bf16_t*)(F.ws + WS_ZQK) + 8 * MiB; const float* fsm = (const float*)(F.ws + WS_FSM);
    for (int i = gt; i < 16 * 256 * 64; i += NGT) { const size_t e = (size_t)i * 8; f32x4 a = {0.f, 0.f, 0.f, 0.f}, b = a;
        const int rr = i >> 6, h = rr >> 8, bq = rr & 255, bb = bq >> 4, q = bq & 15;
        const float* rs = fsm + F_SSQ_K + ((size_t)bb * 256 + h * 16 + q) * 9; float tot = 0.f;
#pragma unroll
        for (int t = 0; t < 9; ++t) tot += rs[t];
        const float inv = 1.f / tot;
#pragma unroll
        for (int ks = 0; ks < 3; ++ks) { const float* s = PCp + (size_t)ks * 16 * 256 * 512 + e; a += *(const f32x4*)s; b += *(const f32x4*)(s + 4); }
        u32x4 o = {pk2(a[0] * inv, a[1] * inv), pk2(a[2] * inv, a[3] * inv), pk2(b[0] * inv, b[1] * inv), pk2(b[2] * inv, b[3] * inv)}; *(u32x4*)(PCb + e) = o; }
}

__device__ __forceinline__ void p9_ffn_weights(Frame& F, int jlo, int jhi, int wi, int nw) {
    LAS float* scr = (LAS float*)(F.lds + F.wave * 16384);
    const int gw = wi * 8 + F.wave, NGW = nw * 8, lane = lane_fresh_();
    const float* const* in = F.in; unsigned char* ws = F.ws; bf16_t* wup = (bf16_t*)((char*)(F.out + O_Y) + 20 * MiB);
    auto dec = [=](int it) -> TrDesc {
        const int n = (lane_id_() & 7) * 4;
        if (it < 8192) { const int kb = it / 256, nb = it % 256; return tr_desc(in[20], DFF, wup, 2048, kb * 64, nb * 32, nb * 32 + n, in[19], lane); }
        const int r = it - 8192, kb = r / 64, nb = r % 64; return tr_desc(in[21], 2048, (bf16_t*)(ws + WS_R3), DFF, kb * 64, nb * 32, nb * 32 + n, nullptr, lane);
    };
    tr_loop(jlo + gw, jhi, NGW, dec, scr, lane);
}
__device__ __forceinline__ void p9_gla_sample(Frame& F) {
    unsigned char* ws = F.ws; float* fsm = (float*)(ws + WS_FSM);
    const bf16_t* ZQK = (const bf16_t*)(ws + WS_ZQK); bf16_t* ZV = (bf16_t*)(ws + WS_ZV); const bf16_t* ZM = (const bf16_t*)(ws + WS_ZM);
    const float* wa2 = F.in[15]; const float* ba_ = F.in[16]; const float* S0 = F.in[4];
    LAS float* alr_s = (LAS float*)F.lds;
    LAS float* qt_s = alr_s + 256;
    LAS float* kt_s = qt_s + 4096;
    LAS float* ke_s = kt_s + 4096;
    LAS float* gam_s = ke_s + 4096;
    LAS float* A_s = gam_s + 256;
    LAS float* osum = A_s + 256;
    LAS float* red_s = osum + 8192;
    const int tid = F.tid;
    for (int un = F.vcu; un < 256; un += F.G) {
        const int bh = un >> 2, eq = un & 3, b = bh >> 2, h = bh & 3; const int row0 = SEQ + b * 16;
        if (tid < 256) alr_s[tid] = bf2f(ZM[(size_t)(row0 + (tid >> 4)) * 256 + 64 + (tid & 15)]);
        __syncthreads();
        if (tid < 256) { const int d = tid; float bb[16]; float bc = 0.f; const float ba = ba_[h * 256 + d]; float wa[16];
#pragma unroll
            for (int r = 0; r < 16; ++r) wa[r] = wa2[r * 1024 + h * 256 + d];
#pragma unroll
            for (int t = 0; t < 16; ++t) { float x = ba;
#pragma unroll
                for (int r = 0; r < 16; ++r) x += alr_s[t * 16 + r] * wa[r];
                bc += logsig16(x); bb[t] = bc; }
#pragma unroll
            for (int t = 0; t < 16; ++t) { const size_t tr = (size_t)(row0 + t) * 2048;
                const float gq = bf2f(ZQK[tr + h * 256 + d]), gk = bf2f(ZQK[tr + 1024 + h * 256 + d]);
                qt_s[d * 16 + t] = gq * 0.0625f * __expf(bb[t]); kt_s[d * 16 + t] = gk * __expf(-bb[t]); ke_s[d * 16 + t] = gk * __expf(bc - bb[t]); }
            gam_s[d] = __expf(bc); }
        __syncthreads();
        if (tid < 256) { const int t = tid >> 4, s_ = tid & 15; float a = 0.f;
            for (int d = 0; d < 256; ++d) a += qt_s[d * 16 + t] * kt_s[d * 16 + s_];
            A_s[tid] = (s_ <= t) ? a : 0.f; }
        __syncthreads();
        const int el = tid & 127, dq = tid >> 7, e = eq * 128 + el; float v[16], o[16];
#pragma unroll
        for (int t = 0; t < 16; ++t) v[t] = bf2f(ZV[(size_t)(row0 + t) * 2048 + h * 512 + e]);
#pragma unroll
        for (int t = 0; t < 16; ++t) { float a = 0.f;
            if (dq == 0) {
#pragma unroll
                for (int s_ = 0; s_ < 16; ++s_) a += A_s[t * 16 + s_] * v[s_]; }
            o[t] = a; }
        const float* sp = S0 + ((size_t)(b * 4 + h) * 256 + dq * 64) * 512 + e; float* op = F.out + O_STS + ((size_t)(b * 4 + h) * 256 + dq * 64) * 512 + e;
#define GS_LOAD(buf, dd0_) do { _Pragma("unroll") for (int i_ = 0; i_ < 8; ++i_) buf[i_] = sp[(size_t)((dd0_) + i_) * 512]; } while (0)
#define GS_COMP(buf, dd0_) do { _Pragma("unroll") for (int i_ = 0; i_ < 8; ++i_) { const int dd = (dd0_) + i_; const int d = dq * 64 + dd; const float s0 = buf[i_]; float sn = gam_s[d] * s0; \
            const LAS f32x4* q4 = (const LAS f32x4*)(qt_s + d * 16); const LAS f32x4* k4 = (const LAS f32x4*)(ke_s + d * 16); \
            _Pragma("unroll") for (int j = 0; j < 4; ++j) { const f32x4 qv = q4[j], kv = k4[j]; \
                _Pragma("unroll") for (int i = 0; i < 4; ++i) { o[j * 4 + i] += qv[i] * s0; sn += kv[i] * v[j * 4 + i]; } } \
            op[(size_t)dd * 512] = sn; } } while (0)
        { float sa[8], sb[8];
          GS_LOAD(sa, 0);
#pragma unroll 1
          for (int dd0 = 0; dd0 < 64; dd0 += 16) {
              GS_LOAD(sb, dd0 + 8); asm volatile("" ::: "memory");
              GS_COMP(sa, dd0); asm volatile("" ::: "memory");
              if (dd0 + 16 < 64) GS_LOAD(sa, dd0 + 16);
              asm volatile("" ::: "memory");
              GS_COMP(sb, dd0 + 8); asm volatile("" ::: "memory");
          } }
#undef GS_LOAD
#undef GS_COMP
#pragma unroll
        for (int t = 0; t < 16; ++t) osum[(dq * 16 + t) * 128 + el] = o[t];
        __syncthreads();
#pragma unroll
        for (int j = 0; j < 4; ++j) { const int t = dq * 4 + j;
            const float tot = (osum[(0 * 16 + t) * 128 + el] + osum[(1 * 16 + t) * 128 + el]) + (osum[(2 * 16 + t) * 128 + el] + osum[(3 * 16 + t) * 128 + el]);
            ZV[(size_t)(row0 + t) * 2048 + h * 512 + e] = f2bf(tot);
            const float ss = wave_sum(tot * tot); if (F.lane == 0) red_s[t * 8 + F.wave] = ss; }
        __syncthreads();
        if (tid < 16) { const int t = tid, w0 = (t >> 2) * 2; fsm[F_SSQ_OG + ((size_t)(row0 + t) * 4 + h) * 4 + eq] = red_s[t * 8 + w0] + red_s[t * 8 + w0 + 1]; }
        __syncthreads();
    }
}

__device__ __forceinline__ void p10_mix(Frame& F, int t_lo, int t_hi, int wi, int nw) {
    const int gt = (wi * 8 + F.wave) * 64 + F.lane, NGT = nw * 512;
    unsigned char* ws = F.ws; const float* fsm = (const float*)(ws + WS_FSM); const float* gn = F.in[17];
    bf16_t* ZOG = (bf16_t*)(ws + WS_ZOG); const bf16_t* ZGM = (const bf16_t*)(ws + WS_ZGM); const bf16_t* ZGG = (const bf16_t*)(ws + WS_ZGG); const bf16_t* ZV = (const bf16_t*)(ws + WS_ZV);
#pragma unroll 2
    for (int i = t_lo * 256 + gt; i < t_hi * 256; i += NGT) { const int t = i >> 8, c8 = (i & 255) * 8, hg = c8 >> 9; const size_t e = (size_t)t * 2048 + c8;
        const f32x4 sq = *(const f32x4*)(fsm + F_SSQ_OG + ((size_t)t * 4 + hg) * 4);
        const float inv = rsqrtf(((sq[0] + sq[1]) + (sq[2] + sq[3])) * (1.f / 512.f) + EPS);
        const u32x4 wm = *(const u32x4*)(ZGM + e), wg = *(const u32x4*)(ZGG + e), wv = *(const u32x4*)(ZV + e);
        const f32x4 g0 = *(const f32x4*)(gn + (c8 & 511)), g1 = *(const f32x4*)(gn + (c8 & 511) + 4);
        const float m[8] = {bflo(wm.x), bfhi(wm.x), bflo(wm.y), bfhi(wm.y), bflo(wm.z), bfhi(wm.z), bflo(wm.w), bfhi(wm.w)};
        const float gg[8] = {bflo(wg.x), bfhi(wg.x), bflo(wg.y), bfhi(wg.y), bflo(wg.z), bfhi(wg.z), bflo(wg.w), bfhi(wg.w)};
        const float ov[8] = {bflo(wv.x), bfhi(wv.x), bflo(wv.y), bfhi(wv.y), bflo(wv.z), bfhi(wv.z), bflo(wv.w), bfhi(wv.w)};
        const float gnv[8] = {g0[0], g0[1], g0[2], g0[3], g1[0], g1[1], g1[2], g1[3]};
        float r[8];
#pragma unroll
        for (int k = 0; k < 8; ++k) r[k] = m[k] + gg[k] * (ov[k] * inv * gnv[k]);
        u32x4 o = {pk2(r[0], r[1]), pk2(r[2], r[3]), pk2(r[4], r[5]), pk2(r[6], r[7])}; *(u32x4*)(ZOG + e) = o; }
}

__device__ __forceinline__ void t_reduce_wo(Frame& F) {
    const int gw = F.vcu * 8 + F.wave, NGW = F.G * 8, lane = F.lane;
    float* fsm = (float*)(F.ws + WS_FSM); const float* Yp = (const float*)(F.ws + WS_R4); bf16_t* x1b = (bf16_t*)(F.ws + WS_R2);
    for (int r = gw; r < NSAMP; r += NGW) { float ss = 0.f;
#pragma unroll
        for (int j = 0; j < 4; ++j) { const int c = (lane + 64 * j) * 8; const float* xr = F.in[1] + (size_t)r * DM + c;
            f32x4 a = *(const f32x4*)xr, b = *(const f32x4*)(xr + 4);
#pragma unroll
            for (int ks = 0; ks < 8; ++ks) { const float* s = Yp + ((size_t)ks * 256 + r) * DM + c; a += *(const f32x4*)s; b += *(const f32x4*)(s + 4); }
            u32x4 o = {pk2(a[0], a[1]), pk2(a[2], a[3]), pk2(b[0], b[1]), pk2(b[2], b[3])}; *(u32x4*)(x1b + (size_t)(SEQ + r) * DM + c) = o;
            ss += (a[0] * a[0] + a[1] * a[1]) + (a[2] * a[2] + a[3] * a[3]) + (b[0] * b[0] + b[1] * b[1]) + (b[2] * b[2] + b[3] * b[3]); }
        ss = wave_sum(ss);
        if (lane < 8) fsm[F_SSQ_X1 + (size_t)(SEQ + r) * 8 + lane] = lane == 0 ? ss : 0.f; }
}
__device__ __forceinline__ void t_reduce_up(Frame& F) {
    const int gt = (F.vcu * 8 + F.wave) * 64 + F.lane, NGT = F.G * 512;
    const float* fsm = (const float*)(F.ws + WS_FSM); const float* U = (const float*)(F.ws + WS_R5); bf16_t* Hb = (bf16_t*)(F.ws + WS_ZL);
    for (int i = gt; i < NSAMP * 1024; i += NGT) { const int r = i >> 10, c = (i & 1023) * 8;
        const f32x4 q0_ = *(const f32x4*)(fsm + F_SSQ_X1 + (size_t)(SEQ + r) * 8), q1_ = *(const f32x4*)(fsm + F_SSQ_X1 + (size_t)(SEQ + r) * 8 + 4);
        const float inv2 = 1.f / ((((q0_[0] + q0_[1]) + (q0_[2] + q0_[3])) + ((q1_[0] + q1_[1]) + (q1_[2] + q1_[3]))) * (1.f / 2048.f) + EPS);
        f32x4 a = {0.f, 0.f, 0.f, 0.f}, b = a;
#pragma unroll
        for (int ks = 0; ks < 4; ++ks) { const float* s = U + ((size_t)ks * 256 + r) * DFF + c; a += *(const f32x4*)s; b += *(const f32x4*)(s + 4); }
#pragma unroll
        for (int k = 0; k < 4; ++k) { const float x = fmaxf(a[k], 0.f), y = fmaxf(b[k], 0.f); a[k] = x * x * inv2; b[k] = y * y * inv2; }
        u32x4 o = {pk2(a[0], a[1]), pk2(a[2], a[3]), pk2(b[0], b[1]), pk2(b[2], b[3])}; *(u32x4*)(Hb + (size_t)(SEQ + r) * DFF + c) = o; }
}
__device__ __forceinline__ void t_reduce_down(Frame& F) {
    const int gt = (F.vcu * 8 + F.wave) * 64 + F.lane, NGT = F.G * 512;
    const float* Dp = (const float*)(F.ws + WS_R4);
    for (int i = gt; i < NSAMP * 256; i += NGT) { const int r = i >> 8, c = (i & 255) * 8;
        float* yp = F.out + O_Y + (size_t)(SEQ + r) * DM + c; const u32x4 w = *(const u32x4*)((const bf16_t*)(F.ws + WS_R2) + (size_t)(SEQ + r) * DM + c);
        f32x4 a = {bflo(w.x), bfhi(w.x), bflo(w.y), bfhi(w.y)}, b = {bflo(w.z), bfhi(w.z), bflo(w.w), bfhi(w.w)};
#pragma unroll
        for (int ks = 0; ks < 16; ++ks) { const float* s = Dp + ((size_t)ks * 256 + r) * DM + c; a += *(const f32x4*)s; b += *(const f32x4*)(s + 4); }
        *(f32x4*)yp = a; *(f32x4*)(yp + 4) = b; }
}


__device__ __forceinline__ void t_local_wo(Frame& F, int pn, int part) {
    const int tid = F.wave * 64 + F.lane;
    float* fsm = (float*)(F.ws + WS_FSM); const float* Yp = (const float*)(F.ws + WS_R4); bf16_t* x1b = (bf16_t*)(F.ws + WS_R2);
#pragma unroll
    for (int j = 0; j < 2; ++j) { const int i = tid + 512 * j, r = part * 32 + (i >> 5), c = pn * 256 + (i & 31) * 8;
        const float* xr = F.in[1] + (size_t)r * DM + c;
        f32x4 a = *(const f32x4*)xr, b = *(const f32x4*)(xr + 4);
#pragma unroll
        for (int ks = 0; ks < 8; ++ks) { const float* s = Yp + ((size_t)ks * 256 + r) * DM + c; a += *(const f32x4*)s; b += *(const f32x4*)(s + 4); }
        u32x4 o = {pk2(a[0], a[1]), pk2(a[2], a[3]), pk2(b[0], b[1]), pk2(b[2], b[3])}; *(u32x4*)(x1b + (size_t)(SEQ + r) * DM + c) = o;
        float ss = (a[0] * a[0] + a[1] * a[1]) + (a[2] * a[2] + a[3] * a[3]) + (b[0] * b[0] + b[1] * b[1]) + (b[2] * b[2] + b[3] * b[3]);
        ss += __shfl_xor(ss, 1); ss += __shfl_xor(ss, 2); ss += __shfl_xor(ss, 4); ss += __shfl_xor(ss, 8); ss += __shfl_xor(ss, 16);
        if ((i & 31) == 0) fsm[F_SSQ_X1 + (size_t)(SEQ + r) * 8 + pn] = ss; }
}
__device__ __forceinline__ void t_local_up(Frame& F, int pn, int part) {
    const int tid = F.wave * 64 + F.lane;
    const float* fsm = (const float*)(F.ws + WS_FSM); const float* U = (const float*)(F.ws + WS_R5); bf16_t* Hb = (bf16_t*)(F.ws + WS_ZL);
#pragma unroll
    for (int j = 0; j < 4; ++j) { const int i = tid + 512 * j, r = part * 64 + (i >> 5), c = pn * 256 + (i & 31) * 8;
        const f32x4 q0_ = *(const f32x4*)(fsm + F_SSQ_X1 + (size_t)(SEQ + r) * 8), q1_ = *(const f32x4*)(fsm + F_SSQ_X1 + (size_t)(SEQ + r) * 8 + 4);
        const float inv2 = 1.f / ((((q0_[0] + q0_[1]) + (q0_[2] + q0_[3])) + ((q1_[0] + q1_[1]) + (q1_[2] + q1_[3]))) * (1.f / 2048.f) + EPS);
        f32x4 a = {0.f, 0.f, 0.f, 0.f}, b = a;
#pragma unroll
        for (int ks = 0; ks < 4; ++ks) { const float* s = U + ((size_t)ks * 256 + r) * DFF + c; a += *(const f32x4*)s; b += *(const f32x4*)(s + 4); }
#pragma unroll
        for (int k = 0; k < 4; ++k) { const float x = fmaxf(a[k], 0.f), y = fmaxf(b[k], 0.f); a[k] = x * x * inv2; b[k] = y * y * inv2; }
        u32x4 o = {pk2(a[0], a[1]), pk2(a[2], a[3]), pk2(b[0], b[1]), pk2(b[2], b[3])}; *(u32x4*)(Hb + (size_t)(SEQ + r) * DFF + c) = o; }
}
__device__ __forceinline__ void t_local_down(Frame& F, int pn, int part) {
    const int tid = F.wave * 64 + F.lane;
    const float* Dp = (const float*)(F.ws + WS_R4);
    { const int r = part * 16 + (tid >> 5), c = pn * 256 + (tid & 31) * 8;
        float* yp = F.out + O_Y + (size_t)(SEQ + r) * DM + c; const u32x4 w = *(const u32x4*)((const bf16_t*)(F.ws + WS_R2) + (size_t)(SEQ + r) * DM + c);
        f32x4 a = {bflo(w.x), bfhi(w.x), bflo(w.y), bfhi(w.y)}, b = {bflo(w.z), bfhi(w.z), bflo(w.w), bfhi(w.w)};
#pragma unroll
        for (int ks = 0; ks < 16; ++ks) { const float* s = Dp + ((size_t)ks * 256 + r) * DM + c; a += *(const f32x4*)s; b += *(const f32x4*)(s + 4); }
        *(f32x4*)yp = a; *(f32x4*)(yp + 4) = b; }
}

#ifndef N_LAUNCHES
#define N_LAUNCHES 1
#endif
constexpr int N_PHASES = 16;

__device__ __forceinline__ att::BlockRef att_ref(Frame& F, int h, int qb, int dry) {
    att::BlockRef r;
    r.Q = (const bf16_t*)(F.ws + WS_R1) + ((size_t)h * NTOK + (size_t)qb * 256) * 192;
    r.K = (const bf16_t*)(F.out + O_Y) + (size_t)h * SEQ * 192;
    r.V = (const bf16_t*)(F.ws + WS_R2) + (size_t)h * SEQ * 128;
    r.G = (bf16_t*)(F.ws + WS_ZGM) + (size_t)qb * 256 * 2048 + h * 128;
    r.fsm = (const float*)(F.ws + WS_FSM); r.ssq_qg = (const float*)((const char*)(F.out + O_Y) + 56 * MiB);
    r.qb = qb; r.h = h; r.dry = dry; return r;
}
__device__ __forceinline__ void p4_attention(Frame& F, int dry) {
    const int nblk = 512;
    int n = F.vcu * 2; if (n >= nblk) return;
    att::Seam S;
    att::BlockRef cur = att_ref(F, n >> 5, (n & 1) ? 31 - ((n >> 1) & 15) : ((n >> 1) & 15), dry);
    att::prime(cur, (char*)F.lds, S, F.wave);
    for (;;) {
        int nn = (n & 1) ? (n - 1 + 2 * F.G) : n + 1;
        const bool last = nn >= nblk;
        const att::BlockRef nxt = last ? cur : att_ref(F, nn >> 5, (nn & 1) ? 31 - ((nn >> 1) & 15) : ((nn >> 1) & 15), dry);
        att::block(cur, nxt, (char*)F.lds, S, F.wave);
        if (last) break;
        cur = nxt; n = nn;
    }
}

struct Args { const float* in[22]; float* out; unsigned char* ws; float freq[32]; int ph_lo, ph_hi, li, probe; };

__global__ void __launch_bounds__(512, 2) mega_fwd(Args args) {
    extern __shared__ __attribute__((aligned(16))) unsigned char lds_raw[];
    Frame F;
    F.lds = (LAS unsigned char*)lds_raw; F.ws = args.ws; F.out = args.out; F.in = args.in;
    F.tid = threadIdx.x; F.lane = F.tid & 63; F.wave = __builtin_amdgcn_readfirstlane(F.tid >> 6);
    F.G = gridDim.x; { const int bx = blockIdx.x; F.vcu = (F.G % 8 == 0) ? (bx % 8) * (F.G / 8) + bx / 8 : bx; }
    volatile LAS unsigned* MISC = (volatile LAS unsigned*)(F.lds + MISC_OFF);
    for (int u = F.tid; u < (LDS_BYTES - LDSCTL_OFF) / 4; u += 512) ((LAS unsigned*)(F.lds + LDSCTL_OFF))[u] = 0u;
    __syncthreads();
    XcdBarrier bar; bar.bar = (unsigned*)(F.ws + WS_CTL) + 4096; bar.x = 0; bar.st = nullptr;
    if (N_LAUNCHES == 1) bar = xcd_barrier_post((unsigned*)(F.ws + WS_CTL) + 4096, MISC + 8, F.tid == 0);
    EP ep; ep.ws = F.ws; ep.out = F.out; ep.xp = args.in[0]; ep.xs = args.in[1]; ep.gqn = args.in[11]; ep.gqr = args.in[12]; ep.gkn = args.in[13]; ep.gkr = args.in[14]; ep.lds = F.lds; ep.dry = 0;
    const int lo = args.ph_lo, hi = args.ph_hi;
#ifndef PH_MASK
#define PH_MASK 0xffffffff
#endif
#define IN(k) ((((unsigned)PH_MASK >> (k)) & 1u) && lo <= (k) && (k) < hi)
#define RF() do { int l_ = lane_id_(); asm volatile("" : "+v"(l_)); F.lane = l_; F.tid = F.wave * 64 + l_; } while (0)
#define SEAM(k) do { if (IN(k) && IN((k) + 1)) xcd_barrier(bar, F.wave == 0 && lane_id_() == 0); RF(); } while (0)
    int rot = 0;
    const bool late_w = (F.G == 256);
    if (IN(0)) {
        p0_prologue(F, late_w ? 1 : 3, F.vcu, F.G);
        { float* cs = (float*)(F.ws + WS_FSM) + F_ROPE; const int gt = (F.vcu * 8 + F.wave) * 64 + F.lane;
          for (int i = gt; i < SEQ * 32; i += F.G * 512) { const int p = i >> 5, k = i & 31;
              const float ang = (float)p * args.freq[k];
              const double xd = (double)ang; const double kq = __builtin_rint(xd * 0.63661977236758134308); const float r = (float)(xd - kq * 1.57079632679489661923);
              const float sr = __sinf(r), cr = __cosf(r); const int q = ((int)kq) & 3;
              const float c = (q == 0) ? cr : (q == 1) ? -sr : (q == 2) ? -cr : sr;
              const float s = (q == 0) ? sr : (q == 1) ? cr : (q == 2) ? -sr : -cr;
              cs[p * 64 + k] = c; cs[p * 64 + 32 + k] = s; } }
    }
#if defined(PROBE) && (PROBE & 4)
    if (IN(0) && args.probe) { p0_prologue(F, 3, F.vcu, F.G); }
#endif
#if defined(PROBE) && (PROBE & 64)
    if (args.probe) { for (int i = 0; i < 10; ++i) xcd_barrier(bar, F.wave == 0 && lane_id_() == 0); }
#endif
    SEAM(0);
    const bool kcat_early = false;
    if (IN(1)) { rot = 0; run_gemm<M_INPROJ>(F, ep, 33 * 45, 4096, 4096, 32, 32, rot, 1);
        RF(); if (late_w && F.vcu >= 205) p0_prologue(F, 2, F.vcu - 205, 51);
#if defined(PROBE) && (PROBE & 1)
        if (args.probe) { EP ed = ep; ed.dry = args.probe; rot = 0; run_gemm<M_INPROJ>(F, ed, 33 * 45, 4096, 4096, 32, 32, rot); }
#endif
#if defined(PROBE) && (PROBE & 512)
        if (args.probe) { rot = 0; run_gemm<M_INPROJ>(F, ep, 33 * 45, 4096, 4096, 32, 32, rot); }
#endif
    }
    SEAM(1);
    if (IN(2)) { rot = 0; run_gemm<M_QUP>(F, ep, 33 * 12, 2048, 1024, 8, 8, rot); run_gemm<M_KVUP>(F, ep, 33 * 16, 2048, 1024, 8, 8, rot); RF(); p2_ckv_krope(F); RF(); p3_kcat_ct(F, kcat_early); RF(); p3_gla_prep(F); }
#if defined(PROBE) && (PROBE & 128)
    if (IN(2) && args.probe) { EP ed = ep; ed.dry = args.probe; rot = 0; run_gemm<M_QUP>(F, ed, 33 * 12, 2048, 1024, 8, 8, rot); run_gemm<M_KVUP>(F, ed, 33 * 16, 2048, 1024, 8, 8, rot);
        run_gemm<M_CNORM>(F, ed, 144 * 8, 1280, 1024, 8, 8, rot); }
#endif
    SEAM(2);
#if defined(PROBE) && (PROBE & 2)
    if (IN(4) && args.probe) { p4_attention(F, args.probe); }
#endif
    if (IN(4)) { rot = 0; p4_attention(F, 0); RF(); for (int L = F.vcu; L < 32; L += F.G) p4_finalize_q_head(F, L >> 1); asm volatile("s_waitcnt vmcnt(0)" ::: "memory"); __syncthreads(); run_gemm<M_QABS>(F, ep, 32, 512, 512, 4, 4, rot); run_gemm<M_CNORM>(F, ep, 128 * 8, 1280, 1024, 8, 8, rot); }
    SEAM(4);
    if (IN(5)) { rot = 0; run_gemm<M_S>(F, ep, 144, 1280, 1280, 10, 10, rot); if (F.G == 256) { const bool sc = F.vcu < 144;
            run_gemm_cg<M_GLA_A>(F, ep, F.vcu, sc ? 384 : 112, 384, 512, 512, 4); }
        else run_gemm<M_GLA_A>(F, ep, 384, 512, 512, 4, 4, rot); }
    SEAM(5);
    const bool wwin = (F.G == 256);
    constexpr int J6 = 4000, J8 = 9500, J10 = 13100;
    if (IN(6)) { rot = 0; run_gemm<M_PC>(F, ep, 96, 4608, 4608, 12, 12, rot); RF(); p6_softmax_scan(F); if (wwin && F.vcu >= 96) p9_ffn_weights(F, 0, J6, F.vcu - 96, 160); }
    SEAM(6);
    if (IN(7)) { { int r2 = 0; run_gemm<M_GLA_O>(F, ep, 512, 512, 512, 4, 4, r2); } RF(); p8_pc_convert(F); }
    SEAM(7);
    const int x_nx = __builtin_amdgcn_readfirstlane((int)MISC[8 + 1]), x_minc = __builtin_amdgcn_readfirstlane((int)MISC[8 + 2]);
    const int x_xi = __builtin_amdgcn_readfirstlane((int)MISC[8 + 3]), x_rank = __builtin_amdgcn_readfirstlane((int)MISC[8 + 4]);
    const bool xl = (N_LAUNCHES == 1) && XCD_LOCAL_TAIL && F.G == 256 && x_nx == 8 && x_minc == 32;
    unsigned* lctr = (unsigned*)(F.ws + WS_CTL) + 7680;
#define T0() (F.wave == 0 && lane_id_() == 0)
    if (IN(8)) { rot = 0; run_gemm<M_O>(F, ep, 16, 1024, 1024, 8, 8, rot); RF(); p9_gla_sample(F); RF(); p10_mix(F, 0, SEQ, F.vcu, F.G); RF(); if (wwin) { if (F.vcu >= 16) p9_ffn_weights(F, J6, J8, F.vcu - 16, 240); } else p9_ffn_weights(F, 0, 16384, F.vcu, F.G); }
#if defined(PROBE) && (PROBE & 32)
    if (IN(8) && args.probe) { p9_ffn_weights(F, 0, 16384, F.vcu, F.G); }
#endif
    SEAM(8);
    if (!xl) { if (IN(9)) { p10_mix(F, SEQ, NTOK, F.vcu, F.G); }
    SEAM(9); }
#if defined(PROBE) && (PROBE & 512)
    if (IN(10) && args.probe) { rot = 0; run_gemm<M_WO>(F, ep, 32 * 8, 4096, 4096, 32, 32, rot); }
#endif
    if (IN(10)) {
        if (xl) { p10_mix(F, SEQ, NTOK, x_rank, 32); xcd_local_join(lctr + 384 + x_xi * 8, 32u, bar.bar, T0()); RF(); }
        { const int c = xl ? (x_rank < 8 ? x_rank * 8 + x_xi : 64) : F.vcu, st = xl ? 64 : F.G; run_gemm_cg<M_WO_S>(F, ep, c, st, 64, 4096, 4096, 4); }
        if (xl && x_rank < 8) { xcd_local_join(lctr + x_xi * 8, 8u, bar.bar, T0()); RF(); t_local_wo(F, x_xi, x_rank); }
        rot = 64 % F.G; run_gemm<M_WO>(F, ep, 32 * 8, 4096, 4096, 32, 32, rot); RF();
        if (xl) { if (x_rank >= 8) p9_ffn_weights(F, J8, J10, x_xi * 24 + x_rank - 8, 192); }
        else if (wwin && F.vcu >= 64) p9_ffn_weights(F, J8, J10, F.vcu - 64, 192); }
    SEAM(10);
    if (!xl) { if (IN(11)) { t_reduce_wo(F); }
        SEAM(11); }
#if defined(PROBE) && (PROBE & 512)
    if (IN(12) && args.probe) { rot = 0; run_gemm<M_UP>(F, ep, 32 * 32, 4096, 4096, 32, 32, rot); }
#endif
#if defined(PROBE) && (PROBE & 1024)
    if (IN(12) && args.probe) { rot = 0; run_gemm<M_UP>(F, ep, 32 * 32, 4096, 4096, 32, 32, rot); }
#endif
#if defined(PROBE) && (PROBE & 2048)
    if (IN(12) && args.probe) { EP ed = ep; ed.dry = args.probe + 1; rot = 0; run_gemm<M_UP>(F, ed, 32 * 32, 4096, 4096, 32, 32, rot); }
#endif
#if defined(PROBE) && (PROBE & 4096)
    if (IN(12) && args.probe) { EP ed = ep; ed.dry = args.probe; rot = 0; run_gemm<M_UP>(F, ed, 32 * 32, 4096, 4096, 32, 32, rot); }
#endif
    if (IN(12)) {
        const int upn = x_xi * 4 + (x_rank >> 2), uks = x_rank & 3;
        { const int c = xl ? (x_rank < 16 ? uks * 32 + upn : 128) : F.vcu, st = xl ? 128 : F.G; run_gemm_cg<M_UP_S>(F, ep, c, st, 128, 4096, 4096, 8); }
        if (xl && x_rank < 16) { xcd_local_join(lctr + 64 + upn * 8, 4u, bar.bar, T0()); RF(); t_local_up(F, upn, uks); }
        rot = 128 % F.G; run_gemm<M_UP>(F, ep, 32 * 32, 4096, 4096, 32, 32, rot, 1); RF();
        if (xl) { if (x_rank >= 16) p9_ffn_weights(F, J10, 16384, x_xi * 16 + x_rank - 16, 128); }
        else if (wwin && F.vcu >= 128) p9_ffn_weights(F, J10, 16384, F.vcu - 128, 128); }
    SEAM(12);
    if (!xl) { if (IN(13)) { t_reduce_up(F); }
        SEAM(13); }
    if (IN(14)) {
        { const int c = xl ? (x_rank < 16 ? x_rank * 8 + x_xi : 128) : F.vcu, st = xl ? 128 : F.G; run_gemm_cg<M_DOWN_S>(F, ep, c, st, 128, 16384, 16384, 8); }
        if (xl && x_rank < 16) { xcd_local_join(lctr + 320 + x_xi * 8, 16u, bar.bar, T0()); RF(); t_local_down(F, x_xi, x_rank); }
        rot = 128 % F.G; run_gemm<M_DOWN>(F, ep, 32 * 8, 16384, 16384, 128, 128, rot); }
    if (!xl) { SEAM(14);
        if (IN(15)) { t_reduce_down(F); } }
#undef T0
#undef IN
#undef SEAM
}

extern "C" void kernel_launch(void* const* d_in, const int* in_sizes, int n_in, void* d_out, int out_size, void* d_ws, size_t ws_size, hipStream_t stream) {
    static int grid = 0;
    if (grid == 0) {
        if (n_in != 22 || out_size != (int)O_END || ws_size < WS_END) { fprintf(stderr, "kernel_launch: unexpected shapes (n_in %d out %d ws %zu)\n", n_in, out_size, ws_size); grid = -1; return; }
        int dev = 0, cus = 0, per_cu = 0;
        if (hipGetDevice(&dev) != hipSuccess || hipDeviceGetAttribute(&cus, hipDeviceAttributeMultiprocessorCount, dev) != hipSuccess) { grid = -1; return; }
        if (hipFuncSetAttribute((const void*)mega_fwd, hipFuncAttributeMaxDynamicSharedMemorySize, LDS_BYTES) != hipSuccess) { fprintf(stderr, "kernel_launch: hipFuncSetAttribute failed\n"); grid = -1; return; }
        if (hipOccupancyMaxActiveBlocksPerMultiprocessor(&per_cu, (const void*)mega_fwd, 512, LDS_BYTES) != hipSuccess || per_cu < 1) { fprintf(stderr, "kernel_launch: occupancy query says %d blocks per CU\n", per_cu); (void)hipGetLastError(); grid = -1; return; }
        grid = cus;
    }
    if (grid < 0) return;
    (void)hipMemsetAsync((char*)d_ws + WS_CTL, 0, 32768, stream);
    Args a{};
    for (int i = 0; i < 22; ++i) a.in[i] = (const float*)d_in[i];
    a.out = (float*)d_out; a.ws = (unsigned char*)d_ws;
#ifdef PROBE
    a.probe = 1;
#endif
    for (int k = 0; k < 32; ++k) a.freq[k] = powf(10000.f, -(float)k / 32.f);
    if (N_LAUNCHES == 1) { a.ph_lo = 0; a.ph_hi = N_PHASES; a.li = 0; hipLaunchKernelGGL(mega_fwd, dim3(grid), dim3(512), LDS_BYTES, stream, a); }
    else { for (int p = 0; p < N_PHASES; ++p) { a.ph_lo = p; a.ph_hi = p + 1; a.li = p; hipLaunchKernelGGL(mega_fwd, dim3(grid), dim3(512), LDS_BYTES, stream, a); } }
}
```

```cpp
#include <hip/hip_runtime.h>
#include <hip/hip_bf16.h>
#include <cstdio>
#include <cstdint>

#define LAS __attribute__((address_space(3)))
#define GAS __attribute__((address_space(1)))
typedef unsigned short bf16_t;
typedef short bf16x8 __attribute__((ext_vector_type(8)));
typedef short s16x4 __attribute__((ext_vector_type(4)));
typedef float f32x4 __attribute__((ext_vector_type(4)));
typedef float f32x2 __attribute__((ext_vector_type(2)));
typedef float f32x16 __attribute__((ext_vector_type(16)));
typedef unsigned u32x4 __attribute__((ext_vector_type(4)));
typedef unsigned u32x2 __attribute__((ext_vector_type(2)));

constexpr int DM = 2048, SEQ = 8192, NSAMP = 256, NTOK = 8448, NZ = 11520, DFF = 8192, DIN = 11344;
constexpr int NH = 16, QKD = 192, NOPE = 128, ROPE = 64, VD = 128, QR = 512, KVR = 512;
constexpr int GH = 4, GDK = 256, GDV = 512, GC = 256, NCH = 32;
constexpr int PAST = 2048, NKEY = 2064, NKP = 2304, DQC = 640, DECB = 16, DECS = 16;
constexpr float EPS = 1e-6f;
constexpr float LOG2E = 1.4426950408889634f;
constexpr float MLA_SCALE = 0.07216878364870322f;

constexpr size_t MiB = 1u << 20;
constexpr size_t WS_CTL = 0, CTL_BYTES = 1 * MiB;
constexpr size_t WS_FSM = 1 * MiB;
constexpr size_t WS_WSM = 7 * MiB;
constexpr size_t WS_ZL = 30 * MiB, WS_ZM = 47 * MiB, WS_ZQK = 52 * MiB, WS_ZV = 85 * MiB, WS_ZOG = 118 * MiB, WS_ZGM = 151 * MiB, WS_ZGG = 184 * MiB;
constexpr size_t WS_R1 = 217 * MiB, WS_R2 = 267 * MiB, WS_R3 = 300 * MiB, WS_R4 = 345 * MiB, WS_R5 = 381 * MiB, WS_END = 413 * MiB;
constexpr size_t F_SSQ_QL = 0  , F_SSQ_KV = F_SSQ_QL + 16896  , F_SSQ_X1 = F_SSQ_KV + 16896  , F_KRSS = F_SSQ_X1 + 67584, F_SSQ_K = F_KRSS + 8448  ,
                 F_SSQ_OG = F_SSQ_K + 135168  , F_KNSS_C = F_SSQ_OG + 135168, F_KRSS_C = F_KNSS_C + 589824, F_GAMMA = F_KRSS_C + 36864, F_ROPE = F_GAMMA + 32768, F_END = F_ROPE + 524288;
static_assert(F_END * 4 <= 6 * MiB, "FSM");
constexpr size_t W_UQ = 0, W_UKVG = W_UQ + 3072 * 512, W_KNP = W_UKVG + 4096 * 512, W_VP = W_KNP + 2048 * 512, W_KNABS = W_VP + 2048 * 512, W_O = W_KNABS + 16 * 512 * 256, W_END = W_O + 2048 * 2048;
static_assert(W_END * 2 <= 23 * MiB, "WSM");
constexpr size_t O_Y = 0, O_CKVP = 17301504, O_KRP = 21495808, O_STP = 22020096, O_CKVS = 22544384, O_KRS = 22675456, O_STS = 22691840, O_END = 31080448;

#define RLX_AGENT __ATOMIC_RELAXED, __HIP_MEMORY_SCOPE_AGENT
__device__ __forceinline__ unsigned cvt_pk_bf16(float lo, float hi) { unsigned r; asm volatile("v_cvt_pk_bf16_f32 %0, %1, %2" : "=v"(r) : "v"(lo), "v"(hi)); return r; }
__device__ __forceinline__ float bf2f(unsigned short b) { return __uint_as_float(((unsigned)b) << 16); }
__device__ __forceinline__ float bflo(unsigned w) { return __uint_as_float(w << 16); }
__device__ __forceinline__ float bfhi(unsigned w) { return __uint_as_float(w & 0xffff0000u); }
__device__ __forceinline__ unsigned short f2bf(float f) { return (unsigned short)(cvt_pk_bf16(f, 0.f) & 0xffffu); }
__device__ __forceinline__ float sigmoidf_(float x) { return 1.f / (1.f + __expf(-x)); }
__device__ __forceinline__ int lane_id_() { int l_; asm volatile("v_mbcnt_lo_u32_b32 %0, -1, 0\n\tv_mbcnt_hi_u32_b32 %0, -1, %0" : "=v"(l_)); return l_; }
__device__ __forceinline__ float wave_sum(float v) {
#pragma unroll
    for (int o = 1; o < 64; o <<= 1) v += __shfl_xor(v, o);
    return v;
}
__device__ __forceinline__ float wave_max(float v) {
#pragma unroll
    for (int o = 1; o < 64; o <<= 1) v = fmaxf(v, __shfl_xor(v, o));
    return v;
}

#ifndef XCD_LOCAL_TAIL
#define XCD_LOCAL_TAIL 1
#endif
#define XB_TMO      128
#define XB_XCNT(j)  (256  + 64 * (j))
#define XB_XSUB(j)  (1280 + 64 * (j))
#define XB_XGEN(j)  (2304 + 64 * (j))
#define XB_TOP      3328
#define XB_TOPGEN   3392
#define XCD_BAR_WORDS 3456
#define XB_SPIN_CAP (1u << 22)
__device__ __forceinline__ unsigned xb_ld(unsigned* p)              { return __hip_atomic_load(p, __ATOMIC_RELAXED, __HIP_MEMORY_SCOPE_AGENT); }
__device__ __forceinline__ unsigned xb_add(unsigned* p, unsigned v) { return __hip_atomic_fetch_add(p, v, __ATOMIC_RELAXED, __HIP_MEMORY_SCOPE_AGENT); }
__device__ __forceinline__ unsigned xb_xcc_id() { return (unsigned)__builtin_amdgcn_s_getreg((3 << 11) | 20) & 0xFu; }
#define XB_SPIN(cond, bar) do { unsigned _sp = 0; while (cond) { __builtin_amdgcn_s_sleep(1); \
    if ((++_sp & 255u) == 0u) { if (xb_ld(&(bar)[XB_TMO])) break; if (_sp > XB_SPIN_CAP) { atomicAdd(&(bar)[XB_TMO], 1u); break; } } } } while (0)
struct XcdBarrier { unsigned* bar; unsigned x; volatile LAS unsigned* st; };
__device__ __forceinline__ XcdBarrier xcd_barrier_post(unsigned* bar, volatile LAS unsigned* st, bool t0) {
    XcdBarrier b; b.bar = bar; b.x = xb_xcc_id(); b.st = st;
    if (t0) st[4] = xb_add(&bar[XB_XCNT(b.x)], 1u);
    return b;
}
__device__ __forceinline__ void xcd_barrier_complete(unsigned* bar, unsigned x, unsigned& nloc, unsigned& nx, unsigned& minc, unsigned& xi) {
    const unsigned G = gridDim.x * gridDim.y * gridDim.z;
    unsigned sum, cnt, mine, mn, below, sp = 0u;
    for (;;) {
        sum = 0u; cnt = 0u; mine = 0u; mn = ~0u; below = 0u;
#pragma unroll
        for (unsigned j = 0; j < 16; ++j) { const unsigned c = xb_ld(&bar[XB_XCNT(j)]); sum += c; cnt += (c > 0u) ? 1u : 0u; mine = (j == x) ? c : mine; mn = (c > 0u && c < mn) ? c : mn; below += (c > 0u && j < x) ? 1u : 0u; }
        if (sum == G) break;
        __builtin_amdgcn_s_sleep(1);
        if ((++sp & 255u) == 0u) { if (xb_ld(&bar[XB_TMO])) break; if (sp > XB_SPIN_CAP) { atomicAdd(&bar[XB_TMO], 1u); break; } }
    }
    nloc = mine > 0u ? mine : 1u; nx = cnt > 0u ? cnt : 1u; minc = mn; xi = below;
}
__device__ __forceinline__ void xcd_local_join(unsigned* ctr, unsigned target, unsigned* bar, bool t0) {
    asm volatile("s_waitcnt vmcnt(0)" ::: "memory");
    __syncthreads();
    if (t0) {
        __builtin_amdgcn_s_waitcnt(0);
        (void)xb_add(ctr, 1u);
        XB_SPIN(xb_ld(ctr) < target, bar);
        __builtin_amdgcn_fence(__ATOMIC_ACQUIRE, "agent");
        asm volatile("s_waitcnt vmcnt(0)" ::: "memory");
    }
    __syncthreads();
}
__device__ __forceinline__ void xcd_barrier(const XcdBarrier& b, bool t0) {
    asm volatile("s_waitcnt vmcnt(0)" ::: "memory");
    __syncthreads();
    if (t0) {
        unsigned* bar = b.bar;
        __builtin_amdgcn_s_waitcnt(0);
        unsigned nloc = b.st[0], nx = b.st[1];
        if (nloc == 0u) { unsigned minc, xi; xcd_barrier_complete(bar, b.x, nloc, nx, minc, xi); b.st[0] = nloc; b.st[1] = nx; b.st[2] = minc; b.st[3] = xi; }
        const unsigned old = xb_add(&bar[XB_XSUB(b.x)], 1u);
        const unsigned gen = old / nloc;
        if (old + 1u == (gen + 1u) * nloc) {
            __builtin_amdgcn_fence(__ATOMIC_RELEASE, "agent");
            asm volatile("s_waitcnt vmcnt(0)" ::: "memory");
            const unsigned og = xb_add(&bar[XB_TOP], 1u);
            const unsigned tg = og / nx;
            if (og + 1u == (tg + 1u) * nx) xb_add(&bar[XB_TOPGEN], 1u);
            else XB_SPIN(xb_ld(&bar[XB_TOPGEN]) == tg, bar);
            __builtin_amdgcn_fence(__ATOMIC_ACQUIRE, "agent");
            xb_add(&bar[XB_XGEN(b.x)], 1u);
            asm volatile("s_waitcnt vmcnt(0)" ::: "memory");
        } else {
            XB_SPIN(xb_ld(&bar[XB_XGEN(b.x)]) == gen, bar);
            __builtin_amdgcn_fence(__ATOMIC_ACQUIRE, "agent");
            asm volatile("s_waitcnt vmcnt(0)" ::: "memory");
        }
    }
    __syncthreads();
}

constexpr int RING_BYTES = 131072, LDSCTL_OFF = RING_BYTES, MISC_OFF = LDSCTL_OFF + 320, LDS_BYTES = 147456;

struct Frame {
    LAS unsigned char* lds; unsigned char* ws; float* out; const float* const* in;
    int tid, lane, wave, vcu, G;
};

namespace pg8 {
constexpr int BM = 256, BK = 64, HALF = 128, HTB = HALF * BK * 2, STAGE_BYTES = 8 * HTB;
__device__ __forceinline__ int lds_byte(int r, int c) { const int st = (r >> 4) * 2 + (c >> 5), rr = r & 15, cc = c & 31, ob = rr * 64 + cc * 2; return st * 1024 + (ob ^ (((ob >> 9) & 1) << 5)); }
__device__ __forceinline__ void stage_rc(int b, int& R, int& C) { const int st = b / 1024, sb = b % 1024, swz = sb ^ (((sb >> 9) & 1) << 5); R = (st >> 1) * 16 + swz / 64; C = (st & 1) * 32 + (swz % 64) / 2; }
__device__ __forceinline__ int perm32(int rho) { const int n = rho >> 4, i = rho & 15; return 8 * (i >> 2) + 4 * n + (i & 3); }

struct GUnit { const char* A; const char* B; int pm, pn, aux; };
struct GCfg { unsigned lda, ldb; int nt, t1; };

typedef f32x4 Acc[2][2][4][2];

template <class Epi, class Sched>
__device__ __forceinline__ void gemm_phase(LAS unsigned char* lds, const GCfg g, const Sched& S, const Epi& E, int wave) {
    int lane_ = lane_id_(); asm volatile("" : "+v"(lane_));
    const int wid = wave, lane = lane_, tid = wid * 64 + lane, wr = wid >> 2, wc = wid & 3, fr = lane & 15, fq = lane >> 4;
    const int nt = g.nt;
    unsigned voffA[2], voffB[2];
#pragma unroll
    for (int i = 0; i < 2; ++i) { int R, C; stage_rc(tid * 16 + i * 8192, R, C); const int Rb = (R & ~31) + perm32(R & 31);
        voffA[i] = (unsigned)R * g.lda + (unsigned)C * 2u; voffB[i] = (unsigned)Rb * g.ldb + (unsigned)C * 2u; }
    const size_t kstep = (size_t)(BK * 2);
    const size_t hstepA = (size_t)HALF * g.lda, hstepB = (size_t)HALF * g.ldb;
    const unsigned ldsw = (unsigned)wid * 1024u;
    const int aoff = lds_byte(wr * 64 + fr, fq * 8), boff = lds_byte(wc * 32 + fr, fq * 8);
#define PG8_SA(b, h) (((b) * 2 + (h)) * HTB)
#define PG8_SB(b, h) ((4 + (b) * 2 + (h)) * HTB)
#define PG8_STAGE(bufoff, gbase, voff) do { _Pragma("unroll") for (int _i = 0; _i < 2; ++_i) \
        __builtin_amdgcn_global_load_lds((const unsigned*)((const char*)(gbase) + (voff)[_i]), (LAS unsigned*)(lds + (bufoff) + ldsw + _i * 8192), 16, 0, 0); } while (0)
#define PG8_LDA(dst, b, h) do { _Pragma("unroll") for (int m = 0; m < 4; ++m) _Pragma("unroll") for (int k = 0; k < 2; ++k) dst[m][k] = *(const LAS bf16x8*)(lds + PG8_SA(b, h) + aoff + m * 2048 + k * 1024); } while (0)
#define PG8_LDB(dst, b, h) do { _Pragma("unroll") for (int n = 0; n < 2; ++n) _Pragma("unroll") for (int k = 0; k < 2; ++k) dst[n][k] = *(const LAS bf16x8*)(lds + PG8_SB(b, h) + boff + n * 2048 + k * 1024); } while (0)
#define PG8_MMA(ai, bj, At, Bt) do { __builtin_amdgcn_s_setprio(1); _Pragma("unroll") for (int m = 0; m < 4; ++m) _Pragma("unroll") for (int n = 0; n < 2; ++n) _Pragma("unroll") for (int k = 0; k < 2; ++k) \
        acc[ai][bj][m][n] = __builtin_amdgcn_mfma_f32_16x16x32_bf16(Bt[n][k], At[m][k], acc[ai][bj][m][n], 0, 0, 0); __builtin_amdgcn_s_setprio(0); } while (0)
#define PG8_WAIT_V(n) asm volatile("s_waitcnt vmcnt(" #n ")" ::: "memory")
#define PG8_WAIT_L(n) asm volatile("s_waitcnt lgkmcnt(" #n ")" ::: "memory")
#define PG8_BAR __builtin_amdgcn_s_barrier()
#define PG8_SCHED __builtin_amdgcn_sched_barrier(0)
#define PG8_APTR(u, t) ((u).A + (size_t)(t) * kstep)
#define PG8_BPTR(u, t) ((u).B + (size_t)(t) * kstep)
    GUnit cur, nxt; int ui = 0;
    if (!S.next(0, cur)) return;
    Acc acc;
#pragma unroll
    for (int a = 0; a < 2; ++a)
#pragma unroll
        for (int b = 0; b < 2; ++b)
#pragma unroll
            for (int m = 0; m < 4; ++m)
#pragma unroll
                for (int n = 0; n < 2; ++n) acc[a][b][m][n] = (f32x4){0.f, 0.f, 0.f, 0.f};
    bf16x8 At[4][2], B0[2][2], B1[2][2];
    {
        const char* cA = cur.A; const char* cB = cur.B;
        PG8_STAGE(PG8_SB(0, 0), cB, voffB); PG8_STAGE(PG8_SB(0, 1), cB + hstepB, voffB); PG8_STAGE(PG8_SA(0, 0), cA, voffA); PG8_STAGE(PG8_SA(0, 1), cA + hstepA, voffA);
        if (wr == 1) PG8_BAR;
        PG8_WAIT_V(2); PG8_BAR;
        PG8_STAGE(PG8_SB(1, 0), cB + kstep, voffB); PG8_STAGE(PG8_SA(1, 0), cA + kstep, voffA); PG8_STAGE(PG8_SB(1, 1), cB + hstepB + kstep, voffB);
        PG8_WAIT_V(6); PG8_BAR;
    }
    for (;;) {
        const bool has_next = S.next(ui + 1, nxt);
        if (!has_next) nxt = cur;
        for (int t = 0; t < nt; t += 2) {
            const bool last = (t == nt - 2);
            const char* a1 = PG8_APTR(cur, t + 1);
            const char* a2 = last ? nxt.A : PG8_APTR(cur, t + 2); const char* b2 = last ? nxt.B : PG8_BPTR(cur, t + 2);
            const char* a3 = last ? nxt.A + kstep : PG8_APTR(cur, t + 3); const char* b3 = last ? nxt.B + kstep : PG8_BPTR(cur, t + 3);
            PG8_LDB(B0, 0, 0); PG8_LDB(B1, 0, 1); PG8_SCHED; PG8_LDA(At, 0, 0); PG8_STAGE(PG8_SA(1, 1), a1 + hstepA, voffA);
            PG8_WAIT_V(8); PG8_WAIT_L(0); PG8_BAR; PG8_MMA(0, 0, At, B0); PG8_MMA(0, 1, At, B1); PG8_BAR; PG8_SCHED;
            PG8_LDA(At, 0, 1); PG8_STAGE(PG8_SB(0, 0), b2, voffB); PG8_STAGE(PG8_SB(0, 1), b2 + hstepB, voffB); PG8_STAGE(PG8_SA(0, 0), a2, voffA);
            PG8_WAIT_V(8); PG8_WAIT_L(0); PG8_BAR; PG8_MMA(1, 0, At, B0); PG8_MMA(1, 1, At, B1); PG8_BAR; PG8_SCHED;
            PG8_LDB(B0, 1, 0); PG8_LDB(B1, 1, 1); PG8_SCHED; PG8_LDA(At, 1, 0); PG8_STAGE(PG8_SA(0, 1), a2 + hstepA, voffA);
            PG8_WAIT_V(8); PG8_WAIT_L(0); PG8_BAR; PG8_MMA(0, 0, At, B0); PG8_MMA(0, 1, At, B1); PG8_BAR; PG8_SCHED;
            PG8_LDA(At, 1, 1); PG8_STAGE(PG8_SB(1, 0), b3, voffB); PG8_STAGE(PG8_SB(1, 1), b3 + hstepB, voffB); PG8_STAGE(PG8_SA(1, 0), a3, voffA);
            PG8_WAIT_V(8); PG8_WAIT_L(0); PG8_BAR; PG8_MMA(1, 0, At, B0); PG8_MMA(1, 1, At, B1); PG8_BAR; PG8_SCHED;
        }
        if (wr == 0) PG8_BAR;
        { int fr_ = fr, fq_ = fq; asm volatile("" : "+v"(fr_), "+v"(fq_));
          E(acc, cur, wr, wc, fr_, fq_); }
        if (!has_next) break;
#pragma unroll
        for (int a = 0; a < 2; ++a)
#pragma unroll
            for (int b = 0; b < 2; ++b)
#pragma unroll
                for (int m = 0; m < 4; ++m)
#pragma unroll
                    for (int n = 0; n < 2; ++n) acc[a][b][m][n] = (f32x4){0.f, 0.f, 0.f, 0.f};
        cur = nxt; ++ui;
        if (wr == 1) PG8_BAR;
    }
    PG8_WAIT_V(0);
    PG8_BAR;
#undef PG8_SA
#undef PG8_SB
#undef PG8_STAGE
#undef PG8_LDA
#undef PG8_LDB
#undef PG8_MMA
#undef PG8_WAIT_V
#undef PG8_WAIT_L
#undef PG8_BAR
#undef PG8_SCHED
#undef PG8_APTR
#undef PG8_BPTR
}

__device__ __forceinline__ void tile_of(int L, int nM, int nN, int& pm, int& pn) {
    const int nig = 8 * nN, gid = L / nig, fm = gid * 8, gsz = (nM - fm) < 8 ? (nM - fm) : 8, r = L % nig;
    pm = fm + r % gsz; pn = r / gsz;
}
}

enum { M_INPROJ = 0, M_QUP, M_KVUP, M_CNORM, M_QABS, M_S, M_PC, M_O, M_GLA_A, M_GLA_DS, M_GLA_O, M_GLA_O2, M_WO, M_UP, M_DOWN, M_WO_S, M_UP_S, M_DOWN_S };

struct EP { unsigned char* ws; float* out; const float* xp; const float* xs; const float* gqn; const float* gqr; const float* gkn; const float* gkr; LAS unsigned char* lds; int dry; };
constexpr int EPI_RED_OFF = 131072 + 1024;

__device__ __forceinline__ u32x4 pack8(const f32x4 v0, const f32x4 v1) {
    u32x4 w; w.x = cvt_pk_bf16(v0[0], v0[1]); w.y = cvt_pk_bf16(v0[2], v0[3]); w.z = cvt_pk_bf16(v1[0], v1[1]); w.w = cvt_pk_bf16(v1[2], v1[3]); return w;
}
#ifndef WT_STORES
#define WT_STORES 0
#endif
__device__ __forceinline__ void st16(void* ptr, const u32x4 v) {
#if WT_STORES
    asm volatile("global_store_dwordx4 %0, %1, off sc1\n\ts_nop 1" :: "v"(ptr), "v"(v) : "memory");
#else
    *(u32x4*)ptr = v;
#endif
}
__device__ __forceinline__ float sumsq8(const f32x4 a, const f32x4 b) {
    return (a[0] * a[0] + a[1] * a[1]) + (a[2] * a[2] + a[3] * a[3]) + (b[0] * b[0] + b[1] * b[1]) + (b[2] * b[2] + b[3] * b[3]);
}
__device__ __forceinline__ float red_fq(float s) { s += __shfl_xor(s, 16); s += __shfl_xor(s, 32); return s; }


__device__ __forceinline__ void epi_red_put(LAS unsigned char* lds, int slot, const float (&part)[2][4], int rt0, int wc, int fq) {
    LAS float* red = (LAS float*)(lds + EPI_RED_OFF) + slot * 1024;
    if (fq == 0) {
#pragma unroll
        for (int ai = 0; ai < 2; ++ai)
#pragma unroll
            for (int m = 0; m < 4; ++m) red[(rt0 + ai * 128 + m * 16) * 4 + wc] = part[ai][m];
    }
}
__device__ __forceinline__ void epi_red_sync() { asm volatile("s_waitcnt lgkmcnt(0)" ::: "memory"); __builtin_amdgcn_s_barrier(); asm volatile("" ::: "memory"); }
__device__ __forceinline__ float epi_red_get(LAS unsigned char* lds, int slot, int row) {
    const LAS f32x4* red = (const LAS f32x4*)(lds + EPI_RED_OFF) + slot * 256; const f32x4 v = red[row]; return (v[0] + v[1]) + (v[2] + v[3]);
}

template <int MODE> struct Epi {
    EP p;
    __device__ __forceinline__ void operator()(const pg8::Acc& acc, const pg8::GUnit& u, int wr, int wc, int fr, int fq) const {
        unsigned char* ws = p.ws;
        float* fsm = (float*)(ws + WS_FSM);
#ifdef PROBE
        if (p.dry == 1) {
#pragma unroll
            for (int a = 0; a < 2; ++a)
#pragma unroll
                for (int b = 0; b < 2; ++b)
#pragma unroll
                    for (int m = 0; m < 4; ++m) asm volatile("" :: "v"(acc[a][b][m][0]), "v"(acc[a][b][m][1]));
            return; }
#endif
        const int rt0 = wr * 64 + fr;
        const int ct0 = wc * 32 + 8 * fq;
        if constexpr (MODE == M_INPROJ) {
            const int pn = u.pn;
            if (pn >= 20 && pn < 36) {
                bf16_t* base = (bf16_t*)(ws + WS_ZGG) + (pn - 20) * 128 + ct0;
#pragma unroll
                for (int ai = 0; ai < 2; ++ai)
#pragma unroll
                    for (int m = 0; m < 4; ++m) {
                        const int row = u.pm * 256 + rt0 + ai * 128 + m * 16;
                        f32x4 o0, o1;
#pragma unroll
                        for (int i = 0; i < 4; ++i) { const float g0 = acc[ai][0][m][0][i], g1 = acc[ai][0][m][1][i], x0 = acc[ai][1][m][0][i], x1 = acc[ai][1][m][1][i];
                            o0[i] = sigmoidf_(g0) * x0 * sigmoidf_(x0); o1[i] = sigmoidf_(g1) * x1 * sigmoidf_(x1); }
                        *(u32x4*)(base + (size_t)row * 2048) = pack8(o0, o1);
                    }
            } else {
            bf16_t* base; int ld;
            if (pn < 4) { base = (bf16_t*)(ws + WS_ZL) + pn * 256; ld = 1024; }
            else if (pn < 12) { base = (bf16_t*)(ws + WS_ZQK) + (pn - 4) * 256; ld = 2048; }
            else if (pn < 20) { base = (bf16_t*)(ws + WS_ZV) + (pn - 12) * 256; ld = 2048; }
            else if (pn < 44) { base = (bf16_t*)(ws + WS_ZGM) + (pn - 36) * 256; ld = 2048; }
            else { base = (bf16_t*)(ws + WS_ZM); ld = 256; }
            float part[2][4];
#pragma unroll
            for (int ai = 0; ai < 2; ++ai)
#pragma unroll
                for (int m = 0; m < 4; ++m) {
                    const int row = u.pm * 256 + rt0 + ai * 128 + m * 16;
                    bf16_t* rowp = base + (size_t)row * ld + ct0;
                    *(u32x4*)(rowp) = pack8(acc[ai][0][m][0], acc[ai][0][m][1]);
                    *(u32x4*)(rowp + 128) = pack8(acc[ai][1][m][0], acc[ai][1][m][1]);
                    part[ai][m] = red_fq(sumsq8(acc[ai][0][m][0], acc[ai][0][m][1]) + sumsq8(acc[ai][1][m][0], acc[ai][1][m][1]));
                }
            if (pn < 4) {
                epi_red_put(p.lds, 0, part, rt0, wc, fq); epi_red_sync();
                const int tid = (wr * 4 + wc) * 64 + fq * 16 + fr;
                if (tid < 256) fsm[(pn < 2 ? F_SSQ_QL : F_SSQ_KV) + (size_t)(u.pm * 256 + tid) * 2 + (pn & 1)] = epi_red_get(p.lds, 0, tid);
            }
            }
        } else if constexpr (MODE == M_QUP) {
            bf16_t* Qp = (bf16_t*)(ws + WS_R1);
            float* ssq = (float*)((char*)(p.out + O_Y) + 56 * MiB);
#pragma unroll
            for (int bj = 0; bj < 2; ++bj) {
                const int c = u.pn * 256 + bj * 128 + ct0, h = c / 192, j = c - h * 192;
                const int grp = u.pn * 8 + bj * 4 + wc;
#pragma unroll
                for (int ai = 0; ai < 2; ++ai)
#pragma unroll
                    for (int m = 0; m < 4; ++m) {
                        const int row = u.pm * 256 + rt0 + ai * 128 + m * 16;
                        st16(Qp + ((size_t)h * NTOK + row) * 192 + j, pack8(acc[ai][bj][m][0], acc[ai][bj][m][1]));
                        float s = red_fq(sumsq8(acc[ai][bj][m][0], acc[ai][bj][m][1]));
                        if (fq == 0) ssq[(size_t)row * 96 + grp] = s;
                    }
            }
        } else if constexpr (MODE == M_KVUP) {
            bf16_t* Kp = (bf16_t*)(p.out + O_Y); bf16_t* Vp = (bf16_t*)(ws + WS_R2);
            const float* ssq_kv = fsm + F_SSQ_KV; const bf16_t* ZM = (const bf16_t*)(ws + WS_ZM);
            const int h = u.pn, tid = (wr * 4 + wc) * 64 + fq * 16 + fr; float part[2][4], invr[2][4];
            { f32x2 sq[2][4];
#pragma unroll
              for (int ai = 0; ai < 2; ++ai)
#pragma unroll
                  for (int m = 0; m < 4; ++m) sq[ai][m] = *(const f32x2*)(ssq_kv + (size_t)(u.pm * 256 + rt0 + ai * 128 + m * 16) * 2);
              asm volatile("" ::: "memory");
#pragma unroll
              for (int ai = 0; ai < 2; ++ai)
#pragma unroll
                  for (int m = 0; m < 4; ++m) invr[ai][m] = rsqrtf((sq[ai][m][0] + sq[ai][m][1]) * (1.f / 512.f) + EPS); }
#pragma unroll
            for (int ai = 0; ai < 2; ++ai)
#pragma unroll
                for (int m = 0; m < 4; ++m) {
                    const int row = u.pm * 256 + rt0 + ai * 128 + m * 16;
                    const float inv = invr[ai][m];
                    if (row < SEQ) *(u32x4*)(Vp + ((size_t)h * SEQ + row) * 128 + ct0) = pack8(acc[ai][1][m][0] * inv, acc[ai][1][m][1] * inv);
                    part[ai][m] = red_fq(sumsq8(acc[ai][0][m][0], acc[ai][0][m][1])) * inv * inv;
                }
            epi_red_put(p.lds, 0, part, rt0, wc, fq);
            LAS float* invk_s = (LAS float*)(p.lds + EPI_RED_OFF + 8192);
            u32x4 kr[8]; const int krow = u.pm * 256 + (tid & 255);
            if (tid < 256) {
#pragma unroll
                for (int i = 0; i < 8; ++i) kr[i] = *(const u32x4*)(ZM + (size_t)krow * 256 + i * 8);
            }
            epi_red_sync();
            if (tid < 256) {
                float x[64];
#pragma unroll
                for (int i = 0; i < 8; ++i) { x[8 * i] = bflo(kr[i].x); x[8 * i + 1] = bfhi(kr[i].x); x[8 * i + 2] = bflo(kr[i].y); x[8 * i + 3] = bfhi(kr[i].y);
                    x[8 * i + 4] = bflo(kr[i].z); x[8 * i + 5] = bfhi(kr[i].z); x[8 * i + 6] = bflo(kr[i].w); x[8 * i + 7] = bfhi(kr[i].w); }
                float krss = 0.f;
#pragma unroll
                for (int i = 0; i < 64; ++i) krss += x[i] * x[i];
                const float invk = rsqrtf((epi_red_get(p.lds, 0, tid) + krss) * (1.f / 192.f) + EPS);
                invk_s[tid] = invk;
                if (krow >= SEQ) { const int r_ = krow - SEQ; fsm[F_KNSS_C + ((size_t)(r_ >> 4) * 16 + h) * NKP + PAST + (r_ & 15)] = invk; }
                if (krow < SEQ) {
                    const float* cs = fsm + F_ROPE + (size_t)krow * 64; const float* gqr = p.gqr; const float* gkr = p.gkr;
                    bf16_t* kd = Kp + ((size_t)h * SEQ + krow) * 192 + 128;
#pragma unroll
                    for (int i8 = 0; i8 < 4; ++i8) { float y1[8], y2[8];
#pragma unroll
                        for (int j = 0; j < 8; ++j) { const int i = i8 * 8 + j; const float c = cs[i], sn = cs[32 + i], g = gqr[i] * gkr[i] * invk;
                            y1[j] = (x[i] * c - x[32 + i] * sn) * g; y2[j] = (x[32 + i] * c + x[i] * sn) * g; }
                        *(u32x4*)(kd + i8 * 8) = (u32x4){cvt_pk_bf16(y1[0], y1[1]), cvt_pk_bf16(y1[2], y1[3]), cvt_pk_bf16(y1[4], y1[5]), cvt_pk_bf16(y1[6], y1[7])};
                        *(u32x4*)(kd + 32 + i8 * 8) = (u32x4){cvt_pk_bf16(y2[0], y2[1]), cvt_pk_bf16(y2[2], y2[3]), cvt_pk_bf16(y2[4], y2[5]), cvt_pk_bf16(y2[6], y2[7])}; }
                }
            }
            epi_red_sync();
            if (u.pm < 32) {
                const f32x4 g0 = *(const f32x4*)(p.gqn + ct0) * *(const f32x4*)(p.gkn + ct0), g1 = *(const f32x4*)(p.gqn + ct0 + 4) * *(const f32x4*)(p.gkn + ct0 + 4);
#pragma unroll
                for (int ai = 0; ai < 2; ++ai)
#pragma unroll
                    for (int m = 0; m < 4; ++m) {
                        const int rt = rt0 + ai * 128 + m * 16; const float ik = invk_s[rt] * invr[ai][m];
                        *(u32x4*)(Kp + ((size_t)h * SEQ + u.pm * 256 + rt) * 192 + ct0) = pack8(acc[ai][0][m][0] * ik * g0, acc[ai][0][m][1] * ik * g1);
                    }
            }
        } else if constexpr (MODE == M_CNORM) {
            float* knss = fsm + F_KNSS_C; float part[2][2][4];
#pragma unroll
            for (int bj = 0; bj < 2; ++bj)
#pragma unroll
                for (int ai = 0; ai < 2; ++ai)
#pragma unroll
                    for (int m = 0; m < 4; ++m) part[bj][ai][m] = red_fq(sumsq8(acc[ai][bj][m][0], acc[ai][bj][m][1]));
            epi_red_put(p.lds, 0, part[0], rt0, wc, fq); epi_red_put(p.lds, 1, part[1], rt0, wc, fq); epi_red_sync();
            { const int tid = (wr * 4 + wc) * 64 + fq * 16 + fr, row = tid & 255, bj = tid >> 8; const int R = u.pm * 256 + row, b = R / NKP, k = R - b * NKP, h = u.pn * 2 + bj;
              knss[((size_t)b * 16 + h) * NKP + k] = rsqrtf((epi_red_get(p.lds, bj, row) + fsm[F_KRSS_C + R]) * (1.f / 192.f) + EPS); }
        } else if constexpr (MODE == M_QABS) {
            bf16_t* Qcat = (bf16_t*)(p.out + O_Y) + 48 * MiB / 2;
            const int h = u.aux;
#pragma unroll
            for (int ai = 0; ai < 2; ++ai)
#pragma unroll
                for (int m = 0; m < 4; ++m) {
                    const int r = rt0 + ai * 128 + m * 16, b = r >> 4, q = r & 15;
                    bf16_t* rowp = Qcat + ((size_t)b * 256 + h * 16 + q) * DQC + u.pn * 256 + ct0;
                    *(u32x4*)(rowp) = pack8(acc[ai][0][m][0], acc[ai][0][m][1]);
                    *(u32x4*)(rowp + 128) = pack8(acc[ai][1][m][0], acc[ai][1][m][1]);
                }
        } else if constexpr (MODE == M_S) {
            bf16_t* Pb = (bf16_t*)(p.out + O_Y); const float* invk_t = fsm + F_KNSS_C; const int b = u.aux; float part[2][4];
#pragma unroll
            for (int ai = 0; ai < 2; ++ai) {
                f32x4 ia[4][2], ib[4][2];
#pragma unroll
                for (int m = 0; m < 4; ++m) { const int h = (rt0 + ai * 128 + m * 16) >> 4;
#pragma unroll
                    for (int bj = 0; bj < 2; ++bj) { const float* ik = invk_t + ((size_t)b * 16 + h) * NKP + u.pn * 256 + bj * 128 + ct0; ia[m][bj] = *(const f32x4*)ik; ib[m][bj] = *(const f32x4*)(ik + 4); } }
                asm volatile("" ::: "memory");
#pragma unroll
                for (int m = 0; m < 4; ++m) {
                    const int r = rt0 + ai * 128 + m * 16; float s_ = 0.f;
#pragma unroll
                    for (int bj = 0; bj < 2; ++bj) {
                        const int k = u.pn * 256 + bj * 128 + ct0; const f32x4 i0 = ia[m][bj], i1 = ib[m][bj];
                        f32x4 o0, o1;
#pragma unroll
                        for (int i = 0; i < 4; ++i) { o0[i] = (k + i < NKEY) ? __builtin_amdgcn_exp2f(acc[ai][bj][m][0][i] * i0[i]) : 0.f; o1[i] = (k + 4 + i < NKEY) ? __builtin_amdgcn_exp2f(acc[ai][bj][m][1][i] * i1[i]) : 0.f; }
                        *(u32x4*)(Pb + ((size_t)b * 256 + r) * NKP + k) = pack8(o0, o1);
                        s_ += ((o0[0] + o0[1]) + (o0[2] + o0[3])) + ((o1[0] + o1[1]) + (o1[2] + o1[3]));
                    }
                    part[ai][m] = red_fq(s_);
                }
            }
            epi_red_put(p.lds, 0, part, rt0, wc, fq); epi_red_sync();
            { const int tid = (wr * 4 + wc) * 64 + fq * 16 + fr; if (tid < 256) fsm[F_SSQ_K + ((size_t)b * 256 + tid) * 9 + u.pn] = epi_red_get(p.lds, 0, tid); }
        } else if constexpr (MODE == M_PC) {
            float* PCp = (float*)(ws + WS_R5);
            const int b = u.aux >> 2, ks = u.aux & 3;
#pragma unroll
            for (int ai = 0; ai < 2; ++ai)
#pragma unroll
                for (int m = 0; m < 4; ++m) {
                    const int r = rt0 + ai * 128 + m * 16, h = r >> 4, q = r & 15;
                    float* rowp = PCp + (((size_t)ks * 16 + h) * 256 + b * 16 + q) * 512 + u.pn * 256 + ct0;
#pragma unroll
                    for (int bj = 0; bj < 2; ++bj) { *(f32x4*)(rowp + bj * 128) = acc[ai][bj][m][0]; *(f32x4*)(rowp + bj * 128 + 4) = acc[ai][bj][m][1]; }
                }
        } else if constexpr (MODE == M_O) {
            bf16_t* Zgm = (bf16_t*)(ws + WS_ZGM);
            const int h = u.aux, bj = h & 1;
            u32x4 g8[2][4];
#pragma unroll
            for (int ai = 0; ai < 2; ++ai)
#pragma unroll
                for (int m = 0; m < 4; ++m) g8[ai][m] = *(const u32x4*)(Zgm + (size_t)(SEQ + rt0 + ai * 128 + m * 16) * 2048 + h * 128 + ct0);
            asm volatile("" ::: "memory");
#pragma unroll
            for (int ai = 0; ai < 2; ++ai)
#pragma unroll
                for (int m = 0; m < 4; ++m) {
                    const int r = rt0 + ai * 128 + m * 16;
                    bf16_t* gp = Zgm + (size_t)(SEQ + r) * 2048 + h * 128 + ct0;
                    const u32x4 g = g8[ai][m];
                    const f32x4 a0 = bj ? acc[ai][1][m][0] : acc[ai][0][m][0], a1 = bj ? acc[ai][1][m][1] : acc[ai][0][m][1];
                    f32x4 o0, o1;
                    o0[0] = a0[0] * sigmoidf_(bflo(g.x)); o0[1] = a0[1] * sigmoidf_(bfhi(g.x)); o0[2] = a0[2] * sigmoidf_(bflo(g.y)); o0[3] = a0[3] * sigmoidf_(bfhi(g.y));
                    o1[0] = a1[0] * sigmoidf_(bflo(g.z)); o1[1] = a1[1] * sigmoidf_(bfhi(g.z)); o1[2] = a1[2] * sigmoidf_(bflo(g.w)); o1[3] = a1[3] * sigmoidf_(bfhi(g.w));
                    *(u32x4*)gp = pack8(o0, o1);
                }
        } else if constexpr (MODE == M_GLA_A) {
          if (u.aux < 128) {
            bf16_t* Am = (bf16_t*)(ws + WS_ZQK) + (size_t)u.aux * 65536;
#pragma unroll
            for (int ai = 0; ai < 2; ++ai)
#pragma unroll
                for (int m = 0; m < 4; ++m) {
                    const int t = rt0 + ai * 128 + m * 16;
#pragma unroll
                    for (int bj = 0; bj < 2; ++bj) {
                        const int s0 = bj * 128 + ct0;
                        f32x4 a0 = acc[ai][bj][m][0], a1 = acc[ai][bj][m][1];
#pragma unroll
                        for (int i = 0; i < 4; ++i) { if (s0 + i > t) a0[i] = 0.f; if (s0 + 4 + i > t) a1[i] = 0.f; }
                        *(u32x4*)(Am + (size_t)t * 256 + s0) = pack8(a0, a1);
                        asm volatile("" ::: "memory");
                    }
                }
          } else {
            bf16_t* dS = (bf16_t*)(ws + WS_R1) + (size_t)(u.aux - 128) * 131072;
#pragma unroll
            for (int ai = 0; ai < 2; ++ai)
#pragma unroll
                for (int m = 0; m < 4; ++m) {
                    const int e = u.pm * 256 + rt0 + ai * 128 + m * 16;
                    bf16_t* rowp = dS + (size_t)e * 256 + ct0;
                    *(u32x4*)(rowp) = pack8(acc[ai][0][m][0], acc[ai][0][m][1]);
                    *(u32x4*)(rowp + 128) = pack8(acc[ai][1][m][0], acc[ai][1][m][1]);
                }
          }
        } else if constexpr (MODE == M_GLA_O) {
            bf16_t* Zv = (bf16_t*)(ws + WS_ZV); float* ssq = fsm + F_SSQ_OG;
            const bool second = (u.aux & 128) != 0; const int hc = u.aux & 127, h = hc >> 5, c = hc & 31; float part[2][4];
#pragma unroll
            for (int ai = 0; ai < 2; ++ai) {
                u32x4 wa[4], wb[4];
                if (second) {
#pragma unroll
                    for (int m = 0; m < 4; ++m) { const bf16_t* rowp = Zv + (size_t)(c * 256 + rt0 + ai * 128 + m * 16) * 2048 + h * 512 + u.pn * 256 + ct0; wa[m] = *(const u32x4*)(rowp); wb[m] = *(const u32x4*)(rowp + 128); }
                } else {
#pragma unroll
                    for (int m = 0; m < 4; ++m) { wa[m] = (u32x4){0u, 0u, 0u, 0u}; wb[m] = wa[m]; }
                }
                asm volatile("" ::: "memory");
#pragma unroll
                for (int m = 0; m < 4; ++m) {
                    const int t = c * 256 + rt0 + ai * 128 + m * 16;
                    bf16_t* rowp = Zv + (size_t)t * 2048 + h * 512 + u.pn * 256 + ct0;
                    f32x4 a0 = acc[ai][0][m][0], a1 = acc[ai][0][m][1], b0 = acc[ai][1][m][0], b1 = acc[ai][1][m][1];
                    a0[0] += bflo(wa[m].x); a0[1] += bfhi(wa[m].x); a0[2] += bflo(wa[m].y); a0[3] += bfhi(wa[m].y); a1[0] += bflo(wa[m].z); a1[1] += bfhi(wa[m].z); a1[2] += bflo(wa[m].w); a1[3] += bfhi(wa[m].w);
                    b0[0] += bflo(wb[m].x); b0[1] += bfhi(wb[m].x); b0[2] += bflo(wb[m].y); b0[3] += bfhi(wb[m].y); b1[0] += bflo(wb[m].z); b1[1] += bfhi(wb[m].z); b1[2] += bflo(wb[m].w); b1[3] += bfhi(wb[m].w);
                    *(u32x4*)(rowp) = pack8(a0, a1);
                    *(u32x4*)(rowp + 128) = pack8(b0, b1);
                    part[ai][m] = red_fq(sumsq8(a0, a1) + sumsq8(b0, b1));
                }
            }
            if (second) {
                epi_red_put(p.lds, 0, part, rt0, wc, fq); epi_red_sync();
                const int tid = (wr * 4 + wc) * 64 + fq * 16 + fr; if (tid < 256) { float* q = ssq + ((size_t)(c * 256 + tid) * 4 + h) * 4 + u.pn; q[0] = epi_red_get(p.lds, 0, tid); q[2] = 0.f; }
            }
        } else if constexpr (MODE == M_WO) {
            bf16_t* x1b = (bf16_t*)(ws + WS_R2); float* ssq = fsm + F_SSQ_X1; float part[2][4];
#pragma unroll
            for (int ai = 0; ai < 2; ++ai) {
                f32x4 xa[4][2], xb[4][2];
#pragma unroll
                for (int m = 0; m < 4; ++m) { const int row = u.pm * 256 + rt0 + ai * 128 + m * 16;
                    const float* xr = (row < SEQ ? p.xp + (size_t)row * DM : p.xs + (size_t)(row - SEQ) * DM) + u.pn * 256 + ct0;
#pragma unroll
                    for (int bj = 0; bj < 2; ++bj) { xa[m][bj] = *(const f32x4*)(xr + bj * 128); xb[m][bj] = *(const f32x4*)(xr + bj * 128 + 4); } }
                asm volatile("" ::: "memory");
#pragma unroll
                for (int m = 0; m < 4; ++m) { const int row = u.pm * 256 + rt0 + ai * 128 + m * 16; float s_ = 0.f;
#pragma unroll
                    for (int bj = 0; bj < 2; ++bj) {
                        const f32x4 x0 = xa[m][bj] + acc[ai][bj][m][0], x1 = xb[m][bj] + acc[ai][bj][m][1];
                        st16(x1b + (size_t)row * DM + u.pn * 256 + bj * 128 + ct0, pack8(x0, x1));
                        s_ += sumsq8(x0, x1);
                    }
                    part[ai][m] = red_fq(s_); }
            }
            epi_red_put(p.lds, 0, part, rt0, wc, fq); epi_red_sync();
            { const int tid = (wr * 4 + wc) * 64 + fq * 16 + fr; if (tid < 256) ssq[(size_t)(u.pm * 256 + tid) * 8 + u.pn] = epi_red_get(p.lds, 0, tid); }
        } else if constexpr (MODE == M_UP) {
            bf16_t* Hb = (bf16_t*)(ws + WS_ZL); const float* ssq = fsm + F_SSQ_X1;
            f32x4 q0[2][4], q1[2][4];
#pragma unroll
            for (int ai = 0; ai < 2; ++ai)
#pragma unroll
                for (int m = 0; m < 4; ++m) { const int row = u.pm * 256 + rt0 + ai * 128 + m * 16; q0[ai][m] = *(const f32x4*)(ssq + (size_t)row * 8); q1[ai][m] = *(const f32x4*)(ssq + (size_t)row * 8 + 4); }
            asm volatile("" ::: "memory");
#pragma unroll
            for (int ai = 0; ai < 2; ++ai)
#pragma unroll
                for (int m = 0; m < 4; ++m) {
                    const int row = u.pm * 256 + rt0 + ai * 128 + m * 16;
                    const f32x4 a_ = q0[ai][m], b_ = q1[ai][m];
                    const float inv2 = 1.f / (((a_[0] + a_[1]) + (a_[2] + a_[3]) + (b_[0] + b_[1]) + (b_[2] + b_[3])) * (1.f / 2048.f) + EPS);
#pragma unroll
                    for (int bj = 0; bj < 2; ++bj) {
                        f32x4 a0 = acc[ai][bj][m][0], a1 = acc[ai][bj][m][1];
#pragma unroll
                        for (int i = 0; i < 4; ++i) { const float r0 = fmaxf(a0[i], 0.f), r1 = fmaxf(a1[i], 0.f); a0[i] = r0 * r0 * inv2; a1[i] = r1 * r1 * inv2; }
                        st16(Hb + (size_t)row * DFF + u.pn * 256 + bj * 128 + ct0, pack8(a0, a1));
                    }
                }
        } else if constexpr (MODE == M_DOWN) {
            float* Y = p.out + O_Y; const bf16_t* x1b = (const bf16_t*)(ws + WS_R2);
#pragma unroll
            for (int ai = 0; ai < 2; ++ai) {
                u32x4 w[4][2];
#pragma unroll
                for (int m = 0; m < 4; ++m)
#pragma unroll
                    for (int bj = 0; bj < 2; ++bj) w[m][bj] = *(const u32x4*)(x1b + (size_t)(u.pm * 256 + rt0 + ai * 128 + m * 16) * DM + u.pn * 256 + bj * 128 + ct0);
                asm volatile("" ::: "memory");
#pragma unroll
                for (int m = 0; m < 4; ++m)
#pragma unroll
                    for (int bj = 0; bj < 2; ++bj) {
                        const size_t e = (size_t)(u.pm * 256 + rt0 + ai * 128 + m * 16) * DM + u.pn * 256 + bj * 128 + ct0; const u32x4 w_ = w[m][bj];
                        f32x4 y0 = acc[ai][bj][m][0], y1 = acc[ai][bj][m][1];
                        y0[0] += bflo(w_.x); y0[1] += bfhi(w_.x); y0[2] += bflo(w_.y); y0[3] += bfhi(w_.y); y1[0] += bflo(w_.z); y1[1] += bfhi(w_.z); y1[2] += bflo(w_.w); y1[3] += bfhi(w_.w);
                        *(f32x4*)(Y + e) = y0; *(f32x4*)(Y + e + 4) = y1;
                    }
            }
        } else if constexpr (MODE == M_WO_S || MODE == M_UP_S || MODE == M_DOWN_S) {
            constexpr int ld = (MODE == M_UP_S) ? DFF : DM;
            float* slab = (float*)(ws + (MODE == M_UP_S ? WS_R5 : WS_R4)) + (size_t)u.aux * 256 * ld;
#pragma unroll
            for (int ai = 0; ai < 2; ++ai)
#pragma unroll
                for (int m = 0; m < 4; ++m) {
                    float* rowp = slab + (size_t)(rt0 + ai * 128 + m * 16) * ld + u.pn * 256 + ct0;
#pragma unroll
                    for (int bj = 0; bj < 2; ++bj) { *(f32x4*)(rowp + bj * 128) = acc[ai][bj][m][0]; *(f32x4*)(rowp + bj * 128 + 4) = acc[ai][bj][m][1]; }
                }
        }
    }
};

template <int MODE> struct Sched {
    unsigned char* ws; float* out; int G, c, n;
    __device__ __forceinline__ bool next(int i, pg8::GUnit& u) const {
        int L = i * G + c;
        if constexpr (MODE == M_GLA_O) { const int j = (i >> 1) * G + c; if (j >= 256) return false; L = j + 256 * (i & 1); }
        else { if (L >= n) return false; }
        u.aux = 0;
        if constexpr (MODE == M_INPROJ) {
            pg8::tile_of(L, 33, 45, u.pm, u.pn);
            u.A = (const char*)(ws + WS_R2) + (size_t)u.pm * 256 * 4096; u.B = (const char*)(ws + WS_R1) + (size_t)u.pn * 256 * 4096;
        } else if constexpr (MODE == M_QUP) {
            pg8::tile_of(L, 33, 12, u.pm, u.pn);
            u.A = (const char*)(ws + WS_ZL) + (size_t)u.pm * 256 * 2048; u.B = (const char*)(ws + WS_WSM) + (W_UQ + (size_t)u.pn * 256 * 512) * 2;
        } else if constexpr (MODE == M_KVUP) {
            pg8::tile_of(L, 33, 16, u.pm, u.pn);
            u.A = (const char*)(ws + WS_ZL) + (size_t)u.pm * 256 * 2048 + 1024; u.B = (const char*)(ws + WS_WSM) + (W_UKVG + (size_t)u.pn * 256 * 512) * 2;
        } else if constexpr (MODE == M_CNORM) {
            pg8::tile_of(L, 128, 8, u.pm, u.pn); u.pm = (u.pm >> 3) * 9 + (u.pm & 7);
            u.A = (const char*)(ws + WS_R3) + (size_t)u.pm * 256 * (DQC * 2); u.B = (const char*)(ws + WS_WSM) + (W_KNP + (size_t)u.pn * 256 * 512) * 2;
        } else if constexpr (MODE == M_QABS) {
            const int h = L >> 1; u.pm = 0; u.pn = L & 1; u.aux = h;
            u.A = (const char*)(out + O_Y) + 53 * MiB + (size_t)h * 256 * 512; u.B = (const char*)(ws + WS_WSM) + (W_KNABS + ((size_t)h * 512 + u.pn * 256) * 256) * 2;
        } else if constexpr (MODE == M_S) {
            const int b = L / 9; u.pm = 0; u.pn = L - b * 9; u.aux = b;
            u.A = (const char*)(out + O_Y) + 48 * MiB + (size_t)b * 256 * (DQC * 2); u.B = (const char*)(ws + WS_R3) + ((size_t)b * NKP + u.pn * 256) * (DQC * 2);
        } else if constexpr (MODE == M_PC) {
            const int b = L / 6, r = L - b * 6, ks = r >> 1; u.pm = 0; u.pn = r & 1; u.aux = b * 4 + ks;
            u.A = (const char*)(out + O_Y) + ((size_t)b * 256 * NKP + ks * 768) * 2; u.B = (const char*)(ws + WS_R4) + (((size_t)b * 512 + u.pn * 256) * NKP + ks * 768) * 2;
        } else if constexpr (MODE == M_O) {
            const int h = L; u.pm = 0; u.pn = 0; u.aux = h;
            u.A = (const char*)(ws + WS_ZQK) + 16 * MiB + (size_t)h * 256 * 1024; u.B = (const char*)(ws + WS_WSM) + (W_VP + (size_t)(h & ~1) * 128 * 512) * 2;
        } else if constexpr (MODE == M_GLA_A) {
            if (L < 128) { u.pm = 0; u.pn = 0; u.aux = L;
                u.A = (const char*)(ws + WS_ZOG) + (size_t)L * 131072; u.B = (const char*)(ws + WS_R5) + (size_t)L * 131072;
            } else { const int l2 = L - 128, hc = l2 >> 1; u.pm = l2 & 1; u.pn = 0; u.aux = 128 + hc;
                u.A = (const char*)(out + O_STS) + ((size_t)hc * 512 + u.pm * 256) * 512; u.B = (const char*)(ws + WS_R5) + 16 * MiB + (size_t)hc * 131072; }
        } else if constexpr (MODE == M_GLA_O) {
            const int second = L >= 256, l2 = L & 255, hc = l2 >> 1; u.pm = 0; u.pn = l2 & 1; u.aux = hc | (second ? 128 : 0);
            if (!second) { u.A = (const char*)(ws + WS_ZQK) + (size_t)hc * 131072; u.B = (const char*)(out + O_STS) + ((size_t)hc * 512 + u.pn * 256) * 512; }
            else { u.A = (const char*)(ws + WS_ZOG) + (size_t)hc * 131072; u.B = (const char*)(ws + WS_R2) + ((size_t)hc * 512 + u.pn * 256) * 512; }
        } else if constexpr (MODE == M_WO) {
            pg8::tile_of(L, 32, 8, u.pm, u.pn);
            u.A = (const char*)(ws + WS_ZOG) + (size_t)u.pm * 256 * 4096; u.B = (const char*)(ws + WS_WSM) + (W_O + (size_t)u.pn * 256 * 2048) * 2;
        } else if constexpr (MODE == M_UP) {
            pg8::tile_of(L, 32, 32, u.pm, u.pn);
            u.A = (const char*)(ws + WS_R2) + (size_t)u.pm * 256 * 4096; u.B = (const char*)(out + O_Y) + 20 * MiB + (size_t)u.pn * 256 * 4096;
        } else if constexpr (MODE == M_DOWN) {
            pg8::tile_of(L, 32, 8, u.pm, u.pn);
            u.A = (const char*)(ws + WS_ZL) + (size_t)u.pm * 256 * 16384; u.B = (const char*)(ws + WS_R3) + (size_t)u.pn * 256 * 16384;
        } else if constexpr (MODE == M_WO_S) {
            u.pm = 0; u.pn = L & 7; u.aux = L >> 3;
            u.A = (const char*)(ws + WS_ZOG) + (size_t)SEQ * 4096 + u.aux * 512; u.B = (const char*)(ws + WS_WSM) + (W_O + (size_t)u.pn * 256 * 2048) * 2 + u.aux * 512;
        } else if constexpr (MODE == M_UP_S) {
            u.pm = 0; u.pn = L & 31; u.aux = L >> 5;
            u.A = (const char*)(ws + WS_R2) + (size_t)SEQ * 4096 + u.aux * 1024; u.B = (const char*)(out + O_Y) + 20 * MiB + (size_t)u.pn * 256 * 4096 + u.aux * 1024;
        } else if constexpr (MODE == M_DOWN_S) {
            u.pm = 0; u.pn = L & 7; u.aux = L >> 3;
            u.A = (const char*)(ws + WS_ZL) + (size_t)SEQ * 16384 + u.aux * 1024; u.B = (const char*)(ws + WS_R3) + (size_t)u.pn * 256 * 16384 + u.aux * 1024;
        }
        return true;
    }
};

#ifndef STAG_TICKS
#define STAG_TICKS 0
#endif
template <int MODE>
__device__ __forceinline__ void run_gemm_cg(Frame& F, const EP& ep, int c, int stride, int n_units, unsigned lda, unsigned ldb, int nt) {
    Sched<MODE> S; S.ws = F.ws; S.out = F.out; S.G = stride; S.c = c; S.n = n_units;
    Epi<MODE> E; E.p = ep;
    pg8::GCfg g; g.lda = lda; g.ldb = ldb; g.nt = nt; g.t1 = nt;
    pg8::gemm_phase<Epi<MODE>, Sched<MODE>>(F.lds, g, S, E, F.wave);
}
template <int MODE>
__device__ __forceinline__ void run_gemm(Frame& F, const EP& ep, int n_units, unsigned lda, unsigned ldb, int nt, int t1, int& rot, int stag = 0) {
    if (stag && STAG_TICKS) {
        const unsigned long long t0 = __builtin_amdgcn_s_memrealtime(); const unsigned long long wait = (unsigned long long)((F.vcu & 3) * STAG_TICKS);
        while (__builtin_amdgcn_s_memrealtime() - t0 < wait) __builtin_amdgcn_s_sleep(8);
    }
    Sched<MODE> S; S.ws = F.ws; S.out = F.out; S.G = F.G; S.c = (F.vcu + F.G - rot) % F.G; S.n = n_units;
    Epi<MODE> E; E.p = ep;
    pg8::GCfg g; g.lda = lda; g.ldb = ldb; g.nt = nt; g.t1 = t1;
    pg8::gemm_phase<Epi<MODE>, Sched<MODE>>(F.lds, g, S, E, F.wave);
    rot = (rot + n_units) % F.G;
}

namespace att {
constexpr int NW = 8, QBLK = 32, KVBLK = 64, QB = 256;
constexpr int SHM_V = KVBLK * 128 * 2, SHM_K = KVBLK * 192 * 2;
constexpr int NBUF = 3;
constexpr int LDS_ATT = NBUF * SHM_V + NBUF * SHM_K + NW * 64 * 4;
constexpr float THR = 8.f;
#define KSWZ(row, colB) ((row) * 384 + ((colB) ^ ((((row) >> 1) & 7) << 4)))
#define SBAR() __builtin_amdgcn_sched_barrier(0)
__device__ __forceinline__ int v_st(int k, int c) { const int kk = (k & ~0xC) | ((k & 4) << 1) | ((k & 8) >> 1); return ((kk >> 3) * 4 + (c >> 5)) * 512 + ((kk & 7) * 32 + (c & 31)) * 2; }
__device__ __forceinline__ int v_rd_base(int lane) { return ((lane & 3) << 3) | (((lane >> 2) & 3) << 6) | (((lane >> 4) & 1) << 5) | (((lane >> 5) & 1) << 8); }
constexpr int v_rd_off(int d0, int ks, int half) { return d0 * 512 + ks * 4096 + half * 2048; }
__device__ __forceinline__ int crow(int r, int hi) { return (r & 3) + 8 * (r >> 2) + 4 * hi; }
__device__ __forceinline__ unsigned cvtpk(float lo, float hi) { unsigned r; asm volatile("v_cvt_pk_bf16_f32 %0, %1, %2" : "=v"(r) : "v"(lo), "v"(hi)); return r; }

__device__ __forceinline__ void partialSM(f32x16& p0, f32x16& p1, float& m_reg, float& mn, float& alpha) {
    mn = 0.f; alpha = 1.f;
#pragma unroll
    for (int r = 0; r < 16; ++r) p0[r] = __builtin_amdgcn_exp2f(p0[r]);
}
__device__ __forceinline__ void finishSM(f32x16& p0, f32x16& p1, float alpha, float& l_reg, bf16x8& pa0, bf16x8& pa1, bf16x8& pa2, bf16x8& pa3) {
#pragma unroll
    for (int r = 0; r < 16; ++r) p1[r] = __builtin_amdgcn_exp2f(p1[r]);
    float ps = 0;
#pragma unroll
    for (int r = 0; r < 16; ++r) ps += p0[r];
#pragma unroll
    for (int r = 0; r < 16; ++r) ps += p1[r];
    { auto rr = __builtin_amdgcn_permlane32_swap(__float_as_uint(ps), __float_as_uint(ps), false, false);
      ps = __uint_as_float(rr[0]) + __uint_as_float(rr[1]); }
    l_reg = l_reg * alpha + ps;
#define PK4(P, B_, OUT) do { unsigned a0 = cvtpk(P[B_+0], P[B_+1]), a1 = cvtpk(P[B_+2], P[B_+3]);                          \
        unsigned b0 = cvtpk(P[B_+4], P[B_+5]), b1 = cvtpk(P[B_+6], P[B_+7]);                                             \
        auto r0 = __builtin_amdgcn_permlane32_swap(a0, b0, false, false); auto r1 = __builtin_amdgcn_permlane32_swap(a1, b1, false, false); \
        u32x4 w = {r0[0], r1[0], r0[1], r1[1]}; OUT = *reinterpret_cast<bf16x8*>(&w); } while (0)
    PK4(p0, 0, pa0); PK4(p0, 8, pa1); PK4(p1, 0, pa2); PK4(p1, 8, pa3);
#undef PK4
}
__device__ __forceinline__ void qkt(int kboff, f32x16& p0, f32x16& p1, const char* K_lds, int r32, int hi, const bf16x8* qr) {
    p0 = f32x16{}; p1 = f32x16{};
    const char* kb[4];
#pragma unroll
    for (int dd = 0; dd < 4; ++dd) kb[dd] = K_lds + kboff + KSWZ(r32, (dd * 16 + hi * 8) * 2);
#pragma unroll
    for (int d0 = 0; d0 < 12; ++d0) { const char* a = kb[d0 & 3] + (d0 >> 2) * 128;
        bf16x8 b0 = *reinterpret_cast<const bf16x8*>(a);
        bf16x8 b1 = *reinterpret_cast<const bf16x8*>(a + 32 * 384);
        p0 = __builtin_amdgcn_mfma_f32_32x32x16_bf16(b0, qr[d0], p0, 0, 0, 0);
        p1 = __builtin_amdgcn_mfma_f32_32x32x16_bf16(b1, qr[d0], p1, 0, 0, 0); }
}
__device__ __forceinline__ void pv_tile(f32x16* o, int vb0, bf16x8 pa0, bf16x8 pa1, bf16x8 pa2, bf16x8 pa3) {
#define TRRD(dst, off) asm volatile("ds_read_b64_tr_b16 %0, %1 offset:%2" : "=&v"(dst) : "v"(vb0), "i"(off) : "memory")
#define PV_RD(L, H, d0) do { constexpr int b_ = v_rd_off(d0, 0, 0); TRRD(L[0], b_); TRRD(H[0], b_ + 2048); TRRD(L[1], b_ + 4096); TRRD(H[1], b_ + 6144); TRRD(L[2], b_ + 8192); TRRD(H[2], b_ + 10240); TRRD(L[3], b_ + 12288); TRRD(H[3], b_ + 14336); } while (0)
#define PV_FR(L, H, k) (bf16x8){L[k][0], L[k][1], L[k][2], L[k][3], H[k][0], H[k][1], H[k][2], H[k][3]}
#define PV_MM(L, H, d0) do { o[d0] = __builtin_amdgcn_mfma_f32_32x32x16_bf16(pa0, PV_FR(L, H, 0), o[d0], 0, 0, 0); o[d0] = __builtin_amdgcn_mfma_f32_32x32x16_bf16(pa1, PV_FR(L, H, 1), o[d0], 0, 0, 0); \
        o[d0] = __builtin_amdgcn_mfma_f32_32x32x16_bf16(pa2, PV_FR(L, H, 2), o[d0], 0, 0, 0); o[d0] = __builtin_amdgcn_mfma_f32_32x32x16_bf16(pa3, PV_FR(L, H, 3), o[d0], 0, 0, 0); } while (0)
    s16x4 la[4], ha[4], lb[4], hb[4];
    PV_RD(la, ha, 0);
    PV_RD(lb, hb, 1); asm volatile("s_waitcnt lgkmcnt(8)" ::: "memory"); SBAR(); PV_MM(la, ha, 0); SBAR();
    PV_RD(la, ha, 2); asm volatile("s_waitcnt lgkmcnt(8)" ::: "memory"); SBAR(); PV_MM(lb, hb, 1); SBAR();
    PV_RD(lb, hb, 3); asm volatile("s_waitcnt lgkmcnt(8)" ::: "memory"); SBAR(); PV_MM(la, ha, 2); SBAR();
    asm volatile("s_waitcnt lgkmcnt(0)" ::: "memory"); SBAR(); PV_MM(lb, hb, 3);
#undef PV_MM
#undef PV_FR
#undef PV_RD
#undef TRRD
}

struct BlockRef { const bf16_t* Q; const bf16_t* K; const bf16_t* V; bf16_t* G; const float* fsm; const float* ssq_qg; int qb; int h; int dry; };
struct Seam { bf16x8 qr[12]; bf16x8 st_v0, st_v1, st_k0, st_k1, st_k2; };

#define VMW() asm volatile("s_waitcnt vmcnt(0)" ::: "memory")
#define VMWN(n) asm volatile("s_waitcnt vmcnt(%0)" :: "i"(n) : "memory")
#define LD8(p) (*reinterpret_cast<const bf16x8*>(p))
#define SLOAD_H(Kp, Vp, k0) do { S.st_v0 = LD8((Vp) + (size_t)((k0) + sr) * 128 + sc); S.st_v1 = LD8((Vp) + (size_t)((k0) + 32 + sr) * 128 + sc); \
        const bf16_t* kt_ = (Kp) + (size_t)(k0) * 192 + tid * 8; S.st_k0 = LD8(kt_); S.st_k1 = LD8(kt_ + 4096); S.st_k2 = LD8(kt_ + 8192); } while (0)
#define SWRITE_HK(bf) do { *(bf16x8*)(K_lds + (bf) * SHM_K + kw0) = S.st_k0; *(bf16x8*)(K_lds + (bf) * SHM_K + kw1) = S.st_k1; *(bf16x8*)(K_lds + (bf) * SHM_K + kw2) = S.st_k2; } while (0)
#define SWRITE_HV(bf) do { *(bf16x8*)(V_lds + (bf) * SHM_V + vst0) = S.st_v0; *(bf16x8*)(V_lds + (bf) * SHM_V + vst1) = S.st_v1; } while (0)
#define SWRITE_H(bf) do { SWRITE_HV(bf); SWRITE_HK(bf); } while (0)
#define KW_OFFS() const int g0_ = tid, g1_ = tid + 512, g2_ = tid + 1024; \
    const int kw0 = KSWZ(g0_ / 24, (g0_ % 24) * 16), kw1 = KSWZ(g1_ / 24, (g1_ % 24) * 16), kw2 = KSWZ(g2_ / 24, (g2_ % 24) * 16)

__device__ __forceinline__ void prime(const BlockRef& cur, char* lds, Seam& S, int wave) {
    int lane_ = lane_id_(); asm volatile("" : "+v"(lane_));
    const int tid = wave * 64 + lane_;
    const int sr = tid >> 4, sc = (tid & 15) * 8; char* K_lds = lds + NBUF * SHM_V;
    KW_OFFS();
    SLOAD_H(cur.K, cur.V, 0); VMW(); SWRITE_HK(0);
    __syncthreads();
}
__device__ __forceinline__ void block(const BlockRef& cur, const BlockRef& nxt, char* lds, Seam& S, int wave) {
    int lane_ = lane_id_(); asm volatile("" : "+v"(lane_));
    const int wid = wave, lane = lane_, tid = wid * 64 + lane, r32 = lane & 31, hi = lane >> 5;
    const int NT = 4 * cur.qb + 4;
    const int tmax = 4 * cur.qb + (wid >> 1);
    char* V_lds = lds; char* K_lds = lds + NBUF * SHM_V;
    float* wsf = (float*)(lds + NBUF * SHM_V + NBUF * SHM_K) + wid * 64; float* li_l = wsf, * al_l = wsf + 32;
    float m_reg = -1e30f, l_reg = 0; f32x16 o[4] = {};
    const int sr = tid >> 4, sc = (tid & 15) * 8, vst0 = v_st(sr, sc), vst1 = v_st(32 + sr, sc);
    KW_OFFS();
    const int vb0 = (int)(uintptr_t)V_lds + v_rd_base(lane);
    const bf16_t* Kh = cur.K; const bf16_t* Vh = cur.V;
#define RESC(a) do { if (__any((a) < 1.f)) { if (hi == 0) al_l[r32] = (a); asm volatile("s_waitcnt lgkmcnt(0)" ::: "memory");              \
                     _Pragma("unroll") for (int d_ = 0; d_ < 4; ++d_) _Pragma("unroll") for (int r = 0; r < 16; ++r) o[d_][r] *= al_l[crow(r, hi)]; } } while (0)
#define KBASE(t) ((t) * KVBLK)
#define MASKT(P0_, P1_, t) do { if ((t) > tmax) { const float NEG_ = -__builtin_inff(); _Pragma("unroll") for (int r = 0; r < 16; ++r) { P0_[r] = NEG_; P1_[r] = NEG_; } } } while (0)
    constexpr int NQL = 0;
#define SEAM_K0() do { VMWN(NQL); SWRITE_HK(0); SBAR(); } while (0)
    f32x16 pA0, pA1, pB0, pB1; float mnA, mnB, alA, alB; bf16x8 pa0, pa1, pa2, pa3;
    {
        const int t = cur.qb * QB + wid * QBLK + r32;
        const float* fsm = cur.fsm;
        const float al = rsqrtf((fsm[F_SSQ_QL + 2 * t] + fsm[F_SSQ_QL + 2 * t + 1]) * (1.f / 512.f) + EPS);
        const float* qg = cur.ssq_qg + (size_t)t * 96 + cur.h * 6;
        const float ssh = ((qg[0] + qg[1]) + (qg[2] + qg[3])) + (qg[4] + qg[5]);
        const float sc = al * rsqrtf(al * al * ssh * (1.f / 192.f) + EPS) * (MLA_SCALE * LOG2E);
        const bf16_t* qrow = cur.Q + (size_t)(wid * QBLK + r32) * 192 + hi * 8;
#define UNPK(src_, f) do { const u32x4 w_ = __builtin_bit_cast(u32x4, (src_)); f[0] = bflo(w_.x); f[1] = bfhi(w_.x); f[2] = bflo(w_.y); f[3] = bfhi(w_.y); f[4] = bflo(w_.z); f[5] = bfhi(w_.z); f[6] = bflo(w_.w); f[7] = bfhi(w_.w); } while (0)
#define REPK(f) __builtin_bit_cast(bf16x8, (u32x4){cvtpk(f[0], f[1]), cvtpk(f[2], f[3]), cvtpk(f[4], f[5]), cvtpk(f[6], f[7])})
#pragma unroll
        for (int d0 = 0; d0 < 8; ++d0) { float f[8]; UNPK(LD8(qrow + d0 * 16), f);
#pragma unroll
            for (int j = 0; j < 8; ++j) f[j] *= sc;
            S.qr[d0] = REPK(f); }
        const float* cs = fsm + F_ROPE + (size_t)t * 64;
#pragma unroll
        for (int dd = 0; dd < 2; ++dd) { float x1[8], x2[8], y1[8], y2[8]; UNPK(LD8(qrow + (8 + dd) * 16), x1); UNPK(LD8(qrow + (10 + dd) * 16), x2);
            const int i0 = dd * 16 + hi * 8;
#pragma unroll
            for (int j = 0; j < 8; ++j) { const float c = cs[i0 + j], sn = cs[32 + i0 + j]; y1[j] = (x1[j] * c - x2[j] * sn) * sc; y2[j] = (x2[j] * c + x1[j] * sn) * sc; }
            S.qr[8 + dd] = REPK(y1); S.qr[10 + dd] = REPK(y2); }
#undef UNPK
#undef REPK
    }
    SWRITE_HV(0); SBAR();
    SLOAD_H(Kh, Vh, KBASE(1));
    SBAR(); qkt(0, pA0, pA1, K_lds, r32, hi, S.qr);
    MASKT(pA0, pA1, 0); partialSM(pA0, pA1, m_reg, mnA, alA);
    VMW(); SWRITE_H(1);
    __syncthreads();
    int b_prev = 0, b_cur = 1, b_next = 2;
#define ROT3() do { const int t_ = b_prev; b_prev = b_cur; b_cur = b_next; b_next = t_; } while (0)
#define HALF_STEP(PX0, PX1, mnX, alX, PY0, PY1, alY, t) do {                                                      \
        SBAR(); if ((t) + 1 < NT) { SLOAD_H(Kh, Vh, KBASE((t) + 1)); SBAR(); }     \
        qkt(b_cur * SHM_K, PX0, PX1, K_lds, r32, hi, S.qr);                                                          \
        finishSM(PY0, PY1, alY, l_reg, pa0, pa1, pa2, pa3); SBAR();                                                           \
        pv_tile(o, vb0 + b_prev * SHM_V, pa0, pa1, pa2, pa3); MASKT(PX0, PX1, (t)); partialSM(PX0, PX1, m_reg, mnX, alX);                                        \
        if ((t) + 1 < NT) { VMW(); SWRITE_H(b_next); }                                                                          \
        RESC(alX); __syncthreads(); ROT3(); } while (0)
    for (int t = 1; t + 1 < NT; t += 2) {
        HALF_STEP(pB0, pB1, mnB, alB, pA0, pA1, alA, t);
        HALF_STEP(pA0, pA1, mnA, alA, pB0, pB1, alB, t + 1);
    }
    SBAR(); qkt(b_cur * SHM_K, pB0, pB1, K_lds, r32, hi, S.qr); SBAR();
    SLOAD_H(nxt.K, nxt.V, 0); SBAR();
    finishSM(pA0, pA1, alA, l_reg, pa0, pa1, pa2, pa3); SBAR();
    pv_tile(o, vb0 + b_prev * SHM_V, pa0, pa1, pa2, pa3);
    MASKT(pB0, pB1, NT - 1); partialSM(pB0, pB1, m_reg, mnB, alB); __syncthreads(); RESC(alB);
    finishSM(pB0, pB1, alB, l_reg, pa0, pa1, pa2, pa3); SBAR(); pv_tile(o, vb0 + b_cur * SHM_V, pa0, pa1, pa2, pa3);
    SBAR(); SEAM_K0();
    if (hi == 0) li_l[r32] = l_reg; asm volatile("s_waitcnt lgkmcnt(0)" ::: "memory");
    float rli[16];
#pragma unroll
    for (int r = 0; r < 16; ++r) rli[r] = __builtin_amdgcn_rcpf(li_l[crow(r, hi)]);
    bf16_t* Gw = cur.G + (size_t)(wid * QBLK) * 2048;
#pragma unroll
    for (int dp = 0; dp < 4; dp += 2) {
        bf16_t gt_[2][16];
#pragma unroll
        for (int dd = 0; dd < 2; ++dd)
#pragma unroll
            for (int r = 0; r < 16; ++r) gt_[dd][r] = Gw[(size_t)crow(r, hi) * 2048 + (dp + dd) * 32 + r32];
        asm volatile("" ::: "memory");
#pragma unroll
        for (int dd = 0; dd < 2; ++dd)
#pragma unroll
            for (int r = 0; r < 16; ++r) { const int d0 = dp + dd;
                bf16_t* gp = Gw + (size_t)crow(r, hi) * 2048 + d0 * 32 + r32;
                const float v = o[d0][r] * rli[r] * sigmoidf_(bf2f(gt_[dd][r]));
                const float vn = __shfl_xor(v, 1);
                if ((r32 & 1) == 0 && !cur.dry) *(unsigned*)gp = cvtpk(v, vn); }
        asm volatile("" ::: "memory");
    }
    __syncthreads();
#undef RESC
#undef KBASE
#undef MASKT
#undef SEAM_K0
#undef HALF_STEP
#undef ROT3
}
#undef VMW
#undef VMWN
#undef LD8
#undef SLOAD_H
#undef SWRITE_HK
#undef SWRITE_HV
#undef SWRITE_H
#undef KW_OFFS
#undef KSWZ
#undef SBAR
}

#define LDS_WAIT() asm volatile("s_waitcnt lgkmcnt(0)" ::: "memory")
__device__ __forceinline__ unsigned pk2(float lo, float hi) { return cvt_pk_bf16(lo, hi); }

__device__ __forceinline__ int lane_fresh_() { int l_ = lane_id_(); asm volatile("" : "+v"(l_)); return l_; }
struct TrDesc { const float* sp; size_t ldn; bf16_t* dp; size_t ldk; const float* ks; int valid; };
__device__ __forceinline__ TrDesc tr_desc(const float* src, size_t ldn, bf16_t* dst, size_t ldk, int k0, int ndst0, int srcn, const float* kscale, int lane) {
    lane = lane_id_();
    TrDesc d; d.sp = src + (size_t)(k0 + (lane >> 3)) * ldn + (srcn >= 0 ? srcn : 0); d.ldn = ldn; d.dp = dst + (size_t)(ndst0 + (lane >> 3)) * ldk + k0 + 8 * (lane & 7); d.ldk = ldk;
    d.ks = kscale ? kscale + k0 + (lane >> 3) : nullptr; d.valid = srcn >= 0; return d;
}
__device__ __forceinline__ void tr_load(const TrDesc& d, float (&v)[32]) {
#pragma unroll
    for (int j = 0; j < 8; ++j) { const f32x4 w = *(const f32x4*)(d.sp + (size_t)(8 * j) * d.ldn); v[4 * j] = w[0]; v[4 * j + 1] = w[1]; v[4 * j + 2] = w[2]; v[4 * j + 3] = w[3]; }
}
__device__ __forceinline__ void tr_finish(const TrDesc& d, float (&v)[32], LAS float* scr, int lane) {
    lane = lane_id_();
    if (d.ks) {
#pragma unroll
        for (int j = 0; j < 8; ++j) { const float g = d.ks[8 * j]; v[4 * j] *= g; v[4 * j + 1] *= g; v[4 * j + 2] *= g; v[4 * j + 3] *= g; }
    }
#pragma unroll
    for (int j = 0; j < 8; ++j)
#pragma unroll
        for (int e = 0; e < 4; ++e) scr[(8 * j + (lane >> 3)) * 33 + 4 * (lane & 7) + e] = d.valid ? v[4 * j + e] : 0.f;
    LDS_WAIT(); asm volatile("" ::: "memory");
    const int c = lane & 7;
#pragma unroll
    for (int j = 0; j < 4; ++j) { const int n = (lane >> 3) + 8 * j; const LAS float* s_ = scr + (8 * c) * 33 + n;
        u32x4 o; o.x = pk2(s_[0 * 33], s_[1 * 33]); o.y = pk2(s_[2 * 33], s_[3 * 33]); o.z = pk2(s_[4 * 33], s_[5 * 33]); o.w = pk2(s_[6 * 33], s_[7 * 33]);
        *(u32x4*)(d.dp + (size_t)(8 * j) * d.ldk) = o; }
    LDS_WAIT(); asm volatile("" ::: "memory");
}
template <class Dec>
__device__ __forceinline__ void tr_loop(int first, int n, int stride, const Dec& dec, LAS float* scr, int lane) {
    if (first >= n) return;
    float va[32], vb[32];
    TrDesc da = dec(first), db = da;
    tr_load(da, va);
    for (int it = first;; it += 2 * stride) {
        const bool hb = it + stride < n;
        if (hb) { db = dec(it + stride); tr_load(db, vb); }
        tr_finish(da, va, scr, lane);
        if (!hb) break;
        const bool ha = it + 2 * stride < n;
        if (ha) { da = dec(it + 2 * stride); tr_load(da, va); }
        tr_finish(db, vb, scr, lane);
        if (!ha) break;
    }
}
__device__ __forceinline__ int win_src(int n) {
    if (n < 1024) return n;
    if (n < 5120) return n + 64;
    if (n < 9216) { const int w = n - 5120, c = (w >> 8) * 128 + (w & 127); return (w & 128) ? 5200 + c : 9296 + c; }
    if (n < 11264) return 7248 + (n - 9216);
    const int lc = n - 11264;
    if (lc < 64) return 1024 + lc;
    if (lc < 80) return 5184 + (lc - 64);
    return -1;
}

__device__ __forceinline__ void p0_prologue(Frame& F, int parts, int wi, int nw) {
    LAS float* scr = (LAS float*)(F.lds + F.wave * 16384);
    const int gw = wi * 8 + F.wave, NGW = nw * 8, lane = lane_fresh_();
    const int gt = gw * 64 + lane, NGT = NGW * 64;
    unsigned char* ws = F.ws; bf16_t* wsm = (bf16_t*)(ws + WS_WSM);
    if (parts & 1) {
        const float* g = F.in[5]; bf16_t* hb = (bf16_t*)(ws + WS_R2);
        f32x4 gg8[8];
#pragma unroll
        for (int j = 0; j < 8; ++j) gg8[j] = *(const f32x4*)(g + (lane + 64 * j) * 4);
#define H_ROWPTR(row_) ((row_) < SEQ ? F.in[0] + (size_t)(row_) * DM : F.in[1] + (size_t)((row_) - SEQ) * DM)
        f32x4 v[8], vn[8];
        if (gw < NTOK) { const float* xr = H_ROWPTR(gw);
#pragma unroll
            for (int j = 0; j < 8; ++j) v[j] = *(const f32x4*)(xr + (lane + 64 * j) * 4); }
        for (int row = gw; row < NTOK; row += NGW) {
            const bool more = row + NGW < NTOK;
            if (more) { const float* xn = H_ROWPTR(row + NGW);
#pragma unroll
                for (int j = 0; j < 8; ++j) vn[j] = *(const f32x4*)(xn + (lane + 64 * j) * 4); }
            asm volatile("" ::: "memory");
            float s = 0.f;
#pragma unroll
            for (int j = 0; j < 8; ++j) s += (v[j][0] * v[j][0] + v[j][1] * v[j][1]) + (v[j][2] * v[j][2] + v[j][3] * v[j][3]);
            const float inv = rsqrtf(wave_sum(s) * (1.f / DM) + EPS);
#pragma unroll
            for (int j = 0; j < 8; ++j) { const f32x4 gg = gg8[j];
                u32x2 o; o.x = pk2(v[j][0] * inv * gg[0], v[j][1] * inv * gg[1]); o.y = pk2(v[j][2] * inv * gg[2], v[j][3] * inv * gg[3]);
                *(u32x2*)(hb + (size_t)row * DM + (lane + 64 * j) * 4) = o; }
            if (more) {
#pragma unroll
                for (int j = 0; j < 8; ++j) v[j] = vn[j]; }
        }
#undef H_ROWPTR
    }
    if (parts & 2) {
        const float* wukv = F.in[10]; bf16_t* wk = wsm + W_KNABS;
        for (int i = gt; i < 16 * 512 * 32; i += NGT) { const int j8 = (i & 31) * 8, c = (i >> 5) & 511, h = i >> 14;
            u32x4 o = {0u, 0u, 0u, 0u};
            if (j8 < 128) { const float* s = wukv + (size_t)c * 4096 + h * 256 + j8; const f32x4 a = *(const f32x4*)s, b = *(const f32x4*)(s + 4);
                o.x = pk2(a[0], a[1]); o.y = pk2(a[2], a[3]); o.z = pk2(b[0], b[1]); o.w = pk2(b[2], b[3]); }
            *(u32x4*)(wk + ((size_t)h * 512 + c) * 256 + j8) = o; }
    }
    constexpr int I_IN = 32 * 360, I_UQ = 8 * 96, I_UKV = 8 * 128, I_KN = 8 * 64, I_V = 8 * 64, I_O = 32 * 64;
    constexpr int NIT = I_IN + I_UQ + I_UKV + I_KN + I_V + I_O;
    const float* const* in = F.in;
    auto dec = [=](int it) -> TrDesc {
        int r = it; const int n = (lane_id_() & 7) * 4;
        if (r < I_IN) { const int kb = r / 360, nb = r % 360; return tr_desc(in[6], DIN, (bf16_t*)(ws + WS_R1), 2048, kb * 64, nb * 32, win_src(nb * 32 + n), nullptr, lane); } r -= I_IN;
        if (r < I_UQ) { const int kb = r / 96, nb = r % 96; return tr_desc(in[8], 3072, wsm + W_UQ, 512, kb * 64, nb * 32, nb * 32 + n, in[7], lane); } r -= I_UQ;
        if (r < I_UKV) { const int kb = r / 128, nb = r % 128; return tr_desc(in[10], 4096, wsm + W_UKVG, 512, kb * 64, nb * 32, nb * 32 + n, in[9], lane); } r -= I_UKV;
        if (r < I_KN) { const int kb = r / 64, nb = r % 64; const int nd = nb * 32 + n; return tr_desc(in[10], 4096, wsm + W_KNP, 512, kb * 64, nb * 32, (nd >> 7) * 256 + (nd & 127), nullptr, lane); } r -= I_KN;
        if (r < I_V) { const int kb = r / 64, nb = r % 64; const int nd = nb * 32 + n; return tr_desc(in[10], 4096, wsm + W_VP, 512, kb * 64, nb * 32, (nd >> 7) * 256 + 128 + (nd & 127), nullptr, lane); } r -= I_V;
        { const int kb = r / 64, nb = r % 64; return tr_desc(in[18], 2048, wsm + W_O, 2048, kb * 64, nb * 32, nb * 32 + n, nullptr, lane); }
    };
    const int lo = (parts & 1) ? 0 : I_IN, hi = (parts & 2) ? NIT : I_IN;
    tr_loop(lo + gw, hi, NGW, dec, scr, lane);
}

__device__ __forceinline__ void p2_ckv_krope(Frame& F) {
    const int gw = F.vcu * 8 + F.wave, NGW = F.G * 8, lane = F.lane;
    unsigned char* ws = F.ws; float* fsm = (float*)(ws + WS_FSM);
    const bf16_t* ZL = (const bf16_t*)(ws + WS_ZL); const bf16_t* ZM = (const bf16_t*)(ws + WS_ZM);
    const float* gkv = F.in[9]; const float* cs = fsm + F_ROPE;
    for (int t = gw; t < NTOK; t += NGW) {
        const float inv = rsqrtf((fsm[F_SSQ_KV + 2 * t] + fsm[F_SSQ_KV + 2 * t + 1]) * (1.f / 512.f) + EPS);
        const u32x4 w = *(const u32x4*)(ZL + (size_t)t * 1024 + 512 + lane * 8);
        const f32x4 g0 = *(const f32x4*)(gkv + lane * 8), g1 = *(const f32x4*)(gkv + lane * 8 + 4);
        f32x4 o0, o1;
        o0[0] = bflo(w.x) * inv * g0[0]; o0[1] = bfhi(w.x) * inv * g0[1]; o0[2] = bflo(w.y) * inv * g0[2]; o0[3] = bfhi(w.y) * inv * g0[3];
        o1[0] = bflo(w.z) * inv * g1[0]; o1[1] = bfhi(w.z) * inv * g1[1]; o1[2] = bflo(w.w) * inv * g1[2]; o1[3] = bfhi(w.w) * inv * g1[3];
        float* oc = t < SEQ ? F.out + O_CKVP + (size_t)t * 512 : F.out + O_CKVS + (size_t)(t - SEQ) * 512;
        *(f32x4*)(oc + lane * 8) = o0; *(f32x4*)(oc + lane * 8 + 4) = o1;
        const int r_ = t - SEQ, kb_ = r_ >> 4, kq_ = r_ & 15; const int krow = kb_ * NKP + PAST + kq_;
        bf16_t* kc = (bf16_t*)(ws + WS_R3) + (size_t)(t >= SEQ ? krow : 0) * DQC;
        if (t >= SEQ) {
            u32x4 o; o.x = pk2(o0[0], o0[1]); o.y = pk2(o0[2], o0[3]); o.z = pk2(o1[0], o1[1]); o.w = pk2(o1[2], o1[3]);
            *(u32x4*)(kc + lane * 8) = o;
            if (lane < 8) *(u32x4*)(kc + 576 + lane * 8) = (u32x4){0u, 0u, 0u, 0u};
            bf16_t* ct = (bf16_t*)(ws + WS_R4) + ((size_t)kb_ * 512 + lane * 8) * NKP + PAST + kq_;
            ((unsigned short*)ct)[0] = (unsigned short)(o.x & 0xffffu); ((unsigned short*)(ct + NKP))[0] = (unsigned short)(o.x >> 16);
            ((unsigned short*)(ct + 2 * NKP))[0] = (unsigned short)(o.y & 0xffffu); ((unsigned short*)(ct + 3 * NKP))[0] = (unsigned short)(o.y >> 16);
            ((unsigned short*)(ct + 4 * NKP))[0] = (unsigned short)(o.z & 0xffffu); ((unsigned short*)(ct + 5 * NKP))[0] = (unsigned short)(o.z >> 16);
            ((unsigned short*)(ct + 6 * NKP))[0] = (unsigned short)(o.w & 0xffffu); ((unsigned short*)(ct + 7 * NKP))[0] = (unsigned short)(o.w >> 16);
        }
        float ss = 0.f;
        if (lane < 32) {
            const float x1 = bf2f(ZM[(size_t)t * 256 + lane]), x2 = bf2f(ZM[(size_t)t * 256 + 32 + lane]);
            const int pos = t < SEQ ? t : PAST + ((t - SEQ) & 15);
            const float c = cs[pos * 64 + lane], s = cs[pos * 64 + 32 + lane];
            const float y1 = x1 * c - x2 * s, y2 = x2 * c + x1 * s;
            float* ok = t < SEQ ? F.out + O_KRP + (size_t)t * 64 : F.out + O_KRS + (size_t)(t - SEQ) * 64;
            ok[lane] = y1; ok[32 + lane] = y2; ss = y1 * y1 + y2 * y2;
            if (t >= SEQ) { const unsigned p_ = pk2(y1, y2); ((unsigned short*)(kc + 512 + lane))[0] = (unsigned short)(p_ & 0xffffu); ((unsigned short*)(kc + 544 + lane))[0] = (unsigned short)(p_ >> 16); }
        }
        ss = wave_sum(ss);
        if (lane == 0) { fsm[F_KRSS + t] = ss; if (t >= SEQ) fsm[F_KRSS_C + krow] = ss; }
    }
}

__device__ __forceinline__ void p4_finalize_q_head(Frame& F, int h) {
    const int tid = F.wave * 64 + F.lane;
    unsigned char* ws = F.ws; float* fsm = (float*)(ws + WS_FSM); const float* cs = fsm + F_ROPE;
    const bf16_t* Qp = (const bf16_t*)(ws + WS_R1);
    bf16_t* Qcat = (bf16_t*)(F.out + O_Y) + 48 * MiB / 2; bf16_t* QnA = (bf16_t*)(F.out + O_Y) + 53 * MiB / 2;
    const float* gqn = F.in[11]; const float* gqr = F.in[12]; const float* gkn = F.in[13]; const float* gkr = F.in[14];
    const float* ssq_qg = (const float*)((const char*)(F.out + O_Y) + 56 * MiB);
#define QSCALE(t, h) ({ const float al_ = rsqrtf((fsm[F_SSQ_QL + 2 * (t)] + fsm[F_SSQ_QL + 2 * (t) + 1]) * (1.f / 512.f) + EPS); const float* qg_ = ssq_qg + (size_t)(t) * 96 + (h) * 6; \
        const float ssh_ = ((qg_[0] + qg_[1]) + (qg_[2] + qg_[3])) + (qg_[4] + qg_[5]); al_ * rsqrtf(al_ * al_ * ssh_ * (1.f / 192.f) + EPS) * (MLA_SCALE * LOG2E); })
#pragma unroll 4
    for (int i = tid; i < NSAMP * 16; i += 512) { const int l = i & 15, r = i >> 4, t = SEQ + r;
        const float sc = QSCALE(t, h);
        const bf16_t* q = Qp + ((size_t)h * NTOK + t) * 192 + l * 8;
        const u32x4 w = *(const u32x4*)q;
        const f32x4 a0 = *(const f32x4*)(gqn + l * 8), a1 = *(const f32x4*)(gqn + l * 8 + 4), b0 = *(const f32x4*)(gkn + l * 8), b1 = *(const f32x4*)(gkn + l * 8 + 4);
        u32x4 o;
        o.x = pk2(bflo(w.x) * sc * a0[0] * b0[0], bfhi(w.x) * sc * a0[1] * b0[1]); o.y = pk2(bflo(w.y) * sc * a0[2] * b0[2], bfhi(w.y) * sc * a0[3] * b0[3]);
        o.z = pk2(bflo(w.z) * sc * a1[0] * b1[0], bfhi(w.z) * sc * a1[1] * b1[1]); o.w = pk2(bflo(w.w) * sc * a1[2] * b1[2], bfhi(w.w) * sc * a1[3] * b1[3]);
        bf16_t* qa = QnA + ((size_t)h * 256 + r) * 256; *(u32x4*)(qa + l * 8) = o; *(u32x4*)(qa + 128 + l * 8) = (u32x4){0u, 0u, 0u, 0u};
    }
#pragma unroll 2
    for (int i = tid; i < NSAMP * 4; i += 512) { const int k = i & 3, r = i >> 2, t = SEQ + r;
        const float sc = QSCALE(t, h);
        const bf16_t* q = Qp + ((size_t)h * NTOK + t) * 192;
        const int b = r >> 4, qi = r & 15; const int pos = PAST + qi;
        const u32x4 w1 = *(const u32x4*)(q + 128 + 8 * k), w2 = *(const u32x4*)(q + 160 + 8 * k);
        const float x1[8] = {bflo(w1.x), bfhi(w1.x), bflo(w1.y), bfhi(w1.y), bflo(w1.z), bfhi(w1.z), bflo(w1.w), bfhi(w1.w)};
        const float x2[8] = {bflo(w2.x), bfhi(w2.x), bflo(w2.y), bfhi(w2.y), bflo(w2.z), bfhi(w2.z), bflo(w2.w), bfhi(w2.w)};
        float y1[8], y2[8];
#pragma unroll
        for (int j = 0; j < 8; ++j) { const int ii = 8 * k + j; const float c = cs[pos * 64 + ii], sn = cs[pos * 64 + 32 + ii], g = gqr[ii] * gkr[ii] * sc;
            y1[j] = (x1[j] * c - x2[j] * sn) * g; y2[j] = (x2[j] * c + x1[j] * sn) * g; }
        const u32x4 o1 = {pk2(y1[0], y1[1]), pk2(y1[2], y1[3]), pk2(y1[4], y1[5]), pk2(y1[6], y1[7])};
        const u32x4 o2 = {pk2(y2[0], y2[1]), pk2(y2[2], y2[3]), pk2(y2[4], y2[5]), pk2(y2[6], y2[7])};
        bf16_t* qc = Qcat + ((size_t)b * 256 + h * 16 + qi) * DQC; *(u32x4*)(qc + 512 + 8 * k) = o1; *(u32x4*)(qc + 544 + 8 * k) = o2;
        *(u32x4*)(qc + 576 + 8 * k) = (u32x4){0u, 0u, 0u, 0u}; *(u32x4*)(qc + 608 + 8 * k) = (u32x4){0u, 0u, 0u, 0u};
    }
#undef QSCALE
}
__device__ __forceinline__ void kcat_rows(Frame& F, int klo, int khi, int wi, int nw) {
    const int gt = (wi * 8 + F.wave) * 64 + F.lane, NGT = nw * 512, nk = khi - klo;
    unsigned char* ws = F.ws; float* fsm = (float*)(ws + WS_FSM);
    bf16_t* Kcat = (bf16_t*)(ws + WS_R3);
    const float* cckv = F.in[2]; const float* ckr = F.in[3];
#pragma unroll 4
    for (int i = gt; i < DECB * nk * 80; i += NGT) { const int rr = i / 80, ch = i - rr * 80, b = rr / nk, k = klo + (rr - b * nk); const int row = b * NKP + k;
        u32x4 o = {0u, 0u, 0u, 0u};
        if (k < NKEY && ch < 72) {
            const float* s_;
            if (ch < 64) s_ = (k < PAST ? cckv + ((size_t)b * PAST + k) * 512 : F.out + O_CKVS + (size_t)(b * 16 + k - PAST) * 512) + ch * 8;
            else s_ = (k < PAST ? ckr + ((size_t)b * PAST + k) * 64 : F.out + O_KRS + (size_t)(b * 16 + k - PAST) * 64) + (ch - 64) * 8;
            const f32x4 a_ = *(const f32x4*)s_, c_ = *(const f32x4*)(s_ + 4);
            o.x = pk2(a_[0], a_[1]); o.y = pk2(a_[2], a_[3]); o.z = pk2(c_[0], c_[1]); o.w = pk2(c_[2], c_[3]);
        }
        *(u32x4*)(Kcat + (size_t)row * DQC + ch * 8) = o; }
#pragma unroll 4
    for (int i = gt; i < DECB * nk * 16; i += NGT) { const int rr = i >> 4, l = i & 15, b = rr / nk, k = klo + (rr - b * nk); const int row = b * NKP + k;
        float ss = 0.f;
        if (k < NKEY) { const float* s_ = (k < PAST ? ckr + ((size_t)b * PAST + k) * 64 : F.out + O_KRS + (size_t)(b * 16 + k - PAST) * 64) + l * 4; const f32x4 a_ = *(const f32x4*)s_;
            ss = (a_[0] * a_[0] + a_[1] * a_[1]) + (a_[2] * a_[2] + a_[3] * a_[3]); }
        ss += __shfl_xor(ss, 1); ss += __shfl_xor(ss, 2); ss += __shfl_xor(ss, 4); ss += __shfl_xor(ss, 8);
        if (l == 0) fsm[F_KRSS_C + row] = ss; }
}
__device__ __forceinline__ void p3_kcat_ct(Frame& F, bool cache_rows_done) {
    LAS float* scr = (LAS float*)(F.lds + F.wave * 16384);
    const int gw = F.vcu * 8 + F.wave, NGW = F.G * 8, lane = lane_fresh_();
    const int gt = gw * 64 + lane, NGT = NGW * 64;
    unsigned char* ws = F.ws;
    bf16_t* CT = (bf16_t*)(ws + WS_R4);
    const float* cckv = F.in[2];
    if (!cache_rows_done) {
        if (F.G == 256) { kcat_rows(F, 0, PAST, F.vcu, 356); if (F.vcu >= 156) kcat_rows(F, 0, PAST, 100 + F.vcu, 356); }
        else kcat_rows(F, 0, PAST, F.vcu, F.G); }
    kcat_rows(F, NKEY, NKP, F.vcu, F.G);
    { auto dec = [=](int it) -> TrDesc { const int b = it >> 9, r = it & 511, kb = r >> 4, nb = r & 15;
          return tr_desc(cckv + (size_t)b * PAST * 512, 512, CT + (size_t)b * 512 * NKP, NKP, kb * 64, nb * 32, nb * 32 + (lane_id_() & 7) * 4, nullptr, lane); };
      tr_loop(gw, 16 * 32 * 16, NGW, dec, scr, lane); }
    for (int i = gt; i < 16 * 512 * 32; i += NGT) { const int ch = i & 31, c = (i >> 5) & 511, b = i >> 14;
        if (ch >= 2) *(u32x4*)(CT + ((size_t)b * 512 + c) * NKP + PAST + ch * 8) = (u32x4){0u, 0u, 0u, 0u}; }
    { float* invk_t = (float*)(ws + WS_FSM) + F_KNSS_C;
      for (int i = gt; i < 256 * 60; i += NGT) { const int bh = i / 60, j = i - bh * 60; *(f32x4*)(invk_t + (size_t)bh * NKP + NKEY + j * 4) = (f32x4){0.f, 0.f, 0.f, 0.f}; } }
}
__device__ __forceinline__ float logsig16(float x) { return (fminf(x, 0.f) - __logf(1.f + __expf(-fabsf(x)))) * (1.f / 16.f); }
__device__ __forceinline__ void p3_gla_prep(Frame& F) {
    unsigned char* ws = F.ws; float* fsm = (float*)(ws + WS_FSM);
    const bf16_t* ZQK = (const bf16_t*)(ws + WS_ZQK); const bf16_t* ZV = (const bf16_t*)(ws + WS_ZV); const bf16_t* ZM = (const bf16_t*)(ws + WS_ZM);
    bf16_t* qt = (bf16_t*)(ws + WS_ZOG); bf16_t* kt = (bf16_t*)(ws + WS_R5); bf16_t* kendT = (bf16_t*)(ws + WS_R5) + 8 * MiB; bf16_t* vT = (bf16_t*)(F.out + O_STS);
    const float* wa2 = F.in[15]; const float* ba_ = F.in[16];
    LAS float* alr_s = (LAS float*)F.lds;
    LAS float* tot_s = (LAS float*)(F.lds + 16384);
    LAS unsigned char* tile = F.lds + 16384 + 2048;
    const int tid = F.tid;
    __syncthreads();
    for (int un = F.vcu; un < 256; un += F.G) {
        const int hc = un >> 1, dh = un & 1, h = hc >> 5, c = hc & 31;
        const int dl = tid & 127, qtr = tid >> 7, d = dh * 128 + dl;
        { const int tt = tid >> 1, half = tid & 1; const u32x4 w = *(const u32x4*)(ZM + (size_t)(c * 256 + tt) * 256 + 64 + half * 8);
          LAS float* a = alr_s + tt * 16 + half * 8;
          a[0] = bflo(w.x); a[1] = bfhi(w.x); a[2] = bflo(w.y); a[3] = bfhi(w.y); a[4] = bflo(w.z); a[5] = bfhi(w.z); a[6] = bflo(w.w); a[7] = bfhi(w.w); }
        float wa[16];
#pragma unroll
        for (int r = 0; r < 16; ++r) wa[r] = wa2[r * 1024 + h * 256 + d];
        const float ba = ba_[h * 256 + d];
        __syncthreads();
        float tot = 0.f;
#pragma unroll 4
        for (int i = 0; i < 64; ++i) { const LAS float* a = alr_s + (qtr * 64 + i) * 16; float x = ba;
#pragma unroll
            for (int r = 0; r < 16; ++r) x += a[r] * wa[r];
            const _Float16 lh = (_Float16)logsig16(x);
            *(LAS unsigned short*)(tile + dl * 520 + (qtr * 64 + i) * 2) = __builtin_bit_cast(unsigned short, lh);
            tot += (float)lh; }
        tot_s[qtr * 128 + dl] = tot;
        __syncthreads();
        float off = 0.f, bend = 0.f;
#pragma unroll
        for (int q = 0; q < 4; ++q) { const float v = tot_s[q * 128 + dl]; bend += v; if (q < qtr) off += v; }
        const float ebend = __expf(bend);
        if (qtr == 0) fsm[F_GAMMA + hc * 256 + d] = ebend;
        float bcum = off;
#define GP_LOAD(bq, bk, i0_) do { _Pragma("unroll") for (int i_ = 0; i_ < 8; ++i_) { const size_t trow_ = (size_t)(c * 256 + qtr * 64 + (i0_) + i_) * 2048; bq[i_] = ZQK[trow_ + h * 256 + d]; bk[i_] = ZQK[trow_ + 1024 + h * 256 + d]; } } while (0)
#define GP_COMP(bq, bk, i0_) do { _Pragma("unroll") for (int i_ = 0; i_ < 8; ++i_) { const int tl = qtr * 64 + (i0_) + i_; \
            bcum += (float)__builtin_bit_cast(_Float16, *(const LAS unsigned short*)(tile + dl * 520 + tl * 2)); \
            const float gq = bf2f(bq[i_]), gk = bf2f(bk[i_]); \
            const float eb = __expf(bcum), ieb = __builtin_amdgcn_rcpf(eb); \
            qt[(size_t)hc * 65536 + tl * 256 + d] = f2bf(gq * 0.0625f * eb); \
            kt[(size_t)hc * 65536 + tl * 256 + d] = f2bf(gk * ieb); \
            *(LAS bf16_t*)(tile + dl * 520 + tl * 2) = f2bf(gk * (ebend * ieb)); } } while (0)
        { bf16_t qa[8], ka[8], qb[8], kb[8];
          GP_LOAD(qa, ka, 0);
#pragma unroll 1
          for (int i0 = 0; i0 < 64; i0 += 16) {
              GP_LOAD(qb, kb, i0 + 8); asm volatile("" ::: "memory");
              GP_COMP(qa, ka, i0); asm volatile("" ::: "memory");
              if (i0 + 16 < 64) GP_LOAD(qa, ka, i0 + 16);
              asm volatile("" ::: "memory");
              GP_COMP(qb, kb, i0 + 8); asm volatile("" ::: "memory");
          } }
#undef GP_LOAD
#undef GP_COMP
        __syncthreads();
#pragma unroll 4
        for (int j = 0; j < 16; ++j) { const int g = tid + 512 * j, row = g >> 6, ch = g & 63;
            const u32x2 v = *(const LAS u32x2*)(tile + row * 520 + ch * 8);
            *(u32x2*)(kendT + (size_t)hc * 65536 + (size_t)(dh * 128 + row) * 256 + ch * 4) = v; }
        __syncthreads();
    }
    LAS unsigned char* tl2 = F.lds;
    for (int it = F.vcu; it < 1024; it += F.G) {
        const int hc = it >> 3, eb = it & 7, h = hc >> 5, c = hc & 31, e0 = eb * 64;
#pragma unroll
        for (int j = 0; j < 4; ++j) { const int g = tid + 512 * j, t = g >> 3, ch = g & 7;
            const u32x4 w = *(const u32x4*)(ZV + (size_t)(c * 256 + t) * 2048 + h * 512 + e0 + ch * 8);
            LAS unsigned char* p = tl2 + (ch * 8) * 520 + t * 2;
            *(LAS bf16_t*)(p) = (bf16_t)(w.x & 0xffff); *(LAS bf16_t*)(p + 520) = (bf16_t)(w.x >> 16);
            *(LAS bf16_t*)(p + 2 * 520) = (bf16_t)(w.y & 0xffff); *(LAS bf16_t*)(p + 3 * 520) = (bf16_t)(w.y >> 16);
            *(LAS bf16_t*)(p + 4 * 520) = (bf16_t)(w.z & 0xffff); *(LAS bf16_t*)(p + 5 * 520) = (bf16_t)(w.z >> 16);
            *(LAS bf16_t*)(p + 6 * 520) = (bf16_t)(w.w & 0xffff); *(LAS bf16_t*)(p + 7 * 520) = (bf16_t)(w.w >> 16); }
        __syncthreads();
#pragma unroll
        for (int j = 0; j < 8; ++j) { const int g = tid + 512 * j, row = g >> 6, ch = g & 63;
            const u32x2 v = *(const LAS u32x2*)(tl2 + row * 520 + ch * 8);
            *(u32x2*)(vT + ((size_t)hc * 512 + e0 + row) * 256 + ch * 4) = v; }
        __syncthreads();
    }
}

__device__ __forceinline__ void p6_softmax_scan(Frame& F) {
    const int lane = F.lane;
    unsigned char* ws = F.ws; float* fsm = (float*)(ws + WS_FSM);
    const bf16_t* dS = (const bf16_t*)(ws + WS_R1); bf16_t* Sst = (bf16_t*)(ws + WS_R2); const float* gam = fsm + F_GAMMA;
    for (int gid = (F.vcu * 8 + F.wave) * 64 + lane; gid < 4 * 512 * 64; gid += F.G * 512) {
        const int dq = gid & 63, e = (gid >> 6) & 511, h = gid >> 15;
        f32x4 st = {0.f, 0.f, 0.f, 0.f};
#pragma unroll 8
        for (int c = 0; c < 32; ++c) { const int hc = h * 32 + c; const size_t idx = ((size_t)hc * 512 + e) * 256 + dq * 4;
            const u32x2 w = *(const u32x2*)(dS + idx); const f32x4 g = *(const f32x4*)(gam + hc * 256 + dq * 4);
            u32x2 o = {pk2(st[0], st[1]), pk2(st[2], st[3])}; *(u32x2*)(Sst + idx) = o;
            st[0] = g[0] * st[0] + bflo(w.x); st[1] = g[1] * st[1] + bfhi(w.x); st[2] = g[2] * st[2] + bflo(w.y); st[3] = g[3] * st[3] + bfhi(w.y); }
        float* op = F.out + O_STP + ((size_t)h * 256 + dq * 4) * 512 + e;
        op[0] = st[0]; op[512] = st[1]; op[1024] = st[2]; op[1536] = st[3];
    }
}

__device__ __forceinline__ void p8_pc_convert(Frame& F) {
    const int gt = (F.vcu * 8 + F.wave) * 64 + F.lane, NGT = F.G * 512;
    const float* PCp = (const float*)(F.ws + WS_R5); bf16_t* PCb = (bf16_t*)(F.ws + WS_ZQK) + 8 * MiB; const float* fsm = (const float*)(F.ws + WS_FSM);
    for (int i = gt; i < 16 * 256 * 64; i += NGT) { const size_t e = (size_t)i * 8; f32x4 a = {0.f, 0.f, 0.f, 0.f}, b = a;
        const int rr = i >> 6, h = rr >> 8, bq = rr & 255, bb = bq >> 4, q = bq & 15;
        const float* rs = fsm + F_SSQ_K + ((size_t)bb * 256 + h * 16 + q) * 9; float tot = 0.f;
#pragma unroll
        for (int t = 0; t < 9; ++t) tot += rs[t];
        const float inv = 1.f / tot;
#pragma unroll
        for (int ks = 0; ks < 3; ++ks) { const float* s = PCp + (size_t)ks * 16 * 256 * 512 + e; a += *(const f32x4*)s; b += *(const f32x4*)(s + 4); }
        u32x4 o = {pk2(a[0] * inv, a[1] * inv), pk2(a[2] * inv, a[3] * inv), pk2(b[0] * inv, b[1] * inv), pk2(b[2] * inv, b[3] * inv)}; *(u32x4*)(PCb + e) = o; }
}

__device__ __forceinline__ void p9_ffn_weights(Frame& F, int jlo, int jhi, int wi, int nw) {
    LAS float* scr = (LAS float*)(F.lds + F.wave * 16384);
    const int gw = wi * 8 + F.wave, NGW = nw * 8, lane = lane_fresh_();
    const float* const* in = F.in; unsigned char* ws = F.ws; bf16_t* wup = (bf16_t*)((char*)(F.out + O_Y) + 20 * MiB);
    auto dec = [=](int it) -> TrDesc {
        const int n = (lane_id_() & 7) * 4;
        if (it < 8192) { const int kb = it / 256, nb = it % 256; return tr_desc(in[20], DFF, wup, 2048, kb * 64, nb * 32, nb * 32 + n, in[19], lane); }
        const int r = it - 8192, kb = r / 64, nb = r % 64; return tr_desc(in[21], 2048, (bf16_t*)(ws + WS_R3), DFF, kb * 64, nb * 32, nb * 32 + n, nullptr, lane);
    };
    tr_loop(jlo + gw, jhi, NGW, dec, scr, lane);
}
__device__ __forceinline__ void p9_gla_sample(Frame& F) {
    unsigned char* ws = F.ws; float* fsm = (float*)(ws + WS_FSM);
    const bf16_t* ZQK = (const bf16_t*)(ws + WS_ZQK); bf16_t* ZV = (bf16_t*)(ws + WS_ZV); const bf16_t* ZM = (const bf16_t*)(ws + WS_ZM);
    const float* wa2 = F.in[15]; const float* ba_ = F.in[16]; const float* S0 = F.in[4];
    LAS float* alr_s = (LAS float*)F.lds;
    LAS float* qt_s = alr_s + 256;
    LAS float* kt_s = qt_s + 4096;
    LAS float* ke_s = kt_s + 4096;
    LAS float* gam_s = ke_s + 4096;
    LAS float* A_s = gam_s + 256;
    LAS float* osum = A_s + 256;
    LAS float* red_s = osum + 8192;
    const int tid = F.tid;
    for (int un = F.vcu; un < 256; un += F.G) {
        const int bh = un >> 2, eq = un & 3, b = bh >> 2, h = bh & 3; const int row0 = SEQ + b * 16;
        if (tid < 256) alr_s[tid] = bf2f(ZM[(size_t)(row0 + (tid >> 4)) * 256 + 64 + (tid & 15)]);
        __syncthreads();
        if (tid < 256) { const int d = tid; float bb[16]; float bc = 0.f; const float ba = ba_[h * 256 + d]; float wa[16];
#pragma unroll
            for (int r = 0; r < 16; ++r) wa[r] = wa2[r * 1024 + h * 256 + d];
#pragma unroll
            for (int t = 0; t < 16; ++t) { float x = ba;
#pragma unroll
                for (int r = 0; r < 16; ++r) x += alr_s[t * 16 + r] * wa[r];
                bc += logsig16(x); bb[t] = bc; }
#pragma unroll
            for (int t = 0; t < 16; ++t) { const size_t tr = (size_t)(row0 + t) * 2048;
                const float gq = bf2f(ZQK[tr + h * 256 + d]), gk = bf2f(ZQK[tr + 1024 + h * 256 + d]);
                qt_s[d * 16 + t] = gq * 0.0625f * __expf(bb[t]); kt_s[d * 16 + t] = gk * __expf(-bb[t]); ke_s[d * 16 + t] = gk * __expf(bc - bb[t]); }
            gam_s[d] = __expf(bc); }
        __syncthreads();
        if (tid < 256) { const int t = tid >> 4, s_ = tid & 15; float a = 0.f;
            for (int d = 0; d < 256; ++d) a += qt_s[d * 16 + t] * kt_s[d * 16 + s_];
            A_s[tid] = (s_ <= t) ? a : 0.f; }
        __syncthreads();
        const int el = tid & 127, dq = tid >> 7, e = eq * 128 + el; float v[16], o[16];
#pragma unroll
        for (int t = 0; t < 16; ++t) v[t] = bf2f(ZV[(size_t)(row0 + t) * 2048 + h * 512 + e]);
#pragma unroll
        for (int t = 0; t < 16; ++t) { float a = 0.f;
            if (dq == 0) {
#pragma unroll
                for (int s_ = 0; s_ < 16; ++s_) a += A_s[t * 16 + s_] * v[s_]; }
            o[t] = a; }
        const float* sp = S0 + ((size_t)(b * 4 + h) * 256 + dq * 64) * 512 + e; float* op = F.out + O_STS + ((size_t)(b * 4 + h) * 256 + dq * 64) * 512 + e;
#define GS_LOAD(buf, dd0_) do { _Pragma("unroll") for (int i_ = 0; i_ < 8; ++i_) buf[i_] = sp[(size_t)((dd0_) + i_) * 512]; } while (0)
#define GS_COMP(buf, dd0_) do { _Pragma("unroll") for (int i_ = 0; i_ < 8; ++i_) { const int dd = (dd0_) + i_; const int d = dq * 64 + dd; const float s0 = buf[i_]; float sn = gam_s[d] * s0; \
            const LAS f32x4* q4 = (const LAS f32x4*)(qt_s + d * 16); const LAS f32x4* k4 = (const LAS f32x4*)(ke_s + d * 16); \
            _Pragma("unroll") for (int j = 0; j < 4; ++j) { const f32x4 qv = q4[j], kv = k4[j]; \
                _Pragma("unroll") for (int i = 0; i < 4; ++i) { o[j * 4 + i] += qv[i] * s0; sn += kv[i] * v[j * 4 + i]; } } \
            op[(size_t)dd * 512] = sn; } } while (0)
        { float sa[8], sb[8];
          GS_LOAD(sa, 0);
#pragma unroll 1
          for (int dd0 = 0; dd0 < 64; dd0 += 16) {
              GS_LOAD(sb, dd0 + 8); asm volatile("" ::: "memory");
              GS_COMP(sa, dd0); asm volatile("" ::: "memory");
              if (dd0 + 16 < 64) GS_LOAD(sa, dd0 + 16);
              asm volatile("" ::: "memory");
              GS_COMP(sb, dd0 + 8); asm volatile("" ::: "memory");
          } }
#undef GS_LOAD
#undef GS_COMP
#pragma unroll
        for (int t = 0; t < 16; ++t) osum[(dq * 16 + t) * 128 + el] = o[t];
        __syncthreads();
#pragma unroll
        for (int j = 0; j < 4; ++j) { const int t = dq * 4 + j;
            const float tot = (osum[(0 * 16 + t) * 128 + el] + osum[(1 * 16 + t) * 128 + el]) + (osum[(2 * 16 + t) * 128 + el] + osum[(3 * 16 + t) * 128 + el]);
            ZV[(size_t)(row0 + t) * 2048 + h * 512 + e] = f2bf(tot);
            const float ss = wave_sum(tot * tot); if (F.lane == 0) red_s[t * 8 + F.wave] = ss; }
        __syncthreads();
        if (tid < 16) { const int t = tid, w0 = (t >> 2) * 2; fsm[F_SSQ_OG + ((size_t)(row0 + t) * 4 + h) * 4 + eq] = red_s[t * 8 + w0] + red_s[t * 8 + w0 + 1]; }
        __syncthreads();
    }
}

__device__ __forceinline__ void p10_mix(Frame& F, int t_lo, int t_hi, int wi, int nw) {
    const int gt = (wi * 8 + F.wave) * 64 + F.lane, NGT = nw * 512;
    unsigned char* ws = F.ws; const float* fsm = (const float*)(ws + WS_FSM); const float* gn = F.in[17];
    bf16_t* ZOG = (bf16_t*)(ws + WS_ZOG); const bf16_t* ZGM = (const bf16_t*)(ws + WS_ZGM); const bf16_t* ZGG = (const bf16_t*)(ws + WS_ZGG); const bf16_t* ZV = (const bf16_t*)(ws + WS_ZV);
#pragma unroll 2
    for (int i = t_lo * 256 + gt; i < t_hi * 256; i += NGT) { const int t = i >> 8, c8 = (i & 255) * 8, hg = c8 >> 9; const size_t e = (size_t)t * 2048 + c8;
        const f32x4 sq = *(const f32x4*)(fsm + F_SSQ_OG + ((size_t)t * 4 + hg) * 4);
        const float inv = rsqrtf(((sq[0] + sq[1]) + (sq[2] + sq[3])) * (1.f / 512.f) + EPS);
        const u32x4 wm = *(const u32x4*)(ZGM + e), wg = *(const u32x4*)(ZGG + e), wv = *(const u32x4*)(ZV + e);
        const f32x4 g0 = *(const f32x4*)(gn + (c8 & 511)), g1 = *(const f32x4*)(gn + (c8 & 511) + 4);
        const float m[8] = {bflo(wm.x), bfhi(wm.x), bflo(wm.y), bfhi(wm.y), bflo(wm.z), bfhi(wm.z), bflo(wm.w), bfhi(wm.w)};
        const float gg[8] = {bflo(wg.x), bfhi(wg.x), bflo(wg.y), bfhi(wg.y), bflo(wg.z), bfhi(wg.z), bflo(wg.w), bfhi(wg.w)};
        const float ov[8] = {bflo(wv.x), bfhi(wv.x), bflo(wv.y), bfhi(wv.y), bflo(wv.z), bfhi(wv.z), bflo(wv.w), bfhi(wv.w)};
        const float gnv[8] = {g0[0], g0[1], g0[2], g0[3], g1[0], g1[1], g1[2], g1[3]};
        float r[8];
#pragma unroll
        for (int k = 0; k < 8; ++k) r[k] = m[k] + gg[k] * (ov[k] * inv * gnv[k]);
        u32x4 o = {pk2(r[0], r[1]), pk2(r[2], r[3]), pk2(r[4], r[5]), pk2(r[6], r[7])}; *(u32x4*)(ZOG + e) = o; }
}

__device__ __forceinline__ void t_reduce_wo(Frame& F) {
    const int gw = F.vcu * 8 + F.wave, NGW = F.G * 8, lane = F.lane;
    float* fsm = (float*)(F.ws + WS_FSM); const float* Yp = (const float*)(F.ws + WS_R4); bf16_t* x1b = (bf16_t*)(F.ws + WS_R2);
    for (int r = gw; r < NSAMP; r += NGW) { float ss = 0.f;
#pragma unroll
        for (int j = 0; j < 4; ++j) { const int c = (lane + 64 * j) * 8; const float* xr = F.in[1] + (size_t)r * DM + c;
            f32x4 a = *(const f32x4*)xr, b = *(const f32x4*)(xr + 4);
#pragma unroll
            for (int ks = 0; ks < 8; ++ks) { const float* s = Yp + ((size_t)ks * 256 + r) * DM + c; a += *(const f32x4*)s; b += *(const f32x4*)(s + 4); }
            u32x4 o = {pk2(a[0], a[1]), pk2(a[2], a[3]), pk2(b[0], b[1]), pk2(b[2], b[3])}; *(u32x4*)(x1b + (size_t)(SEQ + r) * DM + c) = o;
            ss += (a[0] * a[0] + a[1] * a[1]) + (a[2] * a[2] + a[3] * a[3]) + (b[0] * b[0] + b[1] * b[1]) + (b[2] * b[2] + b[3] * b[3]); }
        ss = wave_sum(ss);
        if (lane < 8) fsm[F_SSQ_X1 + (size_t)(SEQ + r) * 8 + lane] = lane == 0 ? ss : 0.f; }
}
__device__ __forceinline__ void t_reduce_up(Frame& F) {
    const int gt = (F.vcu * 8 + F.wave) * 64 + F.lane, NGT = F.G * 512;
    const float* fsm = (const float*)(F.ws + WS_FSM); const float* U = (const float*)(F.ws + WS_R5); bf16_t* Hb = (bf16_t*)(F.ws + WS_ZL);
    for (int i = gt; i < NSAMP * 1024; i += NGT) { const int r = i >> 10, c = (i & 1023) * 8;
        const f32x4 q0_ = *(const f32x4*)(fsm + F_SSQ_X1 + (size_t)(SEQ + r) * 8), q1_ = *(const f32x4*)(fsm + F_SSQ_X1 + (size_t)(SEQ + r) * 8 + 4);
        const float inv2 = 1.f / ((((q0_[0] + q0_[1]) + (q0_[2] + q0_[3])) + ((q1_[0] + q1_[1]) + (q1_[2] + q1_[3]))) * (1.f / 2048.f) + EPS);
        f32x4 a = {0.f, 0.f, 0.f, 0.f}, b = a;
#pragma unroll
        for (int ks = 0; ks < 4; ++ks) { const float* s = U + ((size_t)ks * 256 + r) * DFF + c; a += *(const f32x4*)s; b += *(const f32x4*)(s + 4); }
#pragma unroll
        for (int k = 0; k < 4; ++k) { const float x = fmaxf(a[k], 0.f), y = fmaxf(b[k], 0.f); a[k] = x * x * inv2; b[k] = y * y * inv2; }
        u32x4 o = {pk2(a[0], a[1]), pk2(a[2], a[3]), pk2(b[0], b[1]), pk2(b[2], b[3])}; *(u32x4*)(Hb + (size_t)(SEQ + r) * DFF + c) = o; }
}
__device__ __forceinline__ void t_reduce_down(Frame& F) {
    const int gt = (F.vcu * 8 + F.wave) * 64 + F.lane, NGT = F.G * 512;
    const float* Dp = (const float*)(F.ws + WS_R4);
    for (int i = gt; i < NSAMP * 256; i += NGT) { const int r = i >> 8, c = (i & 255) * 8;
        float* yp = F.out + O_Y + (size_t)(SEQ + r) * DM + c; const u32x4 w = *(const u32x4*)((const bf16_t*)(F.ws + WS_R2) + (size_t)(SEQ + r) * DM + c);
        f32x4 a = {bflo(w.x), bfhi(w.x), bflo(w.y), bfhi(w.y)}, b = {bflo(w.z), bfhi(w.z), bflo(w.w), bfhi(w.w)};
#pragma unroll
        for (int ks = 0; ks < 16; ++ks) { const float* s = Dp + ((size_t)ks * 256 + r) * DM + c; a += *(const f32x4*)s; b += *(const f32x4*)(s + 4); }
        *(f32x4*)yp = a; *(f32x4*)(yp + 4) = b; }
}


__device__ __forceinline__ void t_local_wo(Frame& F, int pn, int part) {
    const int tid = F.wave * 64 + F.lane;
    float* fsm = (float*)(F.ws + WS_FSM); const float* Yp = (const float*)(F.ws + WS_R4); bf16_t* x1b = (bf16_t*)(F.ws + WS_R2);
#pragma unroll
    for (int j = 0; j < 2; ++j) { const int i = tid + 512 * j, r = part * 32 + (i >> 5), c = pn * 256 + (i & 31) * 8;
        const float* xr = F.in[1] + (size_t)r * DM + c;
        f32x4 a = *(const f32x4*)xr, b = *(const f32x4*)(xr + 4);
#pragma unroll
        for (int ks = 0; ks < 8; ++ks) { const float* s = Yp + ((size_t)ks * 256 + r) * DM + c; a += *(const f32x4*)s; b += *(const f32x4*)(s + 4); }
        u32x4 o = {pk2(a[0], a[1]), pk2(a[2], a[3]), pk2(b[0], b[1]), pk2(b[2], b[3])}; *(u32x4*)(x1b + (size_t)(SEQ + r) * DM + c) = o;
        float ss = (a[0] * a[0] + a[1] * a[1]) + (a[2] * a[2] + a[3] * a[3]) + (b[0] * b[0] + b[1] * b[1]) + (b[2] * b[2] + b[3] * b[3]);
        ss += __shfl_xor(ss, 1); ss += __shfl_xor(ss, 2); ss += __shfl_xor(ss, 4); ss += __shfl_xor(ss, 8); ss += __shfl_xor(ss, 16);
        if ((i & 31) == 0) fsm[F_SSQ_X1 + (size_t)(SEQ + r) * 8 + pn] = ss; }
}
__device__ __forceinline__ void t_local_up(Frame& F, int pn, int part) {
    const int tid = F.wave * 64 + F.lane;
    const float* fsm = (const float*)(F.ws + WS_FSM); const float* U = (const float*)(F.ws + WS_R5); bf16_t* Hb = (bf16_t*)(F.ws + WS_ZL);
#pragma unroll
    for (int j = 0; j < 4; ++j) { const int i = tid + 512 * j, r = part * 64 + (i >> 5), c = pn * 256 + (i & 31) * 8;
        const f32x4 q0_ = *(const f32x4*)(fsm + F_SSQ_X1 + (size_t)(SEQ + r) * 8), q1_ = *(const f32x4*)(fsm + F_SSQ_X1 + (size_t)(SEQ + r) * 8 + 4);
        const float inv2 = 1.f / ((((q0_[0] + q0_[1]) + (q0_[2] + q0_[3])) + ((q1_[0] + q1_[1]) + (q1_[2] + q1_[3]))) * (1.f / 2048.f) + EPS);
        f32x4 a = {0.f, 0.f, 0.f, 0.f}, b = a;
#pragma unroll
        for (int ks = 0; ks < 4; ++ks) { const float* s = U + ((size_t)ks * 256 + r) * DFF + c; a += *(const f32x4*)s; b += *(const f32x4*)(s + 4); }
#pragma unroll
        for (int k = 0; k < 4; ++k) { const float x = fmaxf(a[k], 0.f), y = fmaxf(b[k], 0.f); a[k] = x * x * inv2; b[k] = y * y * inv2; }
        u32x4 o = {pk2(a[0], a[1]), pk2(a[2], a[3]), pk2(b[0], b[1]), pk2(b[2], b[3])}; *(u32x4*)(Hb + (size_t)(SEQ + r) * DFF + c) = o; }
}
__device__ __forceinline__ void t_local_down(Frame& F, int pn, int part) {
    const int tid = F.wave * 64 + F.lane;
    const float* Dp = (const float*)(F.ws + WS_R4);
    { const int r = part * 16 + (tid >> 5), c = pn * 256 + (tid & 31) * 8;
        float* yp = F.out + O_Y + (size_t)(SEQ + r) * DM + c; const u32x4 w = *(const u32x4*)((const bf16_t*)(F.ws + WS_R2) + (size_t)(SEQ + r) * DM + c);
        f32x4 a = {bflo(w.x), bfhi(w.x), bflo(w.y), bfhi(w.y)}, b = {bflo(w.z), bfhi(w.z), bflo(w.w), bfhi(w.w)};
#pragma unroll
        for (int ks = 0; ks < 16; ++ks) { const float* s = Dp + ((size_t)ks * 256 + r) * DM + c; a += *(const f32x4*)s; b += *(const f32x4*)(s + 4); }
        *(f32x4*)yp = a; *(f32x4*)(yp + 4) = b; }
}

#ifndef N_LAUNCHES
#define N_LAUNCHES 1
#endif
constexpr int N_PHASES = 16;

__device__ __forceinline__ att::BlockRef att_ref(Frame& F, int h, int qb, int dry) {
    att::BlockRef r;
    r.Q = (const bf16_t*)(F.ws + WS_R1) + ((size_t)h * NTOK + (size_t)qb * 256) * 192;
    r.K = (const bf16_t*)(F.out + O_Y) + (size_t)h * SEQ * 192;
    r.V = (const bf16_t*)(F.ws + WS_R2) + (size_t)h * SEQ * 128;
    r.G = (bf16_t*)(F.ws + WS_ZGM) + (size_t)qb * 256 * 2048 + h * 128;
    r.fsm = (const float*)(F.ws + WS_FSM); r.ssq_qg = (const float*)((const char*)(F.out + O_Y) + 56 * MiB);
    r.qb = qb; r.h = h; r.dry = dry; return r;
}
__device__ __forceinline__ void p4_attention(Frame& F, int dry) {
    const int nblk = 512;
    int n = F.vcu * 2; if (n >= nblk) return;
    att::Seam S;
    att::BlockRef cur = att_ref(F, n >> 5, (n & 1) ? 31 - ((n >> 1) & 15) : ((n >> 1) & 15), dry);
    att::prime(cur, (char*)F.lds, S, F.wave);
    for (;;) {
        int nn = (n & 1) ? (n - 1 + 2 * F.G) : n + 1;
        const bool last = nn >= nblk;
        const att::BlockRef nxt = last ? cur : att_ref(F, nn >> 5, (nn & 1) ? 31 - ((nn >> 1) & 15) : ((nn >> 1) & 15), dry);
        att::block(cur, nxt, (char*)F.lds, S, F.wave);
        if (last) break;
        cur = nxt; n = nn;
    }
}

struct Args { const float* in[22]; float* out; unsigned char* ws; float freq[32]; int ph_lo, ph_hi, li, probe; };

__global__ void __launch_bounds__(512, 2) mega_fwd(Args args) {
    extern __shared__ __attribute__((aligned(16))) unsigned char lds_raw[];
    Frame F;
    F.lds = (LAS unsigned char*)lds_raw; F.ws = args.ws; F.out = args.out; F.in = args.in;
    F.tid = threadIdx.x; F.lane = F.tid & 63; F.wave = __builtin_amdgcn_readfirstlane(F.tid >> 6);
    F.G = gridDim.x; { const int bx = blockIdx.x; F.vcu = (F.G % 8 == 0) ? (bx % 8) * (F.G / 8) + bx / 8 : bx; }
    volatile LAS unsigned* MISC = (volatile LAS unsigned*)(F.lds + MISC_OFF);
    for (int u = F.tid; u < (LDS_BYTES - LDSCTL_OFF) / 4; u += 512) ((LAS unsigned*)(F.lds + LDSCTL_OFF))[u] = 0u;
    __syncthreads();
    XcdBarrier bar; bar.bar = (unsigned*)(F.ws + WS_CTL) + 4096; bar.x = 0; bar.st = nullptr;
    if (N_LAUNCHES == 1) bar = xcd_barrier_post((unsigned*)(F.ws + WS_CTL) + 4096, MISC + 8, F.tid == 0);
    EP ep; ep.ws = F.ws; ep.out = F.out; ep.xp = args.in[0]; ep.xs = args.in[1]; ep.gqn = args.in[11]; ep.gqr = args.in[12]; ep.gkn = args.in[13]; ep.gkr = args.in[14]; ep.lds = F.lds; ep.dry = 0;
    const int lo = args.ph_lo, hi = args.ph_hi;
#ifndef PH_MASK
#define PH_MASK 0xffffffff
#endif
#define IN(k) ((((unsigned)PH_MASK >> (k)) & 1u) && lo <= (k) && (k) < hi)
#define RF() do { int l_ = lane_id_(); asm volatile("" : "+v"(l_)); F.lane = l_; F.tid = F.wave * 64 + l_; } while (0)
#define SEAM(k) do { if (IN(k) && IN((k) + 1)) xcd_barrier(bar, F.wave == 0 && lane_id_() == 0); RF(); } while (0)
    int rot = 0;
    const bool late_w = (F.G == 256);
    if (IN(0)) {
        p0_prologue(F, late_w ? 1 : 3, F.vcu, F.G);
        { float* cs = (float*)(F.ws + WS_FSM) + F_ROPE; const int gt = (F.vcu * 8 + F.wave) * 64 + F.lane;
          for (int i = gt; i < SEQ * 32; i += F.G * 512) { const int p = i >> 5, k = i & 31;
              const float ang = (float)p * args.freq[k];
              const double xd = (double)ang; const double kq = __builtin_rint(xd * 0.63661977236758134308); const float r = (float)(xd - kq * 1.57079632679489661923);
              const float sr = __sinf(r), cr = __cosf(r); const int q = ((int)kq) & 3;
              const float c = (q == 0) ? cr : (q == 1) ? -sr : (q == 2) ? -cr : sr;
              const float s = (q == 0) ? sr : (q == 1) ? cr : (q == 2) ? -sr : -cr;
              cs[p * 64 + k] = c; cs[p * 64 + 32 + k] = s; } }
    }
#if defined(PROBE) && (PROBE & 4)
    if (IN(0) && args.probe) { p0_prologue(F, 3, F.vcu, F.G); }
#endif
#if defined(PROBE) && (PROBE & 64)
    if (args.probe) { for (int i = 0; i < 10; ++i) xcd_barrier(bar, F.wave == 0 && lane_id_() == 0); }
#endif
    SEAM(0);
    const bool kcat_early = false;
    if (IN(1)) { rot = 0; run_gemm<M_INPROJ>(F, ep, 33 * 45, 4096, 4096, 32, 32, rot, 1);
        RF(); if (late_w && F.vcu >= 205) p0_prologue(F, 2, F.vcu - 205, 51);
#if defined(PROBE) && (PROBE & 1)
        if (args.probe) { EP ed = ep; ed.dry = args.probe; rot = 0; run_gemm<M_INPROJ>(F, ed, 33 * 45, 4096, 4096, 32, 32, rot); }
#endif
#if defined(PROBE) && (PROBE & 512)
        if (args.probe) { rot = 0; run_gemm<M_INPROJ>(F, ep, 33 * 45, 4096, 4096, 32, 32, rot); }
#endif
    }
    SEAM(1);
    if (IN(2)) { rot = 0; run_gemm<M_QUP>(F, ep, 33 * 12, 2048, 1024, 8, 8, rot); run_gemm<M_KVUP>(F, ep, 33 * 16, 2048, 1024, 8, 8, rot); RF(); p2_ckv_krope(F); RF(); p3_kcat_ct(F, kcat_early); RF(); p3_gla_prep(F); }
#if defined(PROBE) && (PROBE & 128)
    if (IN(2) && args.probe) { EP ed = ep; ed.dry = args.probe; rot = 0; run_gemm<M_QUP>(F, ed, 33 * 12, 2048, 1024, 8, 8, rot); run_gemm<M_KVUP>(F, ed, 33 * 16, 2048, 1024, 8, 8, rot);
        run_gemm<M_CNORM>(F, ed, 144 * 8, 1280, 1024, 8, 8, rot); }
#endif
    SEAM(2);
#if defined(PROBE) && (PROBE & 2)
    if (IN(4) && args.probe) { p4_attention(F, args.probe); }
#endif
    if (IN(4)) { rot = 0; p4_attention(F, 0); RF(); for (int L = F.vcu; L < 32; L += F.G) p4_finalize_q_head(F, L >> 1); asm volatile("s_waitcnt vmcnt(0)" ::: "memory"); __syncthreads(); run_gemm<M_QABS>(F, ep, 32, 512, 512, 4, 4, rot); run_gemm<M_CNORM>(F, ep, 128 * 8, 1280, 1024, 8, 8, rot); }
    SEAM(4);
    if (IN(5)) { rot = 0; run_gemm<M_S>(F, ep, 144, 1280, 1280, 10, 10, rot); if (F.G == 256) { const bool sc = F.vcu < 144;
            run_gemm_cg<M_GLA_A>(F, ep, F.vcu, sc ? 384 : 112, 384, 512, 512, 4); }
        else run_gemm<M_GLA_A>(F, ep, 384, 512, 512, 4, 4, rot); }
    SEAM(5);
    const bool wwin = (F.G == 256);
    constexpr int J6 = 4000, J8 = 13000, J10 = 14200;
    if (IN(6)) { rot = 0; run_gemm<M_PC>(F, ep, 96, 4608, 4608, 12, 12, rot); RF(); p6_softmax_scan(F); if (wwin && F.vcu >= 96) p9_ffn_weights(F, 0, J6, F.vcu - 96, 160); }
    SEAM(6);
    if (IN(7)) { { int r2 = 0; run_gemm<M_GLA_O>(F, ep, 512, 512, 512, 4, 4, r2); } RF(); p8_pc_convert(F); }
    SEAM(7);
    const int x_nx = __builtin_amdgcn_readfirstlane((int)MISC[8 + 1]), x_minc = __builtin_amdgcn_readfirstlane((int)MISC[8 + 2]);
    const int x_xi = __builtin_amdgcn_readfirstlane((int)MISC[8 + 3]), x_rank = __builtin_amdgcn_readfirstlane((int)MISC[8 + 4]);
    const bool xl = (N_LAUNCHES == 1) && XCD_LOCAL_TAIL && F.G == 256 && x_nx == 8 && x_minc == 32;
    unsigned* lctr = (unsigned*)(F.ws + WS_CTL) + 7680;
#define T0() (F.wave == 0 && lane_id_() == 0)
    if (IN(8)) { rot = 0; run_gemm<M_O>(F, ep, 16, 1024, 1024, 8, 8, rot); RF(); p9_gla_sample(F); RF(); p10_mix(F, 0, SEQ, F.vcu, F.G); RF(); if (wwin) { if (F.vcu >= 16) p9_ffn_weights(F, J6, J8, F.vcu - 16, 240); } else p9_ffn_weights(F, 0, 16384, F.vcu, F.G); }
#if defined(PROBE) && (PROBE & 32)
    if (IN(8) && args.probe) { p9_ffn_weights(F, 0, 16384, F.vcu, F.G); }
#endif
    SEAM(8);
    if (!xl) { if (IN(9)) { p10_mix(F, SEQ, NTOK, F.vcu, F.G); }
    SEAM(9); }
#if defined(PROBE) && (PROBE & 512)
    if (IN(10) && args.probe) { rot = 0; run_gemm<M_WO>(F, ep, 32 * 8, 4096, 4096, 32, 32, rot); }
#endif
    if (IN(10)) {
        if (xl) { p10_mix(F, SEQ, NTOK, x_rank, 32); xcd_local_join(lctr + 384 + x_xi * 8, 32u, bar.bar, T0()); RF(); }
        { const int c = xl ? (x_rank < 8 ? x_rank * 8 + x_xi : 64) : F.vcu, st = xl ? 64 : F.G; run_gemm_cg<M_WO_S>(F, ep, c, st, 64, 4096, 4096, 4); }
        if (xl && x_rank < 8) { xcd_local_join(lctr + x_xi * 8, 8u, bar.bar, T0()); RF(); t_local_wo(F, x_xi, x_rank); }
        rot = 64 % F.G; run_gemm<M_WO>(F, ep, 32 * 8, 4096, 4096, 32, 32, rot); RF();
        if (xl) { if (x_rank >= 8) p9_ffn_weights(F, J8, J10, x_xi * 24 + x_rank - 8, 192); }
        else if (wwin && F.vcu >= 64) p9_ffn_weights(F, J8, J10, F.vcu - 64, 192); }
    SEAM(10);
    if (!xl) { if (IN(11)) { t_reduce_wo(F); }
        SEAM(11); }
#if defined(PROBE) && (PROBE & 512)
    if (IN(12) && args.probe) { rot = 0; run_gemm<M_UP>(F, ep, 32 * 32, 4096, 4096, 32, 32, rot); }
#endif
#if defined(PROBE) && (PROBE & 1024)
    if (IN(12) && args.probe) { rot = 0; run_gemm<M_UP>(F, ep, 32 * 32, 4096, 4096, 32, 32, rot); }
#endif
#if defined(PROBE) && (PROBE & 2048)
    if (IN(12) && args.probe) { EP ed = ep; ed.dry = args.probe + 1; rot = 0; run_gemm<M_UP>(F, ed, 32 * 32, 4096, 4096, 32, 32, rot); }
#endif
#if defined(PROBE) && (PROBE & 4096)
    if (IN(12) && args.probe) { EP ed = ep; ed.dry = args.probe; rot = 0; run_gemm<M_UP>(F, ed, 32 * 32, 4096, 4096, 32, 32, rot); }
#endif
    if (IN(12)) {
        const int upn = x_xi * 4 + (x_rank >> 2), uks = x_rank & 3;
        { const int c = xl ? (x_rank < 16 ? uks * 32 + upn : 128) : F.vcu, st = xl ? 128 : F.G; run_gemm_cg<M_UP_S>(F, ep, c, st, 128, 4096, 4096, 8); }
        if (xl && x_rank < 16) { xcd_local_join(lctr + 64 + upn * 8, 4u, bar.bar, T0()); RF(); t_local_up(F, upn, uks); }
        rot = 128 % F.G; run_gemm<M_UP>(F, ep, 32 * 32, 4096, 4096, 32, 32, rot, 1); RF();
        if (xl) { if (x_rank >= 16) p9_ffn_weights(F, J10, 16384, x_xi * 16 + x_rank - 16, 128); }
        else if (wwin && F.vcu >= 128) p9_ffn_weights(F, J10, 16384, F.vcu - 128, 128); }
    SEAM(12);
    if (!xl) { if (IN(13)) { t_reduce_up(F); }
        SEAM(13); }
    if (IN(14)) {
        { const int c = xl ? (x_rank < 16 ? x_rank * 8 + x_xi : 128) : F.vcu, st = xl ? 128 : F.G; run_gemm_cg<M_DOWN_S>(F, ep, c, st, 128, 16384, 16384, 8); }
        if (xl && x_rank < 16) { xcd_local_join(lctr + 320 + x_xi * 8, 16u, bar.bar, T0()); RF(); t_local_down(F, x_xi, x_rank); }
        rot = 128 % F.G; run_gemm<M_DOWN>(F, ep, 32 * 8, 16384, 16384, 128, 128, rot); }
    if (!xl) { SEAM(14);
        if (IN(15)) { t_reduce_down(F); } }
#undef T0
#undef IN
#undef SEAM
}

extern "C" void kernel_launch(void* const* d_in, const int* in_sizes, int n_in, void* d_out, int out_size, void* d_ws, size_t ws_size, hipStream_t stream) {
    static int grid = 0;
    if (grid == 0) {
        if (n_in != 22 || out_size != (int)O_END || ws_size < WS_END) { fprintf(stderr, "kernel_launch: unexpected shapes (n_in %d out %d ws %zu)\n", n_in, out_size, ws_size); grid = -1; return; }
        int dev = 0, cus = 0, per_cu = 0;
        if (hipGetDevice(&dev) != hipSuccess || hipDeviceGetAttribute(&cus, hipDeviceAttributeMultiprocessorCount, dev) != hipSuccess) { grid = -1; return; }
        if (hipFuncSetAttribute((const void*)mega_fwd, hipFuncAttributeMaxDynamicSharedMemorySize, LDS_BYTES) != hipSuccess) { fprintf(stderr, "kernel_launch: hipFuncSetAttribute failed\n"); grid = -1; return; }
        if (hipOccupancyMaxActiveBlocksPerMultiprocessor(&per_cu, (const void*)mega_fwd, 512, LDS_BYTES) != hipSuccess || per_cu < 1) { fprintf(stderr, "kernel_launch: occupancy query says %d blocks per CU\n", per_cu); (void)hipGetLastError(); grid = -1; return; }
        grid = cus;
    }
    if (grid < 0) return;
    (void)hipMemsetAsync((char*)d_ws + WS_CTL, 0, 32768, stream);
    Args a{};
    for (int i = 0; i < 22; ++i) a.in[i] = (const float*)d_in[i];
    a.out = (float*)d_out; a.ws = (unsigned char*)d_ws;
#ifdef PROBE
    a.probe = 1;
#endif
    for (int k = 0; k < 32; ++k) a.freq[k] = powf(10000.f, -(float)k / 32.f);
    if (N_LAUNCHES == 1) { a.ph_lo = 0; a.ph_hi = N_PHASES; a.li = 0; hipLaunchKernelGGL(mega_fwd, dim3(grid), dim3(512), LDS_BYTES, stream, a); }
    else { for (int p = 0; p < N_PHASES; ++p) { a.ph_lo = p; a.ph_hi = p + 1; a.li = p; hipLaunchKernelGGL(mega_fwd, dim3(grid), dim3(512), LDS_BYTES, stream, a); } }
}
```
